# Optimizing an MI355X kernel written in HIP

```python
import math
import jax, jax.numpy as jnp
from jax import lax
import numpy as np

D_MODEL = 1024
BATCH = 2
SEQ = 8192
DEPTH = 4

DA_HEADS = 4
DA_HEAD_DIM = 64
DA_V_DIM = 2 * DA_HEAD_DIM
DA_WIDTH = DA_HEADS * DA_V_DIM
Q_BLOCK = 128
ML_HEADS = 4
ML_HEAD_DIM = 128
ML_WIDTH = ML_HEADS * ML_HEAD_DIM
ML_CONV = 5
ML_CHUNK = 128
WA_Q_HEADS = 8
WA_KV_HEADS = 2
WA_HEAD_DIM = 64
WA_WIDTH = WA_Q_HEADS * WA_HEAD_DIM
WINDOW = 128
WA_BLOCK = 128
ROPE_THETA = 10000.0
N_BRANCH = 3
N_EXPERTS = 32
TOP_K = 4
D_FF = D_MODEL
SWIGLU_LIMIT = 7.0
SWIGLU_ALPHA = 1.702
DN_ALPHA = (2.0 * DEPTH) ** 0.25
DN_BETA = (8.0 * DEPTH) ** -0.25
EPS = 1e-5

DA_Q = 0
DA_K = DA_Q + DA_HEADS * 2 * DA_HEAD_DIM
DA_V = DA_K + DA_HEADS * 2 * DA_HEAD_DIM
ML_X = DA_V + DA_WIDTH
ML_O = ML_X + ML_WIDTH
WA_Q = ML_O + ML_WIDTH
WA_K = WA_Q + WA_WIDTH
WA_V = WA_K + WA_KV_HEADS * WA_HEAD_DIM
GATES = WA_V + WA_KV_HEADS * WA_HEAD_DIM
D_IN = GATES + N_BRANCH * D_MODEL

kernel_name = 'hybrid_diffattn_mlstm_swa_moe_encoder'


def layer_norm(x, g, b):
    xf = x.astype(jnp.float32)
    mu = jnp.mean(xf, axis=-1, keepdims=True)
    var = jnp.mean(jnp.square(xf - mu), axis=-1, keepdims=True)
    return ((xf - mu) * lax.rsqrt(var + EPS) * g + b).astype(x.dtype)


def rms_norm(x, w):
    xf = x.astype(jnp.float32)
    return xf * lax.rsqrt(jnp.mean(jnp.square(xf), axis=-1, keepdims=True) + EPS) * w


def rope_tables(seq, dim):
    pos = jnp.arange(seq, dtype=jnp.float32)
    inv = ROPE_THETA ** (-jnp.arange(0, dim, 2, dtype=jnp.float32) / dim)
    ang = pos[:, None] * inv[None, :]
    return jnp.cos(ang), jnp.sin(ang)


def apply_rope(x, cos, sin):
    half = x.shape[-1] // 2
    shp = (cos.shape[0],) + (1,) * (x.ndim - 3) + (half,)
    c, s = cos.reshape(shp), sin.reshape(shp)
    xf = x.astype(jnp.float32)
    x1, x2 = xf[..., :half], xf[..., half:]
    return jnp.concatenate([x1 * c - x2 * s, x2 * c + x1 * s], axis=-1)


def diff_attention(q, k, v, lam, subln_w, lam_init):
    B, S, H, _, dh = q.shape
    nb = S // Q_BLOCK
    qb = (q * dh ** -0.5).reshape(B, nb, Q_BLOCK, H, 2, dh).transpose(1, 0, 3, 4, 2, 5)
    kt = k.astype(jnp.float32).transpose(0, 2, 3, 1, 4)
    vt = v.astype(jnp.float32).transpose(0, 2, 1, 3)

    def block(qi):
        s = jnp.einsum('bhmqd,bhmkd->bhmqk', qi, kt)
        p = jax.nn.softmax(s, axis=-1)
        a = p[:, :, 0] - lam * p[:, :, 1]
        return jnp.einsum('bhqk,bhkd->bhqd', a, vt)

    o = lax.map(block, qb)
    o = o.transpose(1, 0, 3, 2, 4).reshape(B, S, H, DA_V_DIM)
    o = rms_norm(o, subln_w) * (1.0 - lam_init)
    return o.reshape(B, S, H * DA_V_DIM)


def window_attention(q, k, v, sinks):
    B, S, Hq, d = q.shape
    Hkv = k.shape[2]
    R = Hq // Hkv
    nb = S // WA_BLOCK
    qb = (q * d ** -0.5).reshape(B, nb, WA_BLOCK, Hkv, R, d)

    def band(t):
        tp = jnp.pad(t.astype(jnp.float32), ((0, 0), (WINDOW, WINDOW), (0, 0), (0, 0)))
        tp = tp.reshape(B, nb + 2, WA_BLOCK, Hkv, d)
        return jnp.concatenate([tp[:, :-2], tp[:, 1:-1], tp[:, 2:]], axis=2)

    kw, vw = band(k), band(v)
    s = jnp.einsum('bnqgrd,bnkgd->bngrqk', qb, kw)
    qpos = jnp.arange(S).reshape(nb, WA_BLOCK)
    kpos = jnp.arange(nb)[:, None] * WA_BLOCK - WINDOW + jnp.arange(3 * WA_BLOCK)[None, :]
    valid = ((jnp.abs(qpos[:, :, None] - kpos[:, None, :]) <= WINDOW)
             & (kpos >= 0)[:, None, :] & (kpos < S)[:, None, :])
    s = jnp.where(valid[None, :, None, None], s, -jnp.inf)
    sink = sinks.astype(jnp.float32).reshape(Hkv, R)[None, None, :, :, None, None]
    m = jnp.maximum(jnp.max(s, axis=-1, keepdims=True), sink)
    e = jnp.exp(s - m)
    p = e / (jnp.sum(e, axis=-1, keepdims=True) + jnp.exp(sink - m))
    o = jnp.einsum('bngrqk,bnkgd->bnqgrd', p, vw)
    return o.reshape(B, S, Hq * d)


def mlstm_chunkwise(q, k, v, i_pre, f_pre):
    B, H, S, d = q.shape
    L = ML_CHUNK
    nc = S // L
    q = q.reshape(B, H, nc, L, d)
    k = k.reshape(B, H, nc, L, d) * d ** -0.5
    v = v.reshape(B, H, nc, L, d)
    ig = i_pre.reshape(B, H, nc, L)
    b = jnp.cumsum(jax.nn.log_sigmoid(f_pre).reshape(B, H, nc, L), axis=-1)
    g = b[..., -1]
    w_end = g[..., None] - b + ig
    m_loc = jnp.max(w_end, axis=-1)
    e_end = jnp.exp(w_end - m_loc[..., None])
    C_loc = jnp.einsum('bhcs,bhcsk,bhcsv->bhckv', e_end, k, v)
    n_loc = jnp.einsum('bhcs,bhcsk->bhck', e_end, k)

    def step(carry, inp):
        C, n, m = carry
        g_c, m_l, C_l, n_l = inp
        m_new = jnp.maximum(g_c + m, m_l)
        a = jnp.exp(g_c + m - m_new)
        bl = jnp.exp(m_l - m_new)
        C_new = a[..., None, None] * C + bl[..., None, None] * C_l
        n_new = a[..., None] * n + bl[..., None] * n_l
        return (C_new, n_new, m_new), (C, n, m)

    init = (jnp.zeros((B, H, d, d), jnp.float32), jnp.zeros((B, H, d), jnp.float32),
            jnp.zeros((B, H), jnp.float32))
    xs = (jnp.moveaxis(g, 2, 0), jnp.moveaxis(m_loc, 2, 0),
          jnp.moveaxis(C_loc, 2, 0), jnp.moveaxis(n_loc, 2, 0))
    _, (C_prev, n_prev, m_prev) = lax.scan(step, init, xs)
    C_prev = jnp.moveaxis(C_prev, 0, 2)
    n_prev = jnp.moveaxis(n_prev, 0, 2)
    m_prev = jnp.moveaxis(m_prev, 0, 2)
    D = b[..., :, None] - b[..., None, :] + ig[..., None, :]
    tril = jnp.tril(jnp.ones((L, L), dtype=bool))
    D = jnp.where(tril, D, -jnp.inf)
    a_t = b + m_prev[..., None]
    m_t = jnp.maximum(a_t, jnp.max(D, axis=-1))
    W = jnp.exp(D - m_t[..., None]) * jnp.einsum('bhctd,bhcsd->bhcts', q, k)
    inter = jnp.exp(a_t - m_t)
    numer = (inter[..., None] * jnp.einsum('bhctk,bhckv->bhctv', q, C_prev)
             + jnp.einsum('bhcts,bhcsv->bhctv', W, v))
    denom = inter * jnp.einsum('bhctk,bhck->bhct', q, n_prev) + jnp.sum(W, axis=-1)
    h = numer / jnp.maximum(jnp.abs(denom), jnp.exp(-m_t))[..., None]
    return h.reshape(B, H, S, d)


def mlstm_branch(xm, o_pre, conv_w, conv_b, wq, wk, wv, w_g, b_g, norm_w, skip):
    B, S, W = xm.shape
    H, d = ML_HEADS, ML_HEAD_DIM
    xc = lax.conv_general_dilated(xm, conv_w[:, None, :], window_strides=(1,),
                                  padding=[(ML_CONV // 2, ML_CONV // 2)],
                                  dimension_numbers=('NWC', 'WIO', 'NWC'),
                                  feature_group_count=W) + conv_b
    xc = jax.nn.silu(xc)
    xch = xc.reshape(B, S, H, d)
    q = jnp.einsum('bshd,hde->bshe', xch, wq)
    k = jnp.einsum('bshd,hde->bshe', xch, wk)
    v = jnp.einsum('bshd,hde->bshe', xm.reshape(B, S, H, d), wv)
    gin = jnp.concatenate([q.reshape(B, S, W), k.reshape(B, S, W), v.reshape(B, S, W)], axis=-1)
    gts = (gin @ w_g + b_g).astype(jnp.float32).reshape(B, S, 4, H).transpose(2, 0, 3, 1)
    i_f, f_f, i_b, f_b = gts[0], gts[1], gts[2], gts[3]
    qf = q.astype(jnp.float32).transpose(0, 2, 1, 3)
    kf = k.astype(jnp.float32).transpose(0, 2, 1, 3)
    vf = v.astype(jnp.float32).transpose(0, 2, 1, 3)
    flip = lambda t: jnp.flip(t, axis=2)
    h_fwd = mlstm_chunkwise(qf, kf, vf, i_f, f_f)
    h_bwd = flip(mlstm_chunkwise(flip(qf), flip(kf), flip(vf), flip(i_b), flip(f_b)))
    h = (h_fwd + h_bwd).transpose(0, 2, 1, 3)
    mu = jnp.mean(h, axis=-1, keepdims=True)
    var = jnp.mean(jnp.square(h - mu), axis=-1, keepdims=True)
    h = (h - mu) * lax.rsqrt(var + EPS) * norm_w.reshape(H, d)
    h = h.reshape(B, S, W) + skip * xc
    return jax.nn.sigmoid(o_pre) * h


def moe(x, router_w, router_b, w_gu, b_gu, w_down, b_down):
    B, S, Dm = x.shape
    t = x.reshape(B * S, Dm)
    logits = (t @ router_w + router_b).astype(jnp.float32)
    top_v, top_i = lax.top_k(logits, TOP_K)
    top_w = jax.nn.softmax(top_v, axis=-1)
    combine = jnp.sum(jax.nn.one_hot(top_i, N_EXPERTS, dtype=jnp.float32) * top_w[..., None], axis=1)
    y = jnp.zeros((B * S, Dm), jnp.float32)
    for e in range(N_EXPERTS):
        h = t @ w_gu[e] + b_gu[e]
        gate = jnp.minimum(h[:, ::2], SWIGLU_LIMIT)
        up = jnp.clip(h[:, 1::2], -SWIGLU_LIMIT, SWIGLU_LIMIT)
        act = gate * jax.nn.sigmoid(SWIGLU_ALPHA * gate) * (up + 1.0)
        y = y + combine[:, e:e + 1] * (act @ w_down[e] + b_down[e])
    return y.reshape(B, S, Dm).astype(x.dtype)


def setup_inputs(seed: int = 0) -> dict:
    key = jax.random.key(seed)
    ks = jax.random.split(key, 32)
    f32 = jnp.float32
    nrm = lambda k, shp, sc: jax.random.normal(k, shp, f32) * sc
    bi = nrm(ks[11], (DEPTH, 2, ML_HEADS), 0.1)
    bf = jnp.linspace(3.0, 6.0, ML_HEADS, dtype=f32)[None, None, :] + nrm(ks[12], (DEPTH, 2, ML_HEADS), 0.1)
    ml_b_gates = jnp.stack([bi[:, 0], bf[:, 0], bi[:, 1], bf[:, 1]], axis=1).reshape(DEPTH, 4 * ML_HEADS)
    return {
        'x': nrm(ks[0], (BATCH, SEQ, D_MODEL), 1.0),
        'w_in': nrm(ks[1], (DEPTH, D_MODEL, D_IN), D_MODEL ** -0.5),
        'da_lambda': nrm(ks[2], (DEPTH, 4, DA_HEAD_DIM), 0.1),
        'da_subln': 1.0 + nrm(ks[3], (DEPTH, DA_V_DIM), 0.02),
        'w_proj_a': nrm(ks[4], (DEPTH, DA_WIDTH, D_MODEL), DA_WIDTH ** -0.5),
        'ml_conv_w': nrm(ks[5], (DEPTH, ML_CONV, ML_WIDTH), ML_CONV ** -0.5),
        'ml_conv_b': nrm(ks[6], (DEPTH, ML_WIDTH), 0.02),
        'ml_wq': nrm(ks[7], (DEPTH, ML_HEADS, ML_HEAD_DIM, ML_HEAD_DIM), ML_HEAD_DIM ** -0.5),
        'ml_wk': nrm(ks[8], (DEPTH, ML_HEADS, ML_HEAD_DIM, ML_HEAD_DIM), ML_HEAD_DIM ** -0.5),
        'ml_wv': nrm(ks[9], (DEPTH, ML_HEADS, ML_HEAD_DIM, ML_HEAD_DIM), ML_HEAD_DIM ** -0.5),
        'ml_w_gates': nrm(ks[10], (DEPTH, 3 * ML_WIDTH, 4 * ML_HEADS), 0.01),
        'ml_b_gates': ml_b_gates,
        'ml_norm': 1.0 + nrm(ks[13], (DEPTH, ML_WIDTH), 0.02),
        'ml_skip': 1.0 + nrm(ks[14], (DEPTH, ML_WIDTH), 0.02),
        'w_proj_b': nrm(ks[15], (DEPTH, ML_WIDTH, D_MODEL), ML_WIDTH ** -0.5),
        'wa_sinks': nrm(ks[16], (DEPTH, WA_Q_HEADS), 0.5),
        'w_proj_c': nrm(ks[17], (DEPTH, WA_WIDTH, D_MODEL), WA_WIDTH ** -0.5),
        'w_out': nrm(ks[18], (DEPTH, D_MODEL, D_MODEL), D_MODEL ** -0.5 * DN_BETA),
        'ln1_g': 1.0 + nrm(ks[19], (DEPTH, D_MODEL), 0.02),
        'ln1_b': nrm(ks[20], (DEPTH, D_MODEL), 0.02),
        'router_w': nrm(ks[21], (DEPTH, D_MODEL, N_EXPERTS), D_MODEL ** -0.5),
        'router_b': nrm(ks[22], (DEPTH, N_EXPERTS), 0.01),
        'exp_w_gu': nrm(ks[23], (DEPTH, N_EXPERTS, D_MODEL, 2 * D_FF), D_MODEL ** -0.5),
        'exp_b_gu': nrm(ks[24], (DEPTH, N_EXPERTS, 2 * D_FF), 0.02),
        'exp_w_down': nrm(ks[25], (DEPTH, N_EXPERTS, D_FF, D_MODEL), D_FF ** -0.5 * DN_BETA),
        'exp_b_down': nrm(ks[26], (DEPTH, N_EXPERTS, D_MODEL), 0.02),
        'ln2_g': 1.0 + nrm(ks[27], (DEPTH, D_MODEL), 0.02),
        'ln2_b': nrm(ks[28], (DEPTH, D_MODEL), 0.02),
    }


def reference(x, w_in, da_lambda, da_subln, w_proj_a, ml_conv_w, ml_conv_b, ml_wq, ml_wk, ml_wv,
              ml_w_gates, ml_b_gates, ml_norm, ml_skip, w_proj_b, wa_sinks, w_proj_c, w_out,
              ln1_g, ln1_b, router_w, router_b, exp_w_gu, exp_b_gu, exp_w_down, exp_b_down,
              ln2_g, ln2_b):
    B, S, _ = x.shape
    cos, sin = rope_tables(S, DA_HEAD_DIM)
    for l in range(DEPTH):
        p = x @ w_in[l]
        qa = apply_rope(p[..., DA_Q:DA_K].reshape(B, S, DA_HEADS, 2, DA_HEAD_DIM), cos, sin)
        ka = apply_rope(p[..., DA_K:DA_V].reshape(B, S, DA_HEADS, 2, DA_HEAD_DIM), cos, sin)
        va = p[..., DA_V:ML_X].reshape(B, S, DA_HEADS, DA_V_DIM)
        lam_init = 0.8 - 0.6 * math.exp(-0.3 * l)
        lp = da_lambda[l].astype(jnp.float32)
        lam = jnp.exp(jnp.sum(lp[0] * lp[1])) - jnp.exp(jnp.sum(lp[2] * lp[3])) + lam_init
        ya = diff_attention(qa, ka, va, lam, da_subln[l], lam_init)
        yb = mlstm_branch(p[..., ML_X:ML_O], p[..., ML_O:WA_Q], ml_conv_w[l], ml_conv_b[l],
                          ml_wq[l], ml_wk[l], ml_wv[l], ml_w_gates[l], ml_b_gates[l],
                          ml_norm[l], ml_skip[l])
        qc = apply_rope(p[..., WA_Q:WA_K].reshape(B, S, WA_Q_HEADS, WA_HEAD_DIM), cos, sin)
        kc = apply_rope(p[..., WA_K:WA_V].reshape(B, S, WA_KV_HEADS, WA_HEAD_DIM), cos, sin)
        vc = p[..., WA_V:GATES].reshape(B, S, WA_KV_HEADS, WA_HEAD_DIM)
        yc = window_attention(qc, kc, vc, wa_sinks[l])
        gt = jax.nn.sigmoid(p[..., GATES:].reshape(B, S, N_BRANCH, D_MODEL))
        merged = (gt[:, :, 0] * (ya @ w_proj_a[l]) + gt[:, :, 1] * (yb @ w_proj_b[l])
                  + gt[:, :, 2] * (yc @ w_proj_c[l]))
        x = layer_norm(DN_ALPHA * x + (merged @ w_out[l]).astype(x.dtype), ln1_g[l], ln1_b[l])
        y = moe(x, router_w[l], router_b[l], exp_w_gu[l], exp_b_gu[l], exp_w_down[l], exp_b_down[l])
        x = layer_norm(DN_ALPHA * x + y, ln2_g[l], ln2_b[l])
    return x
```

```cpp
#include <hip/hip_runtime.h>
#include <cstdio>
#include <cstdint>
#include <cmath>

#ifndef MK_MULTI
#define MK_MULTI 0
#endif

#ifndef PHASE_MASK
#define PHASE_MASK 0xffffffffull
#endif
#define LAS __attribute__((address_space(3)))
#define GAS __attribute__((address_space(1)))
typedef unsigned short bf16;
typedef short bf16x8 __attribute__((ext_vector_type(8)));
typedef short s16x4 __attribute__((ext_vector_type(4)));
typedef float f32x2 __attribute__((ext_vector_type(2)));
typedef float f32x4 __attribute__((ext_vector_type(4)));
typedef float f32x16 __attribute__((ext_vector_type(16)));
typedef unsigned u32x2 __attribute__((ext_vector_type(2)));
typedef unsigned u32x4 __attribute__((ext_vector_type(4)));

constexpr int BATCH = 2, SEQ = 8192, DM = 1024, TOK = BATCH * SEQ, DEPTH = 4, DIN = 6400;
constexpr int NEXP = 32, DFF = 1024;
constexpr int WA_K_COL = 3072, WA_V_COL = 3200;
constexpr float DN_ALPHA = 1.6817928305074290f;
constexpr float LN_EPS = 1e-5f;
constexpr int NTHR = 512, NWAVES = 8, GRID = 256;
constexpr int MAXROWS = 73728;

constexpr size_t MiB = 1ull << 20;
constexpr size_t OFF_CTL = 0, CTL_BYTES = 1 * MiB;
constexpr size_t OFF_ROPE = 1 * MiB;
constexpr size_t OFF_WML = 3 * MiB;
constexpr size_t OFF_MISC = 5 * MiB;
constexpr size_t OFF_G4 = OFF_MISC;
constexpr size_t OFF_NLOC = OFF_MISC + 1 * MiB;
constexpr size_t OFF_NPREV = OFF_NLOC + 512 * 1024;
constexpr size_t OFF_MLOC = OFF_MISC + 2 * MiB;
constexpr size_t OFF_GCH = OFF_MLOC + 4096;
constexpr size_t OFF_MPREV = OFF_GCH + 4096;
constexpr size_t OFF_BLKCNT = OFF_MLOC + 16384;
constexpr size_t OFF_TILEE = OFF_MLOC + 65536;
constexpr size_t OFF_ROWW = OFF_MLOC + 131072;
constexpr size_t OFF_TOKE = OFF_MISC + 3 * MiB;
constexpr size_t OFF_TOKW = OFF_TOKE + 256 * 1024;
constexpr size_t OFF_TOKLP = OFF_TOKW + 256 * 1024;
constexpr size_t OFF_TOKROW = OFF_TOKLP + 256 * 1024;
constexpr size_t OFF_WIN = 9 * MiB;
constexpr size_t OFF_WP = OFF_WIN + 50 * MiB;
constexpr size_t OFF_WOUT = OFF_WP + 12 * MiB;
constexpr size_t OFF_WGU = OFF_WOUT + 8 * MiB;
constexpr size_t OFF_WDN = OFF_WGU + 512 * MiB;
constexpr size_t OFF_XB = OFF_WDN + 256 * MiB;
constexpr size_t OFF_XF = OFF_XB + 32 * MiB;
constexpr size_t OFF_QA = OFF_XF + 64 * MiB;
constexpr size_t OFF_KA = OFF_QA + 16 * MiB;
constexpr size_t OFF_VA = OFF_KA + 16 * MiB;
constexpr size_t OFF_MLX = OFF_VA + 16 * MiB;
constexpr size_t OFF_MLO = OFF_MLX + 16 * MiB;
constexpr size_t OFF_XC = OFF_MLO + 16 * MiB;
constexpr size_t OFF_WQ = OFF_XC + 16 * MiB;
constexpr size_t OFF_WK = OFF_WQ + 16 * MiB;
constexpr size_t OFF_WV = OFF_WK + 4 * MiB;
constexpr size_t OFF_GT = OFF_WV + 4 * MiB;
constexpr size_t OFF_Y3 = OFF_GT + 96 * MiB;
constexpr size_t OFF_MF = OFF_Y3 + 48 * MiB;
constexpr size_t OFF_MB = OFF_MF + 64 * MiB;
constexpr size_t OFF_MQ = OFF_MB + 32 * MiB;
constexpr size_t OFF_CLOC = OFF_MQ + 48 * MiB;
constexpr size_t OFF_CPT = OFF_CLOC + 64 * MiB;
constexpr size_t OFF_STASH = OFF_CPT + 32 * MiB;
constexpr size_t OFF_XG = OFF_STASH + 32 * MiB;
constexpr size_t OFF_ACT = OFF_XG + 144 * MiB;
constexpr size_t OFF_YS = OFF_ACT + 144 * MiB;
constexpr size_t WS_END = OFF_YS + 144 * MiB;

constexpr int PH_LDS = 147456;
constexpr int LDS_BYTES = PH_LDS + 256;

__device__ __forceinline__ unsigned cvtpk(float lo, float hi) { unsigned r; asm volatile("v_cvt_pk_bf16_f32 %0, %1, %2" : "=v"(r) : "v"(lo), "v"(hi)); return r; }
__device__ __forceinline__ float bflo(unsigned u) { return __uint_as_float(u << 16); }
__device__ __forceinline__ float bfhi(unsigned u) { return __uint_as_float(u & 0xffff0000u); }
__device__ __forceinline__ float bf1(bf16 h) { return __uint_as_float(((unsigned)h) << 16); }
__device__ __forceinline__ bf16 tobf1(float f) { return (bf16)(cvtpk(f, 0.f) & 0xffffu); }
__device__ __forceinline__ float sigmoidf_(float x) { return 1.0f / (1.0f + __expf(-x)); }
__device__ __forceinline__ float wave_sum(float v) {
#pragma unroll
    for (int o = 1; o < 64; o <<= 1) v += __shfl_xor(v, o);
    return v;
}
__device__ __forceinline__ float wave_max(float v) {
#pragma unroll
    for (int o = 1; o < 64; o <<= 1) v = fmaxf(v, __shfl_xor(v, o));
    return v;
}
#define LDS_WAIT() asm volatile("s_waitcnt lgkmcnt(0)" ::: "memory")

namespace pg8 {
constexpr int BM = 256, BK = 64, HALF = 128, HTB = HALF * BK * 2, STAGE_BYTES = 8 * HTB, NXCD = 8, WGM = 8;
__host__ __device__ __forceinline__ int lds_byte(int r, int c) { const int st = (r >> 4) * 2 + (c >> 5), rr = r & 15, cc = c & 31, ob = rr * 64 + cc * 2; return st * 1024 + (ob ^ (((ob >> 9) & 1) << 5)); }
__host__ __device__ __forceinline__ void stage_rc(int b, int& R, int& C) { const int st = b / 1024, sb = b % 1024, swz = sb ^ (((sb >> 9) & 1) << 5); R = (st >> 1) * 16 + swz / 64; C = (st & 1) * 32 + (swz % 64) / 2; }
__host__ __device__ __forceinline__ int perm32(int rho) { const int n = rho >> 4, i = rho & 15; return 8 * (i >> 2) + 4 * n + (i & 3); }

struct Unit { int pm, pn, bt; };
struct Gemm { const bf16* A; const bf16* Bt; int lda, ldb, K; };

struct StaticOrder {
    int nM, nN, nwg, G, c; const int* tile_e;
    __device__ void init(int nM_, int nN_, int G_, int c_, const int* te) { nM = nM_; nN = nN_; nwg = nM * nN; G = G_; c = c_; tile_e = te; }
    __device__ bool next(int i, Unit& u) const {
        const long L = (long)i * G + c; if (L >= nwg) return false;
        int wgid = (int)L; { const int q = nwg / NXCD, r = nwg % NXCD, xcd = wgid % NXCD, off = wgid / NXCD; wgid = (xcd < r ? xcd * (q + 1) : r * (q + 1) + (xcd - r) * q) + off; }
        const int nig = WGM * nN, gid = wgid / nig, fm = gid * WGM, gsz = (nM - fm) < WGM ? (nM - fm) : WGM;
        u.pm = fm + ((wgid % nig) % gsz); u.pn = (wgid % nig) / gsz;
        u.bt = tile_e ? (__builtin_amdgcn_readfirstlane(tile_e[u.pm]) * nN + u.pn) : u.pn;
        return true;
    }
};

template <class Epi, bool ALIGN_EPI>
__device__ __forceinline__ void gemm_phase(LAS unsigned char* lds, const Gemm g, const StaticOrder& S, const Epi& E) {
    int tid = threadIdx.x; asm volatile("" : "+v"(tid));
    const int wid = __builtin_amdgcn_readfirstlane(tid >> 6), lane = tid & 63, wr = wid >> 2, wc = wid & 3, fr = lane & 15, fq = lane >> 4;
    const int K = g.K, nt = K / BK;
    unsigned voffA[2], voffB[2];
#pragma unroll
    for (int i = 0; i < 2; ++i) { int R, C; stage_rc(tid * 16 + i * 8192, R, C); const int Rb = Epi::PERM ? ((R & ~31) + perm32(R & 31)) : R;
        voffA[i] = (unsigned)(R * g.lda + C) * 2u; voffB[i] = (unsigned)(Rb * g.ldb + C) * 2u; }
    const size_t kstep = (size_t)(BK * 2);
    const size_t hsA = (size_t)HALF * g.lda * 2, hsB = (size_t)HALF * g.ldb * 2;
    const size_t tsA = 2 * hsA, tsB = 2 * hsB;
    const unsigned ldsw = (unsigned)wid * 1024u;
    const int aoff = lds_byte(wr * 64 + fr, fq * 8), boff = lds_byte(wc * 32 + fr, fq * 8);
#define PG8_SA(b, h) (((b) * 2 + (h)) * HTB)
#define PG8_SB(b, h) ((4 + (b) * 2 + (h)) * HTB)
#define PG8_STAGE(bufoff, gbase, voff) do { _Pragma("unroll") for (int _i = 0; _i < 2; ++_i) \
        __builtin_amdgcn_global_load_lds((const unsigned*)((const char*)(gbase) + (voff)[_i]), (LAS unsigned*)(lds + (bufoff) + ldsw + _i * 8192), 16, 0, 0); } while (0)
#define PG8_LDA(dst, b, h) do { _Pragma("unroll") for (int m = 0; m < 4; ++m) _Pragma("unroll") for (int k = 0; k < 2; ++k) dst[m][k] = *(const LAS bf16x8*)(lds + PG8_SA(b, h) + aoff + m * 2048 + k * 1024); } while (0)
#define PG8_LDB(dst, b, h) do { _Pragma("unroll") for (int n = 0; n < 2; ++n) _Pragma("unroll") for (int k = 0; k < 2; ++k) dst[n][k] = *(const LAS bf16x8*)(lds + PG8_SB(b, h) + boff + n * 2048 + k * 1024); } while (0)
#define PG8_MMA(ai, bj, At, Bt) do { __builtin_amdgcn_s_setprio(1); _Pragma("unroll") for (int m = 0; m < 4; ++m) _Pragma("unroll") for (int n = 0; n < 2; ++n) _Pragma("unroll") for (int k = 0; k < 2; ++k) \
        acc[ai][bj][m][n] = __builtin_amdgcn_mfma_f32_16x16x32_bf16(Bt[n][k], At[m][k], acc[ai][bj][m][n], 0, 0, 0); __builtin_amdgcn_s_setprio(0); } while (0)
#define PG8_WAIT_V(n) asm volatile("s_waitcnt vmcnt(" #n ")" ::: "memory")
#define PG8_WAIT_L(n) asm volatile("s_waitcnt lgkmcnt(" #n ")" ::: "memory")
#define PG8_BAR __builtin_amdgcn_s_barrier()
#define PG8_SCHED __builtin_amdgcn_sched_barrier(0)
    Unit cur, nxt; int ui = 0;
    if (!S.next(0, cur)) return;
    f32x4 acc[2][2][4][2];
#pragma unroll
    for (int a = 0; a < 2; ++a)
#pragma unroll
        for (int b = 0; b < 2; ++b)
#pragma unroll
            for (int m = 0; m < 4; ++m)
#pragma unroll
                for (int n = 0; n < 2; ++n) acc[a][b][m][n] = (f32x4){0.f, 0.f, 0.f, 0.f};
    bf16x8 At[4][2], B0[2][2], B1[2][2];
    const char* cA = (const char*)g.A + (size_t)cur.pm * tsA; const char* cB = (const char*)g.Bt + (size_t)cur.bt * tsB;
    PG8_STAGE(PG8_SB(0, 0), cB, voffB); PG8_STAGE(PG8_SB(0, 1), cB + hsB, voffB); PG8_STAGE(PG8_SA(0, 0), cA, voffA); PG8_STAGE(PG8_SA(0, 1), cA + hsA, voffA);
    if (wr == 1) PG8_BAR;
    PG8_WAIT_V(2); PG8_BAR;
    PG8_STAGE(PG8_SB(1, 0), cB + kstep, voffB); PG8_STAGE(PG8_SA(1, 0), cA + kstep, voffA); PG8_STAGE(PG8_SB(1, 1), cB + hsB + kstep, voffB);
    PG8_WAIT_V(6); PG8_BAR;
    for (;;) {
        const bool has_next = S.next(ui + 1, nxt);
        const char* nA = has_next ? (const char*)g.A + (size_t)nxt.pm * tsA : cA; const char* nB = has_next ? (const char*)g.Bt + (size_t)nxt.bt * tsB : cB;
        for (int t = 0; t < nt; t += 2) {
            const bool last = (t == nt - 2);
            const char* a1 = cA + (size_t)(t + 1) * kstep;
            const char* a2 = last ? nA : cA + (size_t)(t + 2) * kstep; const char* b2 = last ? nB : cB + (size_t)(t + 2) * kstep;
            const char* a3 = a2 + kstep; const char* b3 = b2 + kstep;
            PG8_LDB(B0, 0, 0); PG8_LDB(B1, 0, 1); PG8_SCHED; PG8_LDA(At, 0, 0); PG8_STAGE(PG8_SA(1, 1), a1 + hsA, voffA);
            PG8_WAIT_V(8); PG8_WAIT_L(0); PG8_BAR; PG8_MMA(0, 0, At, B0); PG8_MMA(0, 1, At, B1); PG8_BAR; PG8_SCHED;
            PG8_LDA(At, 0, 1); PG8_STAGE(PG8_SB(0, 0), b2, voffB); PG8_STAGE(PG8_SB(0, 1), b2 + hsB, voffB); PG8_STAGE(PG8_SA(0, 0), a2, voffA);
            PG8_WAIT_V(8); PG8_WAIT_L(0); PG8_BAR; PG8_MMA(1, 0, At, B0); PG8_MMA(1, 1, At, B1); PG8_BAR; PG8_SCHED;
            PG8_LDB(B0, 1, 0); PG8_LDB(B1, 1, 1); PG8_SCHED; PG8_LDA(At, 1, 0); PG8_STAGE(PG8_SA(0, 1), a2 + hsA, voffA);
            PG8_WAIT_V(8); PG8_WAIT_L(0); PG8_BAR; PG8_MMA(0, 0, At, B0); PG8_MMA(0, 1, At, B1); PG8_BAR; PG8_SCHED;
            PG8_LDA(At, 1, 1); PG8_STAGE(PG8_SB(1, 0), b3, voffB); PG8_STAGE(PG8_SB(1, 1), b3 + hsB, voffB); PG8_STAGE(PG8_SA(1, 0), a3, voffA);
            PG8_WAIT_V(8); PG8_WAIT_L(0); PG8_BAR; PG8_MMA(1, 0, At, B0); PG8_MMA(1, 1, At, B1); PG8_BAR; PG8_SCHED;
        }
        if constexpr (ALIGN_EPI) { if (wr == 0) PG8_BAR; }
        E(acc, cur, wr, wc, fr, fq);
        if (!has_next) break;
#pragma unroll
        for (int a = 0; a < 2; ++a)
#pragma unroll
            for (int b = 0; b < 2; ++b)
#pragma unroll
                for (int m = 0; m < 4; ++m)
#pragma unroll
                    for (int n = 0; n < 2; ++n) acc[a][b][m][n] = (f32x4){0.f, 0.f, 0.f, 0.f};
        cur = nxt; cA = nA; cB = nB; ++ui;
        if constexpr (ALIGN_EPI) { if (wr == 1) PG8_BAR; }
    }
    PG8_WAIT_V(0);
    if constexpr (!ALIGN_EPI) { if (wr == 0) PG8_BAR; }
    PG8_BAR;
#undef PG8_SA
#undef PG8_SB
#undef PG8_STAGE
#undef PG8_LDA
#undef PG8_LDB
#undef PG8_MMA
#undef PG8_WAIT_V
#undef PG8_WAIT_L
#undef PG8_BAR
#undef PG8_SCHED
}

__device__ __forceinline__ u32x4 pack8(const f32x4 v0, const f32x4 v1) { u32x4 w; w.x = cvtpk(v0[0], v0[1]); w.y = cvtpk(v0[2], v0[3]); w.z = cvtpk(v1[0], v1[1]); w.w = cvtpk(v1[2], v1[3]); return w; }

struct EpiInProj {
    static constexpr bool PERM = true;
    bf16 *QA, *KA, *VA, *MLX, *MLO, *WQ, *WK, *WV, *GT; const f32x2* rope;
    __device__ __forceinline__ void operator()(const f32x4 (&acc)[2][2][4][2], const Unit& u, int wr, int wc, int fr, int fq) const {
        const int pn = u.pn, row0 = u.pm * BM + wr * 64 + fr, c0 = wc * 32 + 8 * fq;
        bf16* base; int W, extraB, radd0, radd1, cadd0, cadd1, mode;
        if (pn < 2)       { base = QA; W = 64; extraB = 7 * SEQ; radd0 = radd1 = (4 * pn + wc) * SEQ; cadd0 = 8 * fq; cadd1 = 32 + 8 * fq; mode = 1; }
        else if (pn < 4)  { base = KA; W = 64; extraB = 7 * SEQ; radd0 = radd1 = (4 * (pn - 2) + wc) * SEQ; cadd0 = 8 * fq; cadd1 = 32 + 8 * fq; mode = 1; }
        else if (pn < 6)  { base = VA; W = 128; extraB = 3 * SEQ; radd0 = ((pn - 4) * 2) * SEQ; radd1 = ((pn - 4) * 2 + 1) * SEQ; cadd0 = cadd1 = c0; mode = 0; }
        else if (pn < 8)  { base = MLX; W = 512; extraB = 0; radd0 = radd1 = 0; cadd0 = (pn - 6) * 256 + c0; cadd1 = cadd0 + 128; mode = 0; }
        else if (pn < 10) { base = MLO; W = 512; extraB = 0; radd0 = radd1 = 0; cadd0 = (pn - 8) * 256 + c0; cadd1 = cadd0 + 128; mode = 0; }
        else if (pn < 12) { base = WQ; W = 64; extraB = 7 * SEQ; radd0 = radd1 = (4 * (pn - 10) + wc) * SEQ; cadd0 = 8 * fq; cadd1 = 32 + 8 * fq; mode = 1; }
        else if (pn == 12) {
            if (wc < 2)   { base = WK; W = 64; extraB = SEQ; radd0 = radd1 = wc * SEQ; cadd0 = 8 * fq; cadd1 = 32 + 8 * fq; mode = 1; }
            else          { base = WV; W = 64; extraB = SEQ; radd0 = 0; radd1 = SEQ; cadd0 = cadd1 = (wc - 2) * 32 + 8 * fq; mode = 0; }
        }
        else              { base = GT; W = 3072; extraB = 0; radd0 = radd1 = 0; cadd0 = (pn - 13) * 256 + c0; cadd1 = cadd0 + 128; mode = 2; }
#pragma unroll
        for (int ai = 0; ai < 2; ++ai)
#pragma unroll
            for (int m = 0; m < 4; ++m) {
                const int row = row0 + ai * HALF + m * 16, b = row >> 13, s = row & (SEQ - 1);
                f32x4 l0 = acc[ai][0][m][0], l1 = acc[ai][0][m][1], h0 = acc[ai][1][m][0], h1 = acc[ai][1][m][1];
                if (mode == 1) {
                    const f32x4* rp = (const f32x4*)(rope + (size_t)s * 32 + 8 * fq);
                    const f32x4 r0 = rp[0], r1 = rp[1], r2 = rp[2], r3 = rp[3];
                    f32x4 nl0, nl1, nh0, nh1;
                    nl0[0] = l0[0] * r0[0] - h0[0] * r0[1]; nh0[0] = h0[0] * r0[0] + l0[0] * r0[1];
                    nl0[1] = l0[1] * r0[2] - h0[1] * r0[3]; nh0[1] = h0[1] * r0[2] + l0[1] * r0[3];
                    nl0[2] = l0[2] * r1[0] - h0[2] * r1[1]; nh0[2] = h0[2] * r1[0] + l0[2] * r1[1];
                    nl0[3] = l0[3] * r1[2] - h0[3] * r1[3]; nh0[3] = h0[3] * r1[2] + l0[3] * r1[3];
                    nl1[0] = l1[0] * r2[0] - h1[0] * r2[1]; nh1[0] = h1[0] * r2[0] + l1[0] * r2[1];
                    nl1[1] = l1[1] * r2[2] - h1[1] * r2[3]; nh1[1] = h1[1] * r2[2] + l1[1] * r2[3];
                    nl1[2] = l1[2] * r3[0] - h1[2] * r3[1]; nh1[2] = h1[2] * r3[0] + l1[2] * r3[1];
                    nl1[3] = l1[3] * r3[2] - h1[3] * r3[3]; nh1[3] = h1[3] * r3[2] + l1[3] * r3[3];
                    l0 = nl0; l1 = nl1; h0 = nh0; h1 = nh1;
                } else if (mode == 2) {
#pragma unroll
                    for (int j = 0; j < 4; ++j) { l0[j] = sigmoidf_(l0[j]); l1[j] = sigmoidf_(l1[j]); h0[j] = sigmoidf_(h0[j]); h1[j] = sigmoidf_(h1[j]); }
                }
                const size_t rb = (size_t)row + (size_t)b * extraB;
                *(u32x4*)(base + (rb + radd0) * W + cadd0) = pack8(l0, l1);
                *(u32x4*)(base + (rb + radd1) * W + cadd1) = pack8(h0, h1);
            }
    }
};

template <int PASS> struct EpiMerge {
    static constexpr bool PERM = true;
    const bf16* GT; float* MF; bf16* MB;
    __device__ __forceinline__ void operator()(const f32x4 (&acc)[2][2][4][2], const Unit& u, int wr, int wc, int fr, int fq) const {
        const int row0 = u.pm * BM + wr * 64 + fr, col0 = u.pn * BM + wc * 32 + 8 * fq;
#pragma unroll
        for (int ai = 0; ai < 2; ++ai)
#pragma unroll
            for (int m = 0; m < 4; ++m) {
                const size_t row = (size_t)(row0 + ai * HALF + m * 16);
#pragma unroll
                for (int bj = 0; bj < 2; ++bj) {
                    const int col = col0 + bj * HALF;
                    const u32x4 gw = *(const u32x4*)(GT + row * 3072 + PASS * 1024 + col);
                    f32x4 v0 = acc[ai][bj][m][0], v1 = acc[ai][bj][m][1];
                    v0[0] *= bflo(gw.x); v0[1] *= bfhi(gw.x); v0[2] *= bflo(gw.y); v0[3] *= bfhi(gw.y);
                    v1[0] *= bflo(gw.z); v1[1] *= bfhi(gw.z); v1[2] *= bflo(gw.w); v1[3] *= bfhi(gw.w);
                    float* mf = MF + row * 1024 + col;
                    if (PASS > 0) { v0 += *(const f32x4*)mf; v1 += *(const f32x4*)(mf + 4); }
                    if (PASS < 2) { *(f32x4*)mf = v0; *(f32x4*)(mf + 4) = v1; }
                    else *(u32x4*)(MB + row * 1024 + col) = pack8(v0, v1);
                }
            }
    }
};

struct EpiOut {
    static constexpr bool PERM = true;
    const float* resid; float* XF;
    __device__ __forceinline__ void operator()(const f32x4 (&acc)[2][2][4][2], const Unit& u, int wr, int wc, int fr, int fq) const {
        const int row0 = u.pm * BM + wr * 64 + fr, col0 = u.pn * BM + wc * 32 + 8 * fq;
#pragma unroll
        for (int ai = 0; ai < 2; ++ai)
#pragma unroll
            for (int m = 0; m < 4; ++m) {
                const size_t row = (size_t)(row0 + ai * HALF + m * 16);
#pragma unroll
                for (int bj = 0; bj < 2; ++bj) {
                    const size_t o = row * 1024 + col0 + bj * HALF;
                    const f32x4 r0 = *(const f32x4*)(resid + o), r1 = *(const f32x4*)(resid + o + 4);
                    *(f32x4*)(XF + o) = r0 * DN_ALPHA + acc[ai][bj][m][0];
                    *(f32x4*)(XF + o + 4) = r1 * DN_ALPHA + acc[ai][bj][m][1];
                }
            }
    }
};

struct EpiSwiglu {
    static constexpr bool PERM = true;
    const float* bgu  ; const int* tile_e; bf16* ACT;
    __device__ __forceinline__ void operator()(const f32x4 (&acc)[2][2][4][2], const Unit& u, int wr, int wc, int fr, int fq) const {
        const int e = __builtin_amdgcn_readfirstlane(tile_e[u.pm]);
        const int row0 = u.pm * BM + wr * 64 + fr, cl0 = u.pn * BM + wc * 32 + 8 * fq;
        f32x4 bv[2][2];
#pragma unroll
        for (int bj = 0; bj < 2; ++bj) { bv[bj][0] = *(const f32x4*)(bgu + (size_t)e * 2048 + cl0 + bj * HALF); bv[bj][1] = *(const f32x4*)(bgu + (size_t)e * 2048 + cl0 + bj * HALF + 4); }
#pragma unroll
        for (int ai = 0; ai < 2; ++ai)
#pragma unroll
            for (int m = 0; m < 4; ++m) {
                const size_t row = (size_t)(row0 + ai * HALF + m * 16);
#pragma unroll
                for (int bj = 0; bj < 2; ++bj) {
                    const f32x4 v0 = acc[ai][bj][m][0] + bv[bj][0], v1 = acc[ai][bj][m][1] + bv[bj][1];
                    float a[4];
                    { float g = fminf(v0[0], 7.f), up = fminf(fmaxf(v0[1], -7.f), 7.f); a[0] = g * sigmoidf_(1.702f * g) * (up + 1.f); }
                    { float g = fminf(v0[2], 7.f), up = fminf(fmaxf(v0[3], -7.f), 7.f); a[1] = g * sigmoidf_(1.702f * g) * (up + 1.f); }
                    { float g = fminf(v1[0], 7.f), up = fminf(fmaxf(v1[1], -7.f), 7.f); a[2] = g * sigmoidf_(1.702f * g) * (up + 1.f); }
                    { float g = fminf(v1[2], 7.f), up = fminf(fmaxf(v1[3], -7.f), 7.f); a[3] = g * sigmoidf_(1.702f * g) * (up + 1.f); }
                    u32x2 w; w.x = cvtpk(a[0], a[1]); w.y = cvtpk(a[2], a[3]);
                    *(u32x2*)(ACT + row * 1024 + ((cl0 + bj * HALF) >> 1)) = w;
                }
            }
    }
};

struct EpiDown {
    static constexpr bool PERM = true;
    const float* bdn  ; const int* tile_e; const float* roww; bf16* YS;
    __device__ __forceinline__ void operator()(const f32x4 (&acc)[2][2][4][2], const Unit& u, int wr, int wc, int fr, int fq) const {
        const int e = __builtin_amdgcn_readfirstlane(tile_e[u.pm]);
        const int row0 = u.pm * BM + wr * 64 + fr, cl0 = u.pn * BM + wc * 32 + 8 * fq;
        f32x4 bv[2][2];
#pragma unroll
        for (int bj = 0; bj < 2; ++bj) { bv[bj][0] = *(const f32x4*)(bdn + (size_t)e * 1024 + cl0 + bj * HALF); bv[bj][1] = *(const f32x4*)(bdn + (size_t)e * 1024 + cl0 + bj * HALF + 4); }
#pragma unroll
        for (int ai = 0; ai < 2; ++ai)
#pragma unroll
            for (int m = 0; m < 4; ++m) {
                const size_t row = (size_t)(row0 + ai * HALF + m * 16);
                const float rw = roww[row];
#pragma unroll
                for (int bj = 0; bj < 2; ++bj) {
                    const f32x4 v0 = (acc[ai][bj][m][0] + bv[bj][0]) * rw, v1 = (acc[ai][bj][m][1] + bv[bj][1]) * rw;
                    *(u32x4*)(YS + row * 1024 + cl0 + bj * HALF) = pack8(v0, v1);
                }
            }
    }
};
}

namespace att {
constexpr int QBLK = 32, KVBLK = 64;
constexpr int SHM_V = 16384, SHM_K = 8192;
constexpr int OFF_V = 0, OFF_K = 2 * SHM_V, OFF_WS = 2 * SHM_V + 2 * SHM_K;
constexpr float SCALE = 0.125f, THR = 8.f;
#define KSWZ(row, colB) ((row) * 128 + ((colB) ^ (((row) & 7) << 4)))
#define SBAR() __builtin_amdgcn_sched_barrier(0)
__device__ __forceinline__ int crow(int r, int hi) { return (r & 3) + 8 * (r >> 2) + 4 * hi; }

__device__ __forceinline__ void partialSM(f32x16& p0, f32x16& p1, float& m_reg, float& mn, float& alpha) {
    constexpr float C = SCALE * 1.4426950408889634f;
    float pmax = p0[0];
#pragma unroll
    for (int r = 1; r < 16; ++r) pmax = fmaxf(pmax, p0[r]);
#pragma unroll
    for (int r = 0; r < 16; ++r) pmax = fmaxf(pmax, p1[r]);
    { auto rr = __builtin_amdgcn_permlane32_swap(__float_as_uint(pmax), __float_as_uint(pmax), false, false);
      pmax = fmaxf(__uint_as_float(rr[0]), __uint_as_float(rr[1])); }
    if (__builtin_expect(__all(pmax - m_reg <= THR / SCALE), 1)) { mn = m_reg; alpha = 1.f; }
    else { mn = fmaxf(m_reg, pmax); alpha = __builtin_amdgcn_exp2f((m_reg - mn) * C); m_reg = mn; }
    const float mnC = -mn * C;
#pragma unroll
    for (int r = 0; r < 16; ++r) p0[r] = fmaf(p0[r], C, mnC);
#pragma unroll
    for (int r = 0; r < 16; ++r) p1[r] = fmaf(p1[r], C, mnC);
#pragma unroll
    for (int r = 0; r < 16; ++r) p0[r] = __builtin_amdgcn_exp2f(p0[r]);
}
__device__ __forceinline__ void finishSM(f32x16& p0, f32x16& p1, float alpha, float& l_reg, bf16x8& pa0, bf16x8& pa1, bf16x8& pa2, bf16x8& pa3) {
#pragma unroll
    for (int r = 0; r < 16; ++r) p1[r] = __builtin_amdgcn_exp2f(p1[r]);
    float ps = 0;
#pragma unroll
    for (int r = 0; r < 16; ++r) ps += p0[r];
#pragma unroll
    for (int r = 0; r < 16; ++r) ps += p1[r];
    { auto rr = __builtin_amdgcn_permlane32_swap(__float_as_uint(ps), __float_as_uint(ps), false, false);
      ps = __uint_as_float(rr[0]) + __uint_as_float(rr[1]); }
    l_reg = l_reg * alpha + ps;
#define PK4(P, BASE, OUT) do { unsigned a0 = cvtpk(P[BASE + 0], P[BASE + 1]), a1 = cvtpk(P[BASE + 2], P[BASE + 3]);   \
    unsigned b0 = cvtpk(P[BASE + 4], P[BASE + 5]), b1 = cvtpk(P[BASE + 6], P[BASE + 7]);                              \
    auto r0 = __builtin_amdgcn_permlane32_swap(a0, b0, false, false); auto r1 = __builtin_amdgcn_permlane32_swap(a1, b1, false, false); \
    u32x4 w = {r0[0], r1[0], r0[1], r1[1]}; OUT = *reinterpret_cast<bf16x8*>(&w); } while (0)
    PK4(p0, 0, pa0); PK4(p0, 8, pa1); PK4(p1, 0, pa2); PK4(p1, 8, pa3);
#undef PK4
}
__device__ __forceinline__ void qkt(f32x16& p0, f32x16& p1, const char* Ks, const bf16x8* qr, int r32, int hi) {
    p0 = f32x16{}; p1 = f32x16{};
#pragma unroll
    for (int d0 = 0; d0 < 4; ++d0) { const int cb = (d0 * 16 + hi * 8) * 2;
        const bf16x8 b0 = *reinterpret_cast<const bf16x8*>(Ks + KSWZ(r32, cb));
        const bf16x8 b1 = *reinterpret_cast<const bf16x8*>(Ks + KSWZ(32 + r32, cb));
        p0 = __builtin_amdgcn_mfma_f32_32x32x16_bf16(b0, qr[d0], p0, 0, 0, 0);
        p1 = __builtin_amdgcn_mfma_f32_32x32x16_bf16(b1, qr[d0], p1, 0, 0, 0); }
}
__device__ __forceinline__ int v_st(int k, int c) { const int kk = (k & ~0xC) | ((k & 4) << 1) | ((k & 8) >> 1); return ((kk >> 3) * 4 + (c >> 5)) * 512 + ((kk & 7) * 32 + (c & 31)) * 2; }
__device__ __forceinline__ int v_rd_base(int lane) { return ((lane & 3) << 3) | (((lane >> 2) & 3) << 6) | (((lane >> 4) & 1) << 5) | (((lane >> 5) & 1) << 8); }
constexpr int v_rd_off(int d0, int ks, int half) { return d0 * 512 + ks * 4096 + half * 2048; }
template <int OFF> __device__ __forceinline__ s16x4 tr_read(int vb) {
    s16x4 r; asm volatile("ds_read_b64_tr_b16 %0, %1 offset:%2" : "=&v"(r) : "v"(vb), "i"(OFF) : "memory"); return r;
}
template <int D0> __device__ __forceinline__ void pv_one(f32x16& od, int vb, bf16x8 pa0, bf16x8 pa1, bf16x8 pa2, bf16x8 pa3) {
    const s16x4 l0 = tr_read<v_rd_off(D0, 0, 0)>(vb), h0 = tr_read<v_rd_off(D0, 0, 1)>(vb), l1 = tr_read<v_rd_off(D0, 1, 0)>(vb), h1 = tr_read<v_rd_off(D0, 1, 1)>(vb);
    const s16x4 l2 = tr_read<v_rd_off(D0, 2, 0)>(vb), h2 = tr_read<v_rd_off(D0, 2, 1)>(vb), l3 = tr_read<v_rd_off(D0, 3, 0)>(vb), h3 = tr_read<v_rd_off(D0, 3, 1)>(vb);
    asm volatile("s_waitcnt lgkmcnt(0)" ::: "memory"); SBAR();
#define PK(L, H) (bf16x8){L[0], L[1], L[2], L[3], H[0], H[1], H[2], H[3]}
    od = __builtin_amdgcn_mfma_f32_32x32x16_bf16(pa0, PK(l0, h0), od, 0, 0, 0);
    od = __builtin_amdgcn_mfma_f32_32x32x16_bf16(pa1, PK(l1, h1), od, 0, 0, 0);
    od = __builtin_amdgcn_mfma_f32_32x32x16_bf16(pa2, PK(l2, h2), od, 0, 0, 0);
    od = __builtin_amdgcn_mfma_f32_32x32x16_bf16(pa3, PK(l3, h3), od, 0, 0, 0);
#undef PK
}
template <int NB> __device__ __forceinline__ void pv_all(f32x16* o, int vb, bf16x8 pa0, bf16x8 pa1, bf16x8 pa2, bf16x8 pa3) {
    pv_one<0>(o[0], vb, pa0, pa1, pa2, pa3); pv_one<1>(o[1], vb, pa0, pa1, pa2, pa3);
    if constexpr (NB == 4) { pv_one<2>(o[2], vb, pa0, pa1, pa2, pa3); pv_one<3>(o[3], vb, pa0, pa1, pa2, pa3); }
}
__device__ __forceinline__ void bandmask(f32x16& p0, f32x16& p1, int kt0, int qw0, int r32, int hi) {
    if ((kt0 + 63 - qw0 <= 128) && (qw0 + 31 - kt0 <= 128)) return;
    const int qi = qw0 + r32;
#pragma unroll
    for (int r = 0; r < 16; ++r) { const int d = kt0 + crow(r, hi) - qi;
        if (d > 128 || d < -128) p0[r] = -INFINITY;
        if (d + 32 > 128 || d + 32 < -128) p1[r] = -INFINITY; }
}

template <int NB, bool WIN>
__device__ __forceinline__ void body(const bf16* __restrict__ Qb, const bf16* __restrict__ Kh, const bf16* __restrict__ Vh, int NT,
                                     int kpos0, int qpos0, float sink_l2, f32x16 (&o)[NB], char* lds) {
    constexpr int DV = 32 * NB;
    int tid = threadIdx.x; asm volatile("" : "+v"(tid));
    const int wid = tid >> 6, lane = tid & 63, r32 = lane & 31, hi = lane >> 5;
    char* V_lds = lds + OFF_V; char* K_lds = lds + OFF_K;
    float* ws = (float*)(lds + OFF_WS) + wid * 64; float* li_l = ws; float* al_l = ws + 32;
    float m_reg = -1e30f, l_reg = 0; bf16x8 qr[4];
#pragma unroll
    for (int d = 0; d < NB; ++d) o[d] = f32x16{};
    const bf16* Qw = Qb + (long)(wid * QBLK + r32) * 64 + hi * 8;
#pragma unroll
    for (int d0 = 0; d0 < 4; ++d0) qr[d0] = *reinterpret_cast<const bf16x8*>(Qw + d0 * 16);
    const int qw0 = qpos0 + wid * QBLK;
    const int ksr = tid >> 3, ksc = (tid & 7) * 8;
    const int kst = KSWZ(ksr, ksc * 2);
    const int vsr = (NB == 4) ? (tid >> 4) : (tid >> 3), vsc = (NB == 4) ? (tid & 15) * 8 : (tid & 7) * 8;
    const int vst0 = v_st(vsr, vsc), vst1 = v_st(32 + vsr, vsc);
    const int vb0 = (int)(uintptr_t)V_lds + v_rd_base(lane);
    struct { bf16x8 vs0, vs1, ks0; } sr_[2];
    unsigned vo0 = (unsigned)(vsr * DV + vsc) * 2u, ko0 = (unsigned)(ksr * 64 + ksc) * 2u;
    asm volatile("" : "+v"(vo0), "+v"(ko0));
#define SLOAD(i, k0) do { const char* vt_ = (const char*)Vh + (size_t)(k0) * (DV * 2); const char* kt_ = (const char*)Kh + (size_t)(k0) * 128; \
    sr_[i].vs0 = *reinterpret_cast<const bf16x8*>(vt_ + vo0); \
    if constexpr (NB == 4) sr_[i].vs1 = *reinterpret_cast<const bf16x8*>(vt_ + 32 * DV * 2 + vo0); \
    sr_[i].ks0 = *reinterpret_cast<const bf16x8*>(kt_ + ko0); } while (0)
#define SWRITE(b, i) do { *(bf16x8*)(V_lds + (b) * SHM_V + vst0) = sr_[i].vs0; \
    if constexpr (NB == 4) *(bf16x8*)(V_lds + (b) * SHM_V + vst1) = sr_[i].vs1; \
    *(bf16x8*)(K_lds + (b) * SHM_K + kst) = sr_[i].ks0; } while (0)
#define SWAIT() do { if constexpr (NB == 4) asm volatile("s_waitcnt vmcnt(3)" ::: "memory"); else asm volatile("s_waitcnt vmcnt(2)" ::: "memory"); } while (0)
#define RESC(a) do { if (__any((a) < 1.f)) { if (hi == 0) al_l[r32] = (a); asm volatile("s_waitcnt lgkmcnt(0)" ::: "memory"); \
    _Pragma("unroll") for (int d = 0; d < NB; ++d) _Pragma("unroll") for (int r = 0; r < 16; ++r) o[d][r] *= al_l[crow(r, hi)]; } } while (0)
#define MASK(P0, P1, t) do { if constexpr (WIN) bandmask(P0, P1, kpos0 + (t) * KVBLK, qw0, r32, hi); } while (0)
    f32x16 pA0, pA1, pB0, pB1; float mnA, mnB, alA, alB; bf16x8 pa0, pa1, pa2, pa3;
    constexpr int SE = 0, SO = 1;
    __syncthreads();
    SLOAD(SE, 0); asm volatile("s_waitcnt vmcnt(0)" ::: "memory"); SWRITE(0, SE); __syncthreads();
    qkt(pA0, pA1, K_lds, qr, r32, hi); MASK(pA0, pA1, 0); partialSM(pA0, pA1, m_reg, mnA, alA);
    SLOAD(SO, KVBLK); if (2 < NT) SLOAD(SE, 2 * KVBLK);
    SWAIT(); SWRITE(1, SO); __syncthreads();
    for (int j = 1; j + 1 < NT; j += 2) {
        SBAR(); qkt(pB0, pB1, K_lds + SHM_K, qr, r32, hi); MASK(pB0, pB1, j);
        finishSM(pA0, pA1, alA, l_reg, pa0, pa1, pa2, pa3); SBAR();
        SLOAD(SO, (j + 2) * KVBLK); SBAR();
        pv_all<NB>(o, vb0, pa0, pa1, pa2, pa3); partialSM(pB0, pB1, m_reg, mnB, alB);
        __syncthreads(); SWAIT(); SWRITE(0, SE);
        RESC(alB); __syncthreads();
        SBAR(); qkt(pA0, pA1, K_lds, qr, r32, hi); MASK(pA0, pA1, j + 1);
        finishSM(pB0, pB1, alB, l_reg, pa0, pa1, pa2, pa3); SBAR();
        if (j + 3 < NT) SLOAD(SE, (j + 3) * KVBLK); SBAR();
        pv_all<NB>(o, vb0 + SHM_V, pa0, pa1, pa2, pa3); partialSM(pA0, pA1, m_reg, mnA, alA);
        __syncthreads(); SWAIT(); SWRITE(1, SO);
        RESC(alA); __syncthreads();
    }
    SBAR(); qkt(pB0, pB1, K_lds + SHM_K, qr, r32, hi); MASK(pB0, pB1, NT - 1);
    finishSM(pA0, pA1, alA, l_reg, pa0, pa1, pa2, pa3); SBAR();
    pv_all<NB>(o, vb0, pa0, pa1, pa2, pa3); partialSM(pB0, pB1, m_reg, mnB, alB);
    __syncthreads(); RESC(alB);
    finishSM(pB0, pB1, alB, l_reg, pa0, pa1, pa2, pa3); SBAR();
    pv_all<NB>(o, vb0 + SHM_V, pa0, pa1, pa2, pa3);
    if constexpr (WIN) l_reg += __builtin_amdgcn_exp2f(sink_l2 - m_reg * (SCALE * 1.4426950408889634f));
    if (hi == 0) li_l[r32] = l_reg; asm volatile("s_waitcnt lgkmcnt(0)" ::: "memory");
#pragma unroll
    for (int r = 0; r < 16; ++r) { const float rl = __builtin_amdgcn_rcpf(li_l[crow(r, hi)]);
#pragma unroll
        for (int d = 0; d < NB; ++d) o[d][r] *= rl; }
#undef SLOAD
#undef SWRITE
#undef SWAIT
#undef RESC
#undef MASK
}
}

#define XB_TMO      128
#define XB_XCNT(j)  (256  + 64 * (j))
#define XB_XSUB(j)  (1280 + 64 * (j))
#define XB_XGEN(j)  (2304 + 64 * (j))
#define XB_TOP      3328
#define XB_TOPGEN   3392
#define XCD_BAR_WORDS 3456
#define XB_SPIN_CAP (1u << 22)
__device__ __forceinline__ unsigned xb_ld(unsigned* p)              { return __hip_atomic_load(p, __ATOMIC_RELAXED, __HIP_MEMORY_SCOPE_AGENT); }
__device__ __forceinline__ unsigned xb_add(unsigned* p, unsigned v) { return __hip_atomic_fetch_add(p, v, __ATOMIC_RELAXED, __HIP_MEMORY_SCOPE_AGENT); }
__device__ __forceinline__ unsigned xb_xcc_id() { return (unsigned)__builtin_amdgcn_s_getreg((3 << 11) | 20) & 0xFu; }
#define XB_SPIN(cond, bar) do { unsigned _sp = 0; while (cond) { __builtin_amdgcn_s_sleep(1); \
    if ((++_sp & 255u) == 0u) { if (xb_ld(&(bar)[XB_TMO])) break; if (_sp > XB_SPIN_CAP) { atomicAdd(&(bar)[XB_TMO], 1u); break; } } } } while (0)
struct XcdBarrier { unsigned* bar; unsigned x; volatile LAS unsigned* st; };
__device__ __forceinline__ XcdBarrier xcd_barrier_post(unsigned* bar, volatile LAS unsigned* st) {
    XcdBarrier b; b.bar = bar; b.x = xb_xcc_id(); b.st = st;
    if (threadIdx.x == 0) (void)xb_add(&bar[XB_XCNT(b.x)], 1u);
    return b;
}
__device__ __forceinline__ void xcd_barrier_complete(unsigned* bar, unsigned x, unsigned& nloc, unsigned& nx) {
    const unsigned G = gridDim.x * gridDim.y * gridDim.z;
    unsigned sum, cnt, mine, sp = 0u;
    for (;;) {
        sum = 0u; cnt = 0u; mine = 0u;
#pragma unroll
        for (unsigned j = 0; j < 16; ++j) { const unsigned c = xb_ld(&bar[XB_XCNT(j)]); sum += c; cnt += (c > 0u) ? 1u : 0u; mine = (j == x) ? c : mine; }
        if (sum == G) break;
        __builtin_amdgcn_s_sleep(1);
        if ((++sp & 255u) == 0u) { if (xb_ld(&bar[XB_TMO])) break; if (sp > XB_SPIN_CAP) { atomicAdd(&bar[XB_TMO], 1u); break; } }
    }
    nloc = mine > 0u ? mine : 1u; nx = cnt > 0u ? cnt : 1u;
}
__device__ __forceinline__ void xcd_barrier(unsigned* bar_in, volatile LAS unsigned* st) {
    asm volatile("s_waitcnt vmcnt(0)" ::: "memory");
    __syncthreads();
    if (threadIdx.x == 0) {
        GAS unsigned* barg_ = (GAS unsigned*)bar_in; asm volatile("" : "+s"(barg_)); unsigned* bar = (unsigned*)barg_;
        const unsigned bx_ = xb_xcc_id();
        __builtin_amdgcn_s_waitcnt(0);
        unsigned nloc = st[0], nx = st[1];
        if (nloc == 0u) { xcd_barrier_complete(bar, bx_, nloc, nx); st[0] = nloc; st[1] = nx; }
        const unsigned old = xb_add(&bar[XB_XSUB(bx_)], 1u);
        const unsigned gen = old / nloc;
        if (old + 1u == (gen + 1u) * nloc) {
            __builtin_amdgcn_fence(__ATOMIC_RELEASE, "agent");
            asm volatile("s_waitcnt vmcnt(0)" ::: "memory");
            const unsigned og = xb_add(&bar[XB_TOP], 1u);
            const unsigned tg = og / nx;
            if (og + 1u == (tg + 1u) * nx) xb_add(&bar[XB_TOPGEN], 1u);
            else XB_SPIN(xb_ld(&bar[XB_TOPGEN]) == tg, bar);
            __builtin_amdgcn_fence(__ATOMIC_ACQUIRE, "agent");
            xb_add(&bar[XB_XGEN(bx_)], 1u);
            asm volatile("s_waitcnt vmcnt(0)" ::: "memory");
        } else {
            XB_SPIN(xb_ld(&bar[XB_XGEN(bx_)]) == gen, bar);
            __builtin_amdgcn_fence(__ATOMIC_ACQUIRE, "agent");
            asm volatile("s_waitcnt vmcnt(0)" ::: "memory");
        }
    }
    __syncthreads();
}

struct Args {
    const float* in[28]; float* out; unsigned char* ws;
    float lam_init[4];
    int lay_lo, lay_hi, ph_lo, ph_hi;
    int single, pad;
};
enum { I_X = 0, I_WIN, I_LAMBDA, I_SUBLN, I_WPA, I_CONVW, I_CONVB, I_MLWQ, I_MLWK, I_MLWV, I_MLWG, I_MLBG, I_MLNORM, I_MLSKIP, I_WPB, I_SINKS, I_WPC, I_WOUT,
       I_LN1G, I_LN1B, I_RW, I_RB, I_WGU, I_BGU, I_WDN, I_BDN, I_LN2G, I_LN2B };

__device__ __forceinline__ void transpose_item(const float* W, int K, int N, bf16* WT, int k0, int n0, int c0, LAS float* scr, int lane) {
#pragma unroll 8
    for (int i = 0; i < 32; ++i) { const int kk = 2 * i + (lane >> 5); scr[kk * 33 + (lane & 31)] = W[(size_t)(k0 + kk) * N + c0 + (lane & 31)]; }
    LDS_WAIT(); asm volatile("" ::: "memory");
    const int c = lane & 7;
#pragma unroll
    for (int j = 0; j < 4; ++j) { const int n = (lane >> 3) + 8 * j; const LAS float* s = scr + (8 * c) * 33 + n;
        u32x4 o; o.x = cvtpk(s[0 * 33], s[1 * 33]); o.y = cvtpk(s[2 * 33], s[3 * 33]); o.z = cvtpk(s[4 * 33], s[5 * 33]); o.w = cvtpk(s[6 * 33], s[7 * 33]);
        *(u32x4*)(WT + (size_t)(n0 + n) * K + k0 + 8 * c) = o; }
    LDS_WAIT(); asm volatile("" ::: "memory");
}
__device__ __forceinline__ int inproj_src_col32(int n0) {
    const int tile = n0 >> 8, nt = n0 & 255;
    if (tile <= 3 || tile == 10 || tile == 11) { const int half = nt >> 7, hd = (nt & 127) >> 5; return tile * 256 + hd * 64 + half * 32; }
    if (tile == 12) { const int half = nt >> 7, q = nt & 127; if (q < 64) return WA_K_COL + (q >> 5) * 64 + half * 32; return WA_V_COL + half * 64 + (q - 64); }
    return n0;
}
__device__ __forceinline__ void sincos_acc(float ang, float& sn, float& cs) {
    const double x = (double)ang;
    const double kq = rint(x * 0.63661977236758134308);
    const double r = fma(-kq, 1.57079632679489661923, x);
    const float rf = (float)r, z = rf * rf;
    const float sp = rf + rf * z * (-1.6666654611e-1f + z * (8.3321608736e-3f + z * (-1.9515295891e-4f)));
    const float cp = 1.0f - 0.5f * z + z * z * (4.166664568298827e-2f + z * (-1.388731625493765e-3f + z * 2.443315711809948e-5f));
    const int q = ((int)kq) & 3;
    sn = (q == 0) ? sp : (q == 1) ? cp : (q == 2) ? -sp : -cp;
    cs = (q == 0) ? cp : (q == 1) ? -sp : (q == 2) ? -cp : sp;
}

constexpr int LDT = 136;
constexpr int TILE_B = 128 * LDT * 2;
__device__ __forceinline__ void wave_mm(f32x4 (&acc)[8], const LAS bf16* A, const LAS bf16* Bt, int lane) {
    const int fr = lane & 15, fq = lane >> 4;
#pragma unroll
    for (int j = 0; j < 8; ++j) acc[j] = (f32x4){0.f, 0.f, 0.f, 0.f};
#pragma unroll
    for (int k0 = 0; k0 < 128; k0 += 32) {
        const bf16x8 a = *(const LAS bf16x8*)(A + fr * LDT + k0 + fq * 8);
#pragma unroll
        for (int j = 0; j < 8; ++j) { const bf16x8 b = *(const LAS bf16x8*)(Bt + (j * 16 + fr) * LDT + k0 + fq * 8);
            acc[j] = __builtin_amdgcn_mfma_f32_16x16x32_bf16(a, b, acc[j], 0, 0, 0); }
    }
}
__device__ __forceinline__ void stage_rows(LAS bf16* dst, const bf16* src, int gs, int tid) {
#pragma unroll
    for (int i = 0; i < 4; ++i) { const int q = tid + 512 * i, r = q >> 4, c = (q & 15) * 8;
        *(LAS u32x4*)(dst + r * LDT + c) = *(const u32x4*)(src + (size_t)r * gs + c); }
}
template <bool SCALED> __device__ __forceinline__ void stage_tr(LAS bf16* dst, const bf16* src, int gs, const LAS float* rscale, int tid) {
#pragma unroll
    for (int i = 0; i < 4; ++i) { const int q = tid + 512 * i, r = q >> 4, c = (q & 15) * 8;
        const u32x4 w = *(const u32x4*)(src + (size_t)r * gs + c);
        const unsigned ww[4] = {w.x, w.y, w.z, w.w};
        const float sc = SCALED ? rscale[r] : 1.f;
#pragma unroll
        for (int j = 0; j < 4; ++j) {
            if (SCALED) { dst[(c + 2 * j) * LDT + r] = tobf1(bflo(ww[j]) * sc); dst[(c + 2 * j + 1) * LDT + r] = tobf1(bfhi(ww[j]) * sc); }
            else { dst[(c + 2 * j) * LDT + r] = (bf16)(ww[j] & 0xffffu); dst[(c + 2 * j + 1) * LDT + r] = (bf16)(ww[j] >> 16); } }
    }
}
__device__ __forceinline__ float logsigmoidf_(float x) { return fminf(x, 0.f) - log1pf(__expf(-fabsf(x))); }
template <bool WITH_MAX> __device__ __forceinline__ void scan_dir(const LAS float* ls, const LAS float* ig, LAS float* bcum, LAS float* pmx, int dir, int lane) {
    const int n0 = dir ? 127 - 2 * lane : 2 * lane, n1 = dir ? 126 - 2 * lane : 2 * lane + 1;
    const float x0 = ls[n0], x1 = ls[n1], s = x0 + x1; float inc = s;
#pragma unroll
    for (int off = 1; off < 64; off <<= 1) { const float t = __shfl_up(inc, off); if (lane >= off) inc += t; }
    const float ex = inc - s, b0 = ex + x0, b1 = b0 + x1;
    bcum[n0] = b0; bcum[n1] = b1;
    if (WITH_MAX) {
        const float d0 = ig[n0] - b0, d1 = ig[n1] - b1; float minc = fmaxf(d0, d1);
#pragma unroll
        for (int off = 1; off < 64; off <<= 1) { const float t = __shfl_up(minc, off); if (lane >= off) minc = fmaxf(minc, t); }
        float mex = __shfl_up(minc, 1); if (lane == 0) mex = -INFINITY;
        pmx[n0] = fmaxf(mex, d0); pmx[n1] = fmaxf(fmaxf(mex, d0), d1);
    }
}

enum { PH_INPROJ = 1, PH_CONV, PH_MLQKV, PH_MLGATES, PH_MLLOC, PH_MLSCAN, PH_MLOUT, PH_DIFF, PH_WIN, PH_MERGE0, PH_MERGE1, PH_MERGE2, PH_OUT, PH_LN1, PH_SORT, PH_GU, PH_DOWN, PH_LN2, PH_END };

__global__ void __launch_bounds__(NTHR, 2) mega(Args args) {
    extern __shared__ __attribute__((aligned(16))) unsigned char lds_raw[];
    LAS unsigned char* lds = (LAS unsigned char*)lds_raw;
    volatile LAS unsigned* CTLW = (volatile LAS unsigned*)(lds + PH_LDS);
    const int tid0 = threadIdx.x;
    const int G = gridDim.x, bx = blockIdx.x;
#define PH_LOCALS int tid = tid0; asm volatile("" : "+v"(tid)); GAS unsigned char* wsg_ = (GAS unsigned char*)args.ws; asm volatile("" : "+s"(wsg_)); unsigned char* ws = (unsigned char*)wsg_; const int lane = tid & 63; const int wave = __builtin_amdgcn_readfirstlane(tid >> 6); \
    const int gw = vcu * NWAVES + wave, NGW = G * NWAVES, gt = vcu * NTHR + tid, NGT = G * NTHR; (void)lane; (void)gw; (void)NGW; (void)gt; (void)NGT;
    const int vcu = (bx % 8) * (G / 8) + bx / 8;
    for (int u = tid0; u < 64; u += NTHR) CTLW[u] = 0u;
    __syncthreads();
    if (args.single) (void)xcd_barrier_post((unsigned*)(args.ws + OFF_CTL) + 4096, CTLW + 8);
#define SEAM() do { if (args.single) xcd_barrier((unsigned*)(args.ws + OFF_CTL) + 4096, CTLW + 8); } while (0)

#define WIN_T ((bf16*)((bf16*)(ws + OFF_WIN)))
#define WP_T ((bf16*)((bf16*)(ws + OFF_WP)))
#define WOUT_T ((bf16*)((bf16*)(ws + OFF_WOUT)))
#define WGU_T ((bf16*)((bf16*)(ws + OFF_WGU)))
#define WDN_T ((bf16*)((bf16*)(ws + OFF_WDN)))
#define WML_T ((bf16*)((bf16*)(ws + OFF_WML)))
#define ROPE ((f32x2*)((f32x2*)(ws + OFF_ROPE)))
#define XB ((bf16*)((bf16*)(ws + OFF_XB)))
#define XF ((float*)((float*)(ws + OFF_XF)))
#define QA ((bf16*)((bf16*)(ws + OFF_QA)))
#define KA ((bf16*)((bf16*)(ws + OFF_KA)))
#define VA ((bf16*)((bf16*)(ws + OFF_VA)))
#define MLX ((bf16*)((bf16*)(ws + OFF_MLX)))
#define MLO ((bf16*)((bf16*)(ws + OFF_MLO)))
#define XC ((bf16*)((bf16*)(ws + OFF_XC)))
#define WQb ((bf16*)((bf16*)(ws + OFF_WQ)))
#define WKb ((bf16*)((bf16*)(ws + OFF_WK)))
#define WVb ((bf16*)((bf16*)(ws + OFF_WV)))
#define GT ((bf16*)((bf16*)(ws + OFF_GT)))
#define YA ((bf16*)((bf16*)(ws + OFF_Y3)))
#define YB ((bf16*)(YA + (size_t)TOK * 512))
#define YC ((bf16*)(YB + (size_t)TOK * 512))
#define MF ((float*)((float*)(ws + OFF_MF)))
#define MB ((bf16*)((bf16*)(ws + OFF_MB)))
#define MQ ((bf16*)((bf16*)(ws + OFF_MQ)))
#define MK ((bf16*)(MQ + (size_t)TOK * 512))
#define MV ((bf16*)(MK + (size_t)TOK * 512))
#define G4 ((float*)((float*)(ws + OFF_G4)))
#define CLOC ((float*)((float*)(ws + OFF_CLOC)))
#define CPT ((bf16*)((bf16*)(ws + OFF_CPT)))
#define NLOC ((float*)((float*)(ws + OFF_NLOC)))
#define NPREV ((float*)((float*)(ws + OFF_NPREV)))
#define MLOC ((float*)((float*)(ws + OFF_MLOC)))
#define GCH ((float*)((float*)(ws + OFF_GCH)))
#define MPREV ((float*)((float*)(ws + OFF_MPREV)))
#define STASH ((float*)((float*)(ws + OFF_STASH)))
#define BLKCNT ((int*)((int*)(ws + OFF_BLKCNT)))
#define TILEE ((int*)((int*)(ws + OFF_TILEE)))
#define ROWW ((float*)((float*)(ws + OFF_ROWW)))
#define TOKE ((int*)((int*)(ws + OFF_TOKE)))
#define TOKW ((float*)((float*)(ws + OFF_TOKW)))
#define TOKLP ((int*)((int*)(ws + OFF_TOKLP)))
#define TOKROW ((int*)((int*)(ws + OFF_TOKROW)))
#define XG ((bf16*)((bf16*)(ws + OFF_XG)))
#define ACT ((bf16*)((bf16*)(ws + OFF_ACT)))
#define YS ((bf16*)((bf16*)(ws + OFF_YS)))
    if ((PHASE_MASK & 1ull) && args.lay_lo < 0) {
        PH_LOCALS
        LAS float* scr = (LAS float*)(lds + wave * 16384);
        constexpr int I_IN = 16 * 200, I_P = 8 * 32, I_O = 16 * 32, I_GU = 16 * 64, I_DN = 16 * 32, I_ML = 2 * 4;
        constexpr int N0 = DEPTH * I_IN, N1 = N0 + 3 * DEPTH * I_P, N2 = N1 + DEPTH * I_O, N3 = N2 + DEPTH * NEXP * I_GU, N4 = N3 + DEPTH * NEXP * I_DN, N5 = N4 + 3 * 16 * I_ML;
        for (int it = gw; it < N5; it += NGW) {
            if (it < N0) { const int l = it / I_IN, r = it % I_IN, kb = r / 200, nb = r % 200;
                transpose_item(args.in[I_WIN] + (size_t)l * DM * DIN, DM, DIN, WIN_T + (size_t)l * DIN * DM, 64 * kb, 32 * nb, inproj_src_col32(32 * nb), scr, lane); }
            else if (it < N1) { const int q = it - N0, br = q / (DEPTH * I_P), r2 = q % (DEPTH * I_P), l = r2 / I_P, r = r2 % I_P, kb = r / 32, nb = r % 32;
                const float* src = (br == 0 ? args.in[I_WPA] : br == 1 ? args.in[I_WPB] : args.in[I_WPC]) + (size_t)l * 512 * DM;
                transpose_item(src, 512, DM, WP_T + ((size_t)l * 3 + br) * DM * 512, 64 * kb, 32 * nb, 32 * nb, scr, lane); }
            else if (it < N2) { const int q = it - N1, l = q / I_O, r = q % I_O, kb = r / 32, nb = r % 32;
                transpose_item(args.in[I_WOUT] + (size_t)l * DM * DM, DM, DM, WOUT_T + (size_t)l * DM * DM, 64 * kb, 32 * nb, 32 * nb, scr, lane); }
            else if (it < N3) { const int q = it - N2, mt = q / I_GU, r = q % I_GU, kb = r / 64, nb = r % 64;
                transpose_item(args.in[I_WGU] + (size_t)mt * DM * 2048, DM, 2048, WGU_T + (size_t)mt * 2048 * DM, 64 * kb, 32 * nb, 32 * nb, scr, lane); }
            else if (it < N4) { const int q = it - N3, mt = q / I_DN, r = q % I_DN, kb = r / 32, nb = r % 32;
                transpose_item(args.in[I_WDN] + (size_t)mt * DFF * DM, DFF, DM, WDN_T + (size_t)mt * DM * DFF, 64 * kb, 32 * nb, 32 * nb, scr, lane); }
            else { const int q = it - N4, which = q / (16 * I_ML), r2 = q % (16 * I_ML), lh = r2 / I_ML, r = r2 % I_ML, kb = r / 4, nb = r % 4;
                const float* src = (which == 0 ? args.in[I_MLWQ] : which == 1 ? args.in[I_MLWK] : args.in[I_MLWV]) + (size_t)lh * 128 * 128;
                const int l = lh >> 2, h = lh & 3;
                transpose_item(src, 128, 128, WML_T + (((size_t)l * 3 + which) * 4 + h) * 128 * 128, 64 * kb, 32 * nb, 32 * nb, scr, lane); }
        }
        for (size_t i = gt; i < (size_t)TOK * DM / 8; i += NGT) {
            const f32x4 a = *(const f32x4*)(args.in[I_X] + i * 8), b = *(const f32x4*)(args.in[I_X] + i * 8 + 4);
            *(u32x4*)(XB + i * 8) = pg8::pack8(a, b);
        }
        for (int i = gt; i < SEQ * 32; i += NGT) {
            const int s = i >> 5, j = i & 31;
            const float inv = exp2f(-(float)(2 * j) * (13.287712379549449f / 64.0f));
            const float ang = (float)s * inv; float sn, cs; sincos_acc(ang, sn, cs);
            ROPE[i] = (f32x2){cs, sn};
        }
        SEAM();
    }

    for (int l = (args.lay_lo < 0 ? 0 : args.lay_lo); l < args.lay_hi; ++l) {
        const int plo = args.ph_lo, phi = args.ph_hi;
#define IN(k) (((PHASE_MASK >> (k)) & 1ull) && plo <= (k) && (k) < phi)
        if (IN(PH_INPROJ)) {
            PH_LOCALS
            pg8::Gemm g{XB, WIN_T + (size_t)l * DIN * DM, DM, DM, DM};
            pg8::StaticOrder S; S.init(TOK / 256, DIN / 256, G, bx, nullptr);
            pg8::EpiInProj E{QA, KA, VA, MLX, MLO, WQb, WKb, WVb, GT, ROPE};
            pg8::gemm_phase<pg8::EpiInProj, true>(lds, g, S, E);
            SEAM();
        }
        if (IN(PH_CONV)) {
            PH_LOCALS
            const float* cw = args.in[I_CONVW] + (size_t)l * 5 * 512; const float* cb = args.in[I_CONVB] + (size_t)l * 512;
            for (int i = gt; i < TOK * 64; i += NGT) {
                const int t = i >> 6, c = (i & 63) * 8, s = t & (SEQ - 1);
                float a[8];
#pragma unroll
                for (int j = 0; j < 8; ++j) a[j] = cb[c + j];
#pragma unroll
                for (int k = 0; k < 5; ++k) { const int ss = s + k - 2; if (ss < 0 || ss >= SEQ) continue;
                    const u32x4 w = *(const u32x4*)(MLX + (size_t)(t + k - 2) * 512 + c);
                    const f32x4 w0 = *(const f32x4*)(cw + k * 512 + c), w1 = *(const f32x4*)(cw + k * 512 + c + 4);
                    a[0] += bflo(w.x) * w0[0]; a[1] += bfhi(w.x) * w0[1]; a[2] += bflo(w.y) * w0[2]; a[3] += bfhi(w.y) * w0[3];
                    a[4] += bflo(w.z) * w1[0]; a[5] += bfhi(w.z) * w1[1]; a[6] += bflo(w.w) * w1[2]; a[7] += bfhi(w.w) * w1[3]; }
#pragma unroll
                for (int j = 0; j < 8; ++j) a[j] = a[j] * sigmoidf_(a[j]);
                u32x4 o; o.x = cvtpk(a[0], a[1]); o.y = cvtpk(a[2], a[3]); o.z = cvtpk(a[4], a[5]); o.w = cvtpk(a[6], a[7]);
                *(u32x4*)(XC + (size_t)t * 512 + c) = o;
            }
            SEAM();
        }
        if (IN(PH_MLQKV)) {
            PH_LOCALS
            LAS bf16* BA1 = (LAS bf16*)lds; LAS bf16* BA2 = (LAS bf16*)(lds + TILE_B); LAS bf16* BW = (LAS bf16*)(lds + 2 * TILE_B);
            for (int u = vcu; u < 512; u += G) {
                const int tt = u >> 2, h = u & 3; const size_t t0 = (size_t)tt * 128;
                const int b = (int)(t0 >> 13), s0 = (int)(t0 & (SEQ - 1));
                __syncthreads();
                stage_rows(BA1, XC + t0 * 512 + h * 128, 512, tid);
                stage_rows(BA2, MLX + t0 * 512 + h * 128, 512, tid);
#pragma unroll
                for (int which = 0; which < 3; ++which) {
                    if (which) __syncthreads();
                    stage_rows(BW, WML_T + (((size_t)l * 3 + which) * 4 + h) * 128 * 128, 128, tid);
                    __syncthreads();
                    f32x4 acc[8];
                    wave_mm(acc, (which == 2 ? BA2 : BA1) + wave * 16 * LDT, BW, lane);
                    bf16* dst = (which == 0 ? MQ : which == 1 ? MK : MV) + ((size_t)(b * 4 + h) * SEQ + s0) * 128;
                    const int fr = lane & 15, fq = lane >> 4;
#pragma unroll
                    for (int j = 0; j < 8; ++j)
#pragma unroll
                        for (int r = 0; r < 4; ++r) dst[(size_t)(wave * 16 + 4 * fq + r) * 128 + j * 16 + fr] = tobf1(acc[j][r]);
                }
            }
            SEAM();
        }
        if (IN(PH_MLGATES)) {
            PH_LOCALS
            LAS float* WG = (LAS float*)lds;
            const float* wg = args.in[I_MLWG] + (size_t)l * 1536 * 16; const float* bg = args.in[I_MLBG] + (size_t)l * 16;
            __syncthreads();
            for (int i = tid; i < 1536 * 16; i += NTHR) { const int k = i >> 4, gg = i & 15; WG[gg * 1536 + k] = wg[i]; }
            __syncthreads();
            for (int t = gw; t < TOK; t += NGW) {
                const int b = t >> 13, s = t & (SEQ - 1), h = lane >> 4, e0 = (lane & 15) * 8;
                float x[24];
#pragma unroll
                for (int which = 0; which < 3; ++which) {
                    const bf16* src = (which == 0 ? MQ : which == 1 ? MK : MV) + ((size_t)(b * 4 + h) * SEQ + s) * 128 + e0;
                    const u32x4 w = *(const u32x4*)src;
                    x[which * 8 + 0] = bflo(w.x); x[which * 8 + 1] = bfhi(w.x); x[which * 8 + 2] = bflo(w.y); x[which * 8 + 3] = bfhi(w.y);
                    x[which * 8 + 4] = bflo(w.z); x[which * 8 + 5] = bfhi(w.z); x[which * 8 + 6] = bflo(w.w); x[which * 8 + 7] = bfhi(w.w);
                }
                float a[16];
#pragma unroll
                for (int gg = 0; gg < 16; ++gg) { float sacc = 0.f;
#pragma unroll
                    for (int which = 0; which < 3; ++which) {
                        const f32x4 w0 = *(const LAS f32x4*)(WG + gg * 1536 + which * 512 + lane * 8), w1 = *(const LAS f32x4*)(WG + gg * 1536 + which * 512 + lane * 8 + 4);
                        sacc += x[which * 8 + 0] * w0[0] + x[which * 8 + 1] * w0[1] + x[which * 8 + 2] * w0[2] + x[which * 8 + 3] * w0[3]
                              + x[which * 8 + 4] * w1[0] + x[which * 8 + 5] * w1[1] + x[which * 8 + 6] * w1[2] + x[which * 8 + 7] * w1[3]; }
                    a[gg] = sacc; asm volatile("" ::: "memory"); }
#pragma unroll
                for (int i = 0; i < 8; ++i) { const bool up = lane & 32; const float send = up ? a[i] : a[i + 8], keep = up ? a[i + 8] : a[i]; a[i] = keep + __shfl_xor(send, 32); }
#pragma unroll
                for (int i = 0; i < 4; ++i) { const bool up = lane & 16; const float send = up ? a[i] : a[i + 4], keep = up ? a[i + 4] : a[i]; a[i] = keep + __shfl_xor(send, 16); }
#pragma unroll
                for (int i = 0; i < 2; ++i) { const bool up = lane & 8; const float send = up ? a[i] : a[i + 2], keep = up ? a[i + 2] : a[i]; a[i] = keep + __shfl_xor(send, 8); }
                { const bool up = lane & 4; const float send = up ? a[0] : a[1], keep = up ? a[1] : a[0]; a[0] = keep + __shfl_xor(send, 4); }
                a[0] += __shfl_xor(a[0], 2); a[0] += __shfl_xor(a[0], 1);
                if ((lane & 3) == 0) { const int gg = lane >> 2; const int ty = gg >> 2, hh = gg & 3;
                    G4[((size_t)(ty * BATCH + b) * 4 + hh) * SEQ + s] = a[0] + bg[gg]; }
            }
            SEAM();
        }
        if (IN(PH_MLLOC)) {
            PH_LOCALS
            LAS bf16* BA = (LAS bf16*)lds; LAS bf16* BB = (LAS bf16*)(lds + TILE_B);
            LAS float* sLS = (LAS float*)(lds + 2 * TILE_B); LAS float* sIG = sLS + 128; LAS float* sB = sIG + 128; LAS float* sE = sB + 128;
            for (int u = vcu; u < 1024; u += G) {
                const int dir = u >> 9, b = (u >> 8) & 1, h = (u >> 6) & 3, c = u & 63;
                const int seq = (dir * 2 + b) * 4 + h; const int s0 = c * 128;
                __syncthreads();
                if (tid < 128) { sIG[tid] = G4[((size_t)((dir * 2 + 0) * BATCH + b) * 4 + h) * SEQ + s0 + tid];
                                 sLS[tid] = logsigmoidf_(G4[((size_t)((dir * 2 + 1) * BATCH + b) * 4 + h) * SEQ + s0 + tid]); }
                __syncthreads();
                if (wave == 0) scan_dir<false>(sLS, sIG, sB, nullptr, dir, lane);
                __syncthreads();
                const float gtot = dir ? sB[0] : sB[127];
                const float w0 = gtot - sB[lane] + sIG[lane], w1 = gtot - sB[lane + 64] + sIG[lane + 64];
                const float mloc = wave_max(fmaxf(w0, w1));
                if (wave == 0) { sE[lane] = __expf(w0 - mloc) * 0.08838834764831845f; sE[lane + 64] = __expf(w1 - mloc) * 0.08838834764831845f; }
                __syncthreads();
                const size_t rb = ((size_t)(b * 4 + h) * SEQ + s0) * 128;
                stage_tr<false>(BA, MV + rb, 128, nullptr, tid);
                stage_tr<true>(BB, MK + rb, 128, sE, tid);
                __syncthreads();
                f32x4 acc[8];
                wave_mm(acc, BA + wave * 16 * LDT, BB, lane);
                float* dst = CLOC + ((size_t)seq * 64 + c) * 16384;
                const int fr = lane & 15, fq = lane >> 4;
#pragma unroll
                for (int j = 0; j < 8; ++j)
#pragma unroll
                    for (int r = 0; r < 4; ++r) dst[(wave * 16 + 4 * fq + r) * 128 + j * 16 + fr] = acc[j][r];
                if (tid < 128) { float sacc = 0.f; for (int n = 0; n < 128; ++n) sacc += bf1(BB[tid * LDT + n]); NLOC[((size_t)seq * 64 + c) * 128 + tid] = sacc; }
                if (tid == 0) { MLOC[seq * 64 + c] = mloc; GCH[seq * 64 + c] = gtot; }
            }
            SEAM();
        }
        if (IN(PH_MLSCAN)) {
            PH_LOCALS
            {
                const int seq = gt >> 13, e2 = (gt & 8191) * 2; const int dir = seq >> 3;
                float m = 0.f; f32x2 C = {0.f, 0.f};
                for (int half = 0; half < 2; ++half) {
                    f32x2 cl[32];
#pragma unroll
                    for (int i = 0; i < 32; ++i) { const int cc = half * 32 + i, c = dir ? 63 - cc : cc; cl[i] = *(const f32x2*)(CLOC + ((size_t)seq * 64 + c) * 16384 + e2); }
#pragma unroll
                    for (int i = 0; i < 32; ++i) { const int cc = half * 32 + i, c = dir ? 63 - cc : cc;
                        *(unsigned*)(CPT + ((size_t)seq * 64 + c) * 16384 + e2) = cvtpk(C[0], C[1]);
                        const float gc = GCH[seq * 64 + c], ml = MLOC[seq * 64 + c];
                        const float mn = fmaxf(gc + m, ml), a = __expf(gc + m - mn), bl = __expf(ml - mn);
                        C = C * a + cl[i] * bl; m = mn; }
                }
            }
            if (gt < 16 * 128) {
                const int seq = gt >> 7, kd = gt & 127, dir = seq >> 3; float m = 0.f, n = 0.f;
                for (int cc = 0; cc < 64; ++cc) { const int c = dir ? 63 - cc : cc;
                    NPREV[((size_t)seq * 64 + c) * 128 + kd] = n; if (kd == 0) MPREV[seq * 64 + c] = m;
                    const float gc = GCH[seq * 64 + c], ml = MLOC[seq * 64 + c];
                    const float mn = fmaxf(gc + m, ml), a = __expf(gc + m - mn), bl = __expf(ml - mn);
                    n = n * a + NLOC[((size_t)seq * 64 + c) * 128 + kd] * bl; m = mn; }
            }
            SEAM();
        }
        if (IN(PH_MLOUT)) {
            PH_LOCALS
            LAS bf16* BQ = (LAS bf16*)lds; LAS bf16* BK = (LAS bf16*)(lds + TILE_B); LAS bf16* BV = (LAS bf16*)(lds + 2 * TILE_B); LAS bf16* BC = (LAS bf16*)(lds + 3 * TILE_B);
            LAS float* sm = (LAS float*)(lds + 4 * TILE_B);
            LAS float* sLSf = sm, *sLSb = sm + 128, *sIf = sm + 256, *sIb = sm + 384, *sBf = sm + 512, *sBb = sm + 640, *sPf = sm + 768, *sPb = sm + 896;
            LAS float* sNf = sm + 1024, *sNb = sm + 1152, *sQNf = sm + 1280, *sQNb = sm + 1408;
            const float* normw = args.in[I_MLNORM] + (size_t)l * 512; const float* skipw = args.in[I_MLSKIP] + (size_t)l * 512;
            for (int u = vcu; u < 512; u += G) {
                asm volatile("" : "+v"(tid));
                const int lane = tid & 63, wave = __builtin_amdgcn_readfirstlane(tid >> 6);
                const int b = u >> 8, h = (u >> 6) & 3, c = u & 63; const int s0 = c * 128;
                const int seqf = (0 * 2 + b) * 4 + h, seqb = (1 * 2 + b) * 4 + h;
                const size_t rb = ((size_t)(b * 4 + h) * SEQ + s0) * 128;
                __syncthreads();
                stage_rows(BQ, MQ + rb, 128, tid); stage_rows(BK, MK + rb, 128, tid); stage_tr<false>(BV, MV + rb, 128, nullptr, tid);
                stage_rows(BC, CPT + ((size_t)seqf * 64 + c) * 16384, 128, tid);
                if (tid < 128) {
                    sIf[tid] = G4[((size_t)(0 * BATCH + b) * 4 + h) * SEQ + s0 + tid]; sLSf[tid] = logsigmoidf_(G4[((size_t)(1 * BATCH + b) * 4 + h) * SEQ + s0 + tid]);
                    sIb[tid] = G4[((size_t)(2 * BATCH + b) * 4 + h) * SEQ + s0 + tid]; sLSb[tid] = logsigmoidf_(G4[((size_t)(3 * BATCH + b) * 4 + h) * SEQ + s0 + tid]);
                    sNf[tid] = NPREV[((size_t)seqf * 64 + c) * 128 + tid]; sNb[tid] = NPREV[((size_t)seqb * 64 + c) * 128 + tid];
                }
                __syncthreads();
                if (wave == 0) scan_dir<true>(sLSf, sIf, sBf, sPf, 0, lane);
                if (wave == 1) scan_dir<true>(sLSb, sIb, sBb, sPb, 1, lane);
                {
                    const int t = tid >> 2, part = tid & 3; float af = 0.f, ab = 0.f;
                    for (int k = 0; k < 32; ++k) { const float q = bf1(BQ[t * LDT + part * 32 + k]); af += q * sNf[part * 32 + k]; ab += q * sNb[part * 32 + k]; }
                    af += __shfl_xor(af, 1); af += __shfl_xor(af, 2); ab += __shfl_xor(ab, 1); ab += __shfl_xor(ab, 2);
                    if (part == 0) { sQNf[t] = af; sQNb[t] = ab; }
                }
                __syncthreads();
                const float mpf = MPREV[seqf * 64 + c], mpb = MPREV[seqb * 64 + c];
                const int fr = lane & 15, fq = lane >> 4;
                f32x4 accS[8];
                wave_mm(accS, BQ + wave * 16 * LDT, BK, lane);
                float rowBf[4], rowBb[4], mtf[4], mtb[4], inf_[4], inb_[4], rsf[4], rsb[4];
#pragma unroll
                for (int r = 0; r < 4; ++r) { const int t = wave * 16 + 4 * fq + r;
                    rowBf[r] = sBf[t]; rowBb[r] = sBb[t];
                    mtf[r] = rowBf[r] + fmaxf(mpf, sPf[t]); mtb[r] = rowBb[r] + fmaxf(mpb, sPb[t]);
                    inf_[r] = __expf(rowBf[r] + mpf - mtf[r]); inb_[r] = __expf(rowBb[r] + mpb - mtb[r]);
                    rsf[r] = 0.f; rsb[r] = 0.f; }
#pragma unroll
                for (int j = 0; j < 8; ++j) { const int s = j * 16 + fr; const float cf = sIf[s] - sBf[s], cb = sIb[s] - sBb[s];
#pragma unroll
                    for (int r = 0; r < 4; ++r) { const int t = wave * 16 + 4 * fq + r; const float sv = accS[j][r];
                        rsf[r] += (s <= t) ? __expf(rowBf[r] + cf - mtf[r]) * sv : 0.f;
                        rsb[r] += (s >= t) ? __expf(rowBb[r] + cb - mtb[r]) * sv : 0.f; } }
                float scf[4], scb[4], cif[4], cib[4];
#pragma unroll
                for (int r = 0; r < 4; ++r) { const int t = wave * 16 + 4 * fq + r;
                    float a = rsf[r] * 0.08838834764831845f, bq = rsb[r] * 0.08838834764831845f;
                    a += __shfl_xor(a, 1); a += __shfl_xor(a, 2); a += __shfl_xor(a, 4); a += __shfl_xor(a, 8);
                    bq += __shfl_xor(bq, 1); bq += __shfl_xor(bq, 2); bq += __shfl_xor(bq, 4); bq += __shfl_xor(bq, 8);
                    const float denf = inf_[r] * sQNf[t] + a, denb = inb_[r] * sQNb[t] + bq;
                    scf[r] = 1.0f / fmaxf(fabsf(denf), __expf(-mtf[r])); scb[r] = 1.0f / fmaxf(fabsf(denb), __expf(-mtb[r]));
                    cif[r] = scf[r] * inf_[r]; cib[r] = scb[r] * inb_[r];
                    scf[r] *= 0.08838834764831845f; scb[r] *= 0.08838834764831845f; }
                __syncthreads();
#pragma unroll
                for (int j = 0; j < 8; ++j) { const int s = j * 16 + fr; const float cf = sIf[s] - sBf[s], cb = sIb[s] - sBb[s];
#pragma unroll
                    for (int r = 0; r < 4; ++r) { const int t = wave * 16 + 4 * fq + r; const float sv = accS[j][r];
                        const float a = (s <= t) ? __expf(rowBf[r] + cf - mtf[r]) * scf[r] : 0.f;
                        const float bq = (s >= t) ? __expf(rowBb[r] + cb - mtb[r]) * scb[r] : 0.f;
                        BK[t * LDT + s] = tobf1((a + bq) * sv); } }
                __syncthreads();
                f32x4 hacc[8];
                wave_mm(hacc, BK + wave * 16 * LDT, BV, lane);
                f32x4 xacc[8];
                wave_mm(xacc, BQ + wave * 16 * LDT, BC, lane);
#pragma unroll
                for (int j = 0; j < 8; ++j)
#pragma unroll
                    for (int r = 0; r < 4; ++r) hacc[j][r] += cif[r] * xacc[j][r];
                __syncthreads();
                stage_rows(BV, CPT + ((size_t)seqb * 64 + c) * 16384, 128, tid);
                __syncthreads();
                wave_mm(xacc, BQ + wave * 16 * LDT, BV, lane);
#pragma unroll
                for (int j = 0; j < 8; ++j)
#pragma unroll
                    for (int r = 0; r < 4; ++r) hacc[j][r] += cib[r] * xacc[j][r];
#pragma unroll
                for (int r = 0; r < 4; ++r) { const int t = wave * 16 + 4 * fq + r; const size_t tokrow = (size_t)b * SEQ + s0 + t;
                    float sacc = 0.f;
#pragma unroll
                    for (int j = 0; j < 8; ++j) sacc += hacc[j][r];
                    sacc += __shfl_xor(sacc, 1); sacc += __shfl_xor(sacc, 2); sacc += __shfl_xor(sacc, 4); sacc += __shfl_xor(sacc, 8);
                    const float mu = sacc * (1.f / 128.f); float q = 0.f;
#pragma unroll
                    for (int j = 0; j < 8; ++j) { const float d = hacc[j][r] - mu; q += d * d; }
                    q += __shfl_xor(q, 1); q += __shfl_xor(q, 2); q += __shfl_xor(q, 4); q += __shfl_xor(q, 8);
                    const float rstd = 1.0f / sqrtf(q * (1.f / 128.f) + LN_EPS);
#pragma unroll
                    for (int j = 0; j < 8; ++j) { const int col = h * 128 + j * 16 + fr;
                        const float hn = (hacc[j][r] - mu) * rstd * normw[col] + skipw[col] * bf1(XC[tokrow * 512 + col]);
                        YB[tokrow * 512 + col] = tobf1(sigmoidf_(bf1(MLO[tokrow * 512 + col])) * hn); }
                }
            }
            SEAM();
        }
        if (IN(PH_DIFF)) {
            PH_LOCALS
            const float* lp = args.in[I_LAMBDA] + (size_t)l * 256;
            const float s1 = wave_sum(lp[lane] * lp[64 + lane]), s2 = wave_sum(lp[128 + lane] * lp[192 + lane]);
            const float lam_init = args.lam_init[l], lam = __expf(s1) - __expf(s2) + lam_init;
            const float* subln = args.in[I_SUBLN] + (size_t)l * 128;
            const int r32 = lane & 31, hi = lane >> 5;
            for (int u = vcu; u < 256; u += G) {
                const int b = u >> 7, h = (u >> 5) & 3, qb = u & 31;
                GAS float* st = (GAS float*)(STASH + (size_t)bx * (16 * 512 * 4) + (size_t)tid * 4);
                f32x16 o[4];
                {   const size_t hb = ((size_t)(b * 8 + h * 2 + 0) * SEQ) * 64;
                    att::body<4, false>(QA + hb + (size_t)qb * 256 * 64, KA + hb, VA + ((size_t)(b * 4 + h) * SEQ) * 128, SEQ / 64, 0, 0, 0.f, o, (char*)lds_raw); }
                asm volatile("" : "+v"(st));
#pragma unroll
                for (int d = 0; d < 4; ++d)
#pragma unroll
                    for (int q4 = 0; q4 < 4; ++q4) *(GAS f32x4*)(st + (size_t)(d * 4 + q4) * 2048) = (f32x4){o[d][q4 * 4], o[d][q4 * 4 + 1], o[d][q4 * 4 + 2], o[d][q4 * 4 + 3]};
                {   const size_t hb = ((size_t)(b * 8 + h * 2 + 1) * SEQ) * 64;
                    att::body<4, false>(QA + hb + (size_t)qb * 256 * 64, KA + hb, VA + ((size_t)(b * 4 + h) * SEQ) * 128, SEQ / 64, 0, 0, 0.f, o, (char*)lds_raw); }
                float ss[16];
#pragma unroll
                for (int r = 0; r < 16; ++r) ss[r] = 0.f;
                asm volatile("" : "+v"(st));
#pragma unroll
                for (int d = 0; d < 4; ++d)
#pragma unroll
                    for (int q4 = 0; q4 < 4; ++q4) { const f32x4 v = *(const GAS f32x4*)(st + (size_t)(d * 4 + q4) * 2048);
#pragma unroll
                        for (int k = 0; k < 4; ++k) { const float x = v[k] - lam * o[d][q4 * 4 + k]; o[d][q4 * 4 + k] = x; ss[q4 * 4 + k] += x * x; } }
#pragma unroll
                for (int r = 0; r < 16; ++r) { float v = ss[r]; v += __shfl_xor(v, 1); v += __shfl_xor(v, 2); v += __shfl_xor(v, 4); v += __shfl_xor(v, 8); v += __shfl_xor(v, 16);
                    ss[r] = (1.0f / sqrtf(v * (1.f / 128.f) + LN_EPS)) * (1.f - lam_init); }
                GAS bf16* yo = (GAS bf16*)(YA + ((size_t)b * SEQ + qb * 256 + wave * 32 + 4 * hi) * 512 + h * 128 + r32);
                asm volatile("" : "+v"(yo));
#pragma unroll
                for (int d = 0; d < 4; ++d) { const float gsc = subln[d * 32 + r32];
#pragma unroll
                    for (int r = 0; r < 16; ++r) yo[((r & 3) + 8 * (r >> 2)) * 512 + d * 32] = tobf1(o[d][r] * ss[r] * gsc); }
            }
            SEAM();
        }
        if (IN(PH_WIN)) {
            PH_LOCALS
            const float* sinks = args.in[I_SINKS] + (size_t)l * 8;
            const int r32 = lane & 31, hi = lane >> 5;
            for (int u = vcu * 2; u < vcu * 2 + 2; ++u) {
                const int b = u >> 8, qh = (u >> 5) & 7, qb = u & 31, kvh = qh >> 2; const int q0 = qb * 256;
                const int klo = (q0 - 128 < 0) ? 0 : q0 - 128, khi = (q0 + 384 > SEQ) ? SEQ : q0 + 384; const int NT = (khi - klo) / 64;
                f32x16 o[2];
                att::body<2, true>(WQb + ((size_t)(b * 8 + qh) * SEQ + q0) * 64, WKb + ((size_t)(b * 2 + kvh) * SEQ + klo) * 64, WVb + ((size_t)(b * 2 + kvh) * SEQ + klo) * 64,
                                   NT, klo, q0, sinks[qh] * 1.4426950408889634f, o, (char*)lds_raw);
                GAS bf16* yo = (GAS bf16*)(YC + ((size_t)b * SEQ + q0 + wave * 32 + 4 * hi) * 512 + qh * 64 + r32);
                asm volatile("" : "+v"(yo));
#pragma unroll
                for (int d = 0; d < 2; ++d)
#pragma unroll
                    for (int r = 0; r < 16; ++r) yo[((r & 3) + 8 * (r >> 2)) * 512 + d * 32] = tobf1(o[d][r]);
            }
            SEAM();
        }
        if (IN(PH_MERGE0)) {
            PH_LOCALS
            pg8::Gemm g{YA, WP_T + ((size_t)l * 3 + 0) * DM * 512, 512, 512, 512};
            pg8::StaticOrder S; S.init(TOK / 256, DM / 256, G, bx, nullptr);
            pg8::EpiMerge<0> E{GT, MF, MB};
            pg8::gemm_phase<pg8::EpiMerge<0>, false>(lds, g, S, E);
            SEAM();
        }
        if (IN(PH_MERGE1)) {
            PH_LOCALS
            pg8::Gemm g{YB, WP_T + ((size_t)l * 3 + 1) * DM * 512, 512, 512, 512};
            pg8::StaticOrder S; S.init(TOK / 256, DM / 256, G, bx, nullptr);
            pg8::EpiMerge<1> E{GT, MF, MB};
            pg8::gemm_phase<pg8::EpiMerge<1>, false>(lds, g, S, E);
            SEAM();
        }
        if (IN(PH_MERGE2)) {
            PH_LOCALS
            pg8::Gemm g{YC, WP_T + ((size_t)l * 3 + 2) * DM * 512, 512, 512, 512};
            pg8::StaticOrder S; S.init(TOK / 256, DM / 256, G, bx, nullptr);
            pg8::EpiMerge<2> E{GT, MF, MB};
            pg8::gemm_phase<pg8::EpiMerge<2>, false>(lds, g, S, E);
            SEAM();
        }
        if (IN(PH_OUT)) {
            PH_LOCALS
            pg8::Gemm g{MB, WOUT_T + (size_t)l * DM * DM, DM, DM, DM};
            pg8::StaticOrder S; S.init(TOK / 256, DM / 256, G, bx, nullptr);
            pg8::EpiOut E{l == 0 ? args.in[I_X] : XF, XF};
            pg8::gemm_phase<pg8::EpiOut, false>(lds, g, S, E);
            SEAM();
        }
        if (IN(PH_LN1)) {
            PH_LOCALS
            LAS float* RW = (LAS float*)lds;
            LAS float* LG = (LAS float*)(lds + 131072) + wave * 32;
            LAS int* LCNT = (LAS int*)(lds + 131072 + 1024);
            const float* rw = args.in[I_RW] + (size_t)l * DM * NEXP; const float* rbias = args.in[I_RB] + (size_t)l * NEXP;
            const float* g1 = args.in[I_LN1G] + (size_t)l * DM; const float* b1 = args.in[I_LN1B] + (size_t)l * DM;
            __syncthreads();
            for (int i = tid; i < DM * NEXP; i += NTHR) { const int k = i >> 5, e = i & 31; RW[e * 1024 + k] = rw[i]; }
            if (tid < 32) LCNT[tid] = 0;
            __syncthreads();
            f32x4 gv[4], bv[4];
#pragma unroll
            for (int j = 0; j < 4; ++j) { gv[j] = *(const f32x4*)(g1 + 4 * lane + 256 * j); bv[j] = *(const f32x4*)(b1 + 4 * lane + 256 * j); }
            for (int i = 0; i < TOK / (GRID * NWAVES); ++i) {
                const int t = bx * (TOK / GRID) + wave * (TOK / (GRID * NWAVES)) + i;
                float* xr = XF + (size_t)t * DM;
                f32x4 v[4]; float s = 0.f;
#pragma unroll
                for (int j = 0; j < 4; ++j) { v[j] = *(const f32x4*)(xr + 4 * lane + 256 * j); s += (v[j][0] + v[j][1]) + (v[j][2] + v[j][3]); }
                const float mean = wave_sum(s) * (1.f / DM); float s2 = 0.f;
#pragma unroll
                for (int j = 0; j < 4; ++j) { v[j] = v[j] - mean; s2 += (v[j][0] * v[j][0] + v[j][1] * v[j][1]) + (v[j][2] * v[j][2] + v[j][3] * v[j][3]); }
                const float rstd = 1.f / sqrtf(wave_sum(s2) * (1.f / DM) + LN_EPS);
#pragma unroll
                for (int j = 0; j < 4; ++j) { v[j] = v[j] * rstd * gv[j] + bv[j];
                    *(f32x4*)(xr + 4 * lane + 256 * j) = v[j];
                    u32x2 w; w.x = cvtpk(v[j][0], v[j][1]); w.y = cvtpk(v[j][2], v[j][3]);
                    *(u32x2*)(XB + (size_t)t * DM + 4 * lane + 256 * j) = w; }
                float a[32];
#pragma unroll
                for (int e = 0; e < 32; ++e) { float sacc = 0.f;
#pragma unroll
                    for (int j = 0; j < 4; ++j) { const f32x4 w = *(const LAS f32x4*)(RW + e * 1024 + 4 * lane + 256 * j); sacc += v[j][0] * w[0] + v[j][1] * w[1] + v[j][2] * w[2] + v[j][3] * w[3]; }
                    a[e] = sacc; }
#pragma unroll
                for (int q = 0; q < 16; ++q) { const bool up = lane & 32; const float send = up ? a[q] : a[q + 16], keep = up ? a[q + 16] : a[q]; a[q] = keep + __shfl_xor(send, 32); }
#pragma unroll
                for (int q = 0; q < 8; ++q) { const bool up = lane & 16; const float send = up ? a[q] : a[q + 8], keep = up ? a[q + 8] : a[q]; a[q] = keep + __shfl_xor(send, 16); }
#pragma unroll
                for (int q = 0; q < 4; ++q) { const bool up = lane & 8; const float send = up ? a[q] : a[q + 4], keep = up ? a[q + 4] : a[q]; a[q] = keep + __shfl_xor(send, 8); }
#pragma unroll
                for (int q = 0; q < 2; ++q) { const bool up = lane & 4; const float send = up ? a[q] : a[q + 2], keep = up ? a[q + 2] : a[q]; a[q] = keep + __shfl_xor(send, 4); }
                { const bool up = lane & 2; const float send = up ? a[0] : a[1], keep = up ? a[1] : a[0]; a[0] = keep + __shfl_xor(send, 2); }
                a[0] += __shfl_xor(a[0], 1);
                if ((lane & 1) == 0) LG[lane >> 1] = a[0] + rbias[lane >> 1];
                LDS_WAIT(); asm volatile("" ::: "memory");
                float v0 = -INFINITY, v1 = -INFINITY, v2 = -INFINITY, v3 = -INFINITY; int e0 = 0, e1 = 0, e2 = 0, e3 = 0;
#pragma unroll 1
                for (int e = 0; e < 32; ++e) { const float x = LG[e];
                    if (x > v0) { v3 = v2; e3 = e2; v2 = v1; e2 = e1; v1 = v0; e1 = e0; v0 = x; e0 = e; }
                    else if (x > v1) { v3 = v2; e3 = e2; v2 = v1; e2 = e1; v1 = x; e1 = e; }
                    else if (x > v2) { v3 = v2; e3 = e2; v2 = x; e2 = e; }
                    else if (x > v3) { v3 = x; e3 = e; } }
                const float p1 = __expf(v1 - v0), p2 = __expf(v2 - v0), p3 = __expf(v3 - v0), inv = 1.f / (1.f + p1 + p2 + p3);
                if (lane < 4) { const int e = lane == 0 ? e0 : lane == 1 ? e1 : lane == 2 ? e2 : e3; const float w = (lane == 0 ? 1.f : lane == 1 ? p1 : lane == 2 ? p2 : p3) * inv;
                    const int lp = atomicAdd((int*)&LCNT[e], 1);
                    TOKE[t * 4 + lane] = e; TOKW[t * 4 + lane] = w; TOKLP[t * 4 + lane] = lp; }
                asm volatile("" ::: "memory");
            }
            __syncthreads();
            if (tid < 32) BLKCNT[bx * 32 + tid] = LCNT[tid];
            SEAM();
        }
        if (IN(PH_SORT)) {
            PH_LOCALS
            LAS int* sTot = (LAS int*)lds; LAS int* sBase = sTot + 32; LAS int* sOff = sTot + 64; LAS int* sRow = sTot + 128;
            __syncthreads();
            if (tid < 32) { int tot = 0, base = 0; for (int b2 = 0; b2 < GRID; ++b2) { const int c = BLKCNT[b2 * 32 + tid]; tot += c; if (b2 < bx) base += c; } sTot[tid] = tot; sBase[tid] = base; }
            __syncthreads();
            if (tid == 0) { int off = 0, nt = 0;
#pragma unroll 1
                for (int e = 0; e < 32; ++e) { sOff[e] = off; const int n = (sTot[e] + 255) >> 8;
                    if (bx == 0) {
#pragma unroll 1
                        for (int i = 0; i < n; ++i) TILEE[nt + i] = e; }
                    nt += n; off += n * 256; }
                if (bx == 0) TILEE[512] = nt; }
            __syncthreads();
            if (tid < 256) { const int t = bx * 64 + (tid >> 2), k = tid & 3; const int e = TOKE[t * 4 + k];
                const int row = sOff[e] + sBase[e] + TOKLP[t * 4 + k]; TOKROW[t * 4 + k] = row; ROWW[row] = TOKW[t * 4 + k]; sRow[tid] = row; }
            __syncthreads();
            for (int i = 0; i < 32; ++i) { const int p = wave * 32 + i; const int t = bx * 64 + (p >> 2); const int row = sRow[p];
                const u32x4* src = (const u32x4*)(XB + (size_t)t * DM); u32x4* dst = (u32x4*)(XG + (size_t)row * DM);
                dst[lane] = src[lane]; dst[lane + 64] = src[lane + 64]; }
            SEAM();
        }
        if (IN(PH_GU)) {
            PH_LOCALS
            const int ntiles = __builtin_amdgcn_readfirstlane(TILEE[512]);
            pg8::Gemm g{XG, WGU_T + (size_t)l * NEXP * 2048 * DM, DM, DM, DM};
            pg8::StaticOrder S; S.init(ntiles, 8, G, bx, TILEE);
            pg8::EpiSwiglu E{args.in[I_BGU] + (size_t)l * NEXP * 2048, TILEE, ACT};
            pg8::gemm_phase<pg8::EpiSwiglu, true>(lds, g, S, E);
            SEAM();
        }
        if (IN(PH_DOWN)) {
            PH_LOCALS
            const int ntiles = __builtin_amdgcn_readfirstlane(TILEE[512]);
            pg8::Gemm g{ACT, WDN_T + (size_t)l * NEXP * DM * DFF, DFF, DFF, DFF};
            pg8::StaticOrder S; S.init(ntiles, 4, G, bx, TILEE);
            pg8::EpiDown E{args.in[I_BDN] + (size_t)l * NEXP * DM, TILEE, ROWW, YS};
            pg8::gemm_phase<pg8::EpiDown, true>(lds, g, S, E);
            SEAM();
        }
        if (IN(PH_LN2)) {
            PH_LOCALS
            const float* g2 = args.in[I_LN2G] + (size_t)l * DM; const float* b2 = args.in[I_LN2B] + (size_t)l * DM;
            f32x4 gv[4], bv[4];
#pragma unroll
            for (int j = 0; j < 4; ++j) { gv[j] = *(const f32x4*)(g2 + 4 * lane + 256 * j); bv[j] = *(const f32x4*)(b2 + 4 * lane + 256 * j); }
            float* dstf = (l == DEPTH - 1) ? args.out : XF;
            for (int t = gw; t < TOK; t += NGW) {
                const float* xr = XF + (size_t)t * DM;
                f32x4 v[4];
#pragma unroll
                for (int j = 0; j < 4; ++j) v[j] = *(const f32x4*)(xr + 4 * lane + 256 * j) * DN_ALPHA;
#pragma unroll
                for (int k = 0; k < 4; ++k) { const int row = __builtin_amdgcn_readfirstlane(TOKROW[t * 4 + k]); const bf16* yr = YS + (size_t)row * DM;
#pragma unroll
                    for (int j = 0; j < 4; ++j) { const u32x2 w = *(const u32x2*)(yr + 4 * lane + 256 * j); v[j][0] += bflo(w.x); v[j][1] += bfhi(w.x); v[j][2] += bflo(w.y); v[j][3] += bfhi(w.y); } }
                float s = 0.f;
#pragma unroll
                for (int j = 0; j < 4; ++j) s += (v[j][0] + v[j][1]) + (v[j][2] + v[j][3]);
                const float mean = wave_sum(s) * (1.f / DM); float s2 = 0.f;
#pragma unroll
                for (int j = 0; j < 4; ++j) { v[j] = v[j] - mean; s2 += (v[j][0] * v[j][0] + v[j][1] * v[j][1]) + (v[j][2] * v[j][2] + v[j][3] * v[j][3]); }
                const float rstd = 1.f / sqrtf(wave_sum(s2) * (1.f / DM) + LN_EPS);
#pragma unroll
                for (int j = 0; j < 4; ++j) { v[j] = v[j] * rstd * gv[j] + bv[j];
                    *(f32x4*)(dstf + (size_t)t * DM + 4 * lane + 256 * j) = v[j];
                    u32x2 w; w.x = cvtpk(v[j][0], v[j][1]); w.y = cvtpk(v[j][2], v[j][3]);
                    *(u32x2*)(XB + (size_t)t * DM + 4 * lane + 256 * j) = w; }
            }
            if (l + 1 < args.lay_hi) SEAM();
        }
#undef IN
    }
}

extern "C" void kernel_launch(void* const* d_in, const int* in_sizes, int n_in, void* d_out, int out_size, void* d_ws, size_t ws_size, hipStream_t stream) {
    static int ok = 0;
    if (ok == 0) {
        if (n_in != 28 || in_sizes[0] != TOK * DM || out_size != TOK * DM || ws_size < WS_END) {
            fprintf(stderr, "kernel_launch: unexpected shapes: n_in %d in0 %d out %d ws %zu (need %zu)\n", n_in, n_in > 0 ? in_sizes[0] : -1, out_size, ws_size, (size_t)WS_END); ok = -1; return; }
        int dev = 0, cus = 0, per_cu = 0;
        hipGetDevice(&dev); hipDeviceGetAttribute(&cus, hipDeviceAttributeMultiprocessorCount, dev);
        if (hipFuncSetAttribute((const void*)mega, hipFuncAttributeMaxDynamicSharedMemorySize, LDS_BYTES) != hipSuccess) { fprintf(stderr, "kernel_launch: hipFuncSetAttribute failed\n"); ok = -1; return; }
        if (hipOccupancyMaxActiveBlocksPerMultiprocessor(&per_cu, (const void*)mega, NTHR, LDS_BYTES) != hipSuccess || per_cu < 1) fprintf(stderr, "kernel_launch: occupancy query says %d blocks/CU\n", per_cu);
        (void)hipGetLastError();
        if (cus < GRID) { fprintf(stderr, "kernel_launch: device has %d CUs, need %d\n", cus, GRID); ok = -1; return; }
        ok = 1;
    }
    if (ok < 0) return;
    hipMemsetAsync((char*)d_ws + OFF_CTL, 0, CTL_BYTES, stream);
    Args a{};
    for (int i = 0; i < 28; ++i) a.in[i] = (const float*)d_in[i];
    a.out = (float*)d_out; a.ws = (unsigned char*)d_ws;
    for (int l = 0; l < 4; ++l) a.lam_init[l] = (float)(0.8 - 0.6 * exp(-0.3 * (double)l));
#if MK_MULTI
    a.single = 0;
    a.lay_lo = -1; a.lay_hi = 0; a.ph_lo = 0; a.ph_hi = 0;
    hipLaunchKernelGGL(mega, dim3(GRID), dim3(NTHR), LDS_BYTES, stream, a);
    for (int l = 0; l < DEPTH; ++l) for (int p = 1; p < PH_END; ++p) { a.lay_lo = l; a.lay_hi = l + 1; a.ph_lo = p; a.ph_hi = p + 1; hipLaunchKernelGGL(mega, dim3(GRID), dim3(NTHR), LDS_BYTES, stream, a); }
#else
    a.single = 1; a.lay_lo = -1; a.lay_hi = DEPTH; a.ph_lo = 1; a.ph_hi = PH_END;
    hipLaunchKernelGGL(mega, dim3(GRID), dim3(NTHR), LDS_BYTES, stream, a);
#endif
    const hipError_t le = hipPeekAtLastError();
    if (le != hipSuccess) fprintf(stderr, "kernel_launch: launch failed: %s\n", hipGetErrorName(le));
}
```

```cpp
#include <hip/hip_runtime.h>
#include <cstdio>
#include <cstdint>
#include <cmath>

#ifndef MK_MULTI
#define MK_MULTI 0
#endif

#ifndef REPEAT_MASK
#define REPEAT_MASK 0ull
#endif
#ifndef PHASE_MASK
#define PHASE_MASK 0xffffffffull
#endif
#define LAS __attribute__((address_space(3)))
#define GAS __attribute__((address_space(1)))
typedef unsigned short bf16;
typedef short bf16x8 __attribute__((ext_vector_type(8)));
typedef short s16x4 __attribute__((ext_vector_type(4)));
typedef float f32x2 __attribute__((ext_vector_type(2)));
typedef float f32x4 __attribute__((ext_vector_type(4)));
typedef float f32x16 __attribute__((ext_vector_type(16)));
typedef unsigned u32x2 __attribute__((ext_vector_type(2)));
typedef unsigned u32x4 __attribute__((ext_vector_type(4)));

constexpr int BATCH = 2, SEQ = 8192, DM = 1024, TOK = BATCH * SEQ, DEPTH = 4, DIN = 6400;
constexpr int NEXP = 32, DFF = 1024;
constexpr int WA_K_COL = 3072, WA_V_COL = 3200;
constexpr float DN_ALPHA = 1.6817928305074290f;
constexpr float LN_EPS = 1e-5f;
constexpr int NTHR = 512, NWAVES = 8, GRID = 256;
constexpr int MAXROWS = 73728;

constexpr size_t MiB = 1ull << 20;
constexpr size_t OFF_CTL = 0, CTL_BYTES = 1 * MiB;
constexpr size_t OFF_ROPE = 1 * MiB;
constexpr size_t OFF_WML = 3 * MiB;
constexpr size_t OFF_MISC = 5 * MiB;
constexpr size_t OFF_G4 = OFF_MISC;
constexpr size_t OFF_NLOC = OFF_MISC + 1 * MiB;
constexpr size_t OFF_NPREV = OFF_NLOC + 512 * 1024;
constexpr size_t OFF_MLOC = OFF_MISC + 2 * MiB;
constexpr size_t OFF_GCH = OFF_MLOC + 4096;
constexpr size_t OFF_MPREV = OFF_GCH + 4096;
constexpr size_t OFF_BLKCNT = OFF_MLOC + 16384;
constexpr size_t OFF_CGCB = OFF_MLOC + 49152;
constexpr size_t OFF_TILEE = OFF_MLOC + 65536;
constexpr size_t OFF_RWGH = OFF_MISC + 2 * MiB + 512 * 1024;
constexpr size_t OFF_RWGL = OFF_RWGH + 256 * 1024;
constexpr size_t OFF_ROWW = OFF_MLOC + 131072;
constexpr size_t OFF_TOKE = OFF_MISC + 3 * MiB;
constexpr size_t OFF_TOKW = OFF_TOKE + 256 * 1024;
constexpr size_t OFF_TOKLP = OFF_TOKW + 256 * 1024;
constexpr size_t OFF_TOKROW = OFF_TOKLP + 256 * 1024;
constexpr size_t OFF_WIN = 9 * MiB;
constexpr size_t OFF_WP = OFF_WIN + 50 * MiB;
constexpr size_t OFF_WOUT = OFF_WP + 12 * MiB;
constexpr size_t OFF_WGU = OFF_WOUT + 8 * MiB;
constexpr size_t OFF_WDN = OFF_WGU + 512 * MiB;
constexpr size_t OFF_XB = OFF_WDN + 256 * MiB;
constexpr size_t OFF_XF = OFF_XB + 32 * MiB;
constexpr size_t OFF_QA = OFF_XF + 64 * MiB;
constexpr size_t OFF_KA = OFF_QA + 16 * MiB;
constexpr size_t OFF_VA = OFF_KA + 16 * MiB;
constexpr size_t OFF_MLX = OFF_VA + 16 * MiB;
constexpr size_t OFF_MLO = OFF_MLX + 16 * MiB;
constexpr size_t OFF_XC = OFF_MLO + 16 * MiB;
constexpr size_t OFF_WQ = OFF_XC + 16 * MiB;
constexpr size_t OFF_WK = OFF_WQ + 16 * MiB;
constexpr size_t OFF_WV = OFF_WK + 4 * MiB;
constexpr size_t OFF_GT = OFF_WV + 4 * MiB;
constexpr size_t OFF_Y3 = OFF_GT + 96 * MiB;
constexpr size_t OFF_MF = OFF_Y3 + 48 * MiB;
constexpr size_t OFF_MB = OFF_MF + 64 * MiB;
constexpr size_t OFF_MQ = OFF_MB + 32 * MiB;
constexpr size_t OFF_CLOC = OFF_MQ + 48 * MiB;
constexpr size_t OFF_CPT = OFF_CLOC + 64 * MiB;
constexpr size_t OFF_STASH = OFF_CPT + 32 * MiB;
constexpr size_t OFF_XG = OFF_STASH + 32 * MiB;
constexpr size_t OFF_ACT = OFF_XG + 144 * MiB;
constexpr size_t OFF_YS = OFF_ACT + 144 * MiB;
constexpr size_t OFF_ZB = OFF_YS + 144 * MiB;
constexpr size_t OFF_X1 = OFF_ZB + 64 * MiB;
constexpr size_t OFF_WGT = OFF_X1 + 64 * MiB;
constexpr size_t OFF_ROWTOK = OFF_WGT + 1 * MiB;
constexpr size_t OFF_XB8 = OFF_ROWTOK + 1 * MiB;
constexpr size_t WS_END = OFF_XB8 + 16 * MiB;

constexpr int PH_LDS = 147456;
constexpr int LDS_BYTES = PH_LDS + 256;

typedef float f32x2_cv __attribute__((ext_vector_type(2))); typedef __bf16 bf16x2_cv __attribute__((ext_vector_type(2)));
__device__ __forceinline__ unsigned cvtpk(float lo, float hi) { const f32x2_cv v = {lo, hi}; const bf16x2_cv b = __builtin_convertvector(v, bf16x2_cv); return __builtin_bit_cast(unsigned, b); }
__device__ __forceinline__ float bflo(unsigned u) { return __uint_as_float(u << 16); }
__device__ __forceinline__ float bfhi(unsigned u) { return __uint_as_float(u & 0xffff0000u); }
__device__ __forceinline__ float bf1(bf16 h) { return __uint_as_float(((unsigned)h) << 16); }
__device__ __forceinline__ bf16 tobf1(float f) { return (bf16)(cvtpk(f, 0.f) & 0xffffu); }
__device__ __forceinline__ float sigmoidf_(float x) { return __builtin_amdgcn_rcpf(1.0f + __builtin_amdgcn_exp2f(-1.4426950408889634f * x)); }
__device__ __forceinline__ float shx(float v, int mask, int lane) { return __int_as_float(__builtin_amdgcn_ds_bpermute((lane ^ mask) << 2, __float_as_int(v))); }
__device__ __forceinline__ float shup(float v, int off, int lane) { return __int_as_float(__builtin_amdgcn_ds_bpermute((lane - off) << 2, __float_as_int(v))); }
__device__ __forceinline__ float wave_sum(float v, int lane) {
#pragma unroll
    for (int o = 1; o < 64; o <<= 1) v += shx(v, o, lane);
    return v;
}
__device__ __forceinline__ float wave_max(float v, int lane) {
#pragma unroll
    for (int o = 1; o < 64; o <<= 1) v = fmaxf(v, shx(v, o, lane));
    return v;
}
#define LDS_WAIT() asm volatile("s_waitcnt lgkmcnt(0)" ::: "memory")

__device__ __forceinline__ unsigned pk4_fp8(float a, float b, float c, float d) { int w = __builtin_amdgcn_cvt_pk_fp8_f32(a, b, 0, false); w = __builtin_amdgcn_cvt_pk_fp8_f32(c, d, w, true); return (unsigned)w; }
constexpr float W8_GU_SCALE = 32.f, W8_DN_SCALE = 64.f, W8_IN_SCALE = 32.f, YS8_SCALE = 16.f;

namespace pg8 {
constexpr int BM = 256, BK = 64, HALF = 128, HTB = HALF * BK * 2, STAGE_BYTES = 8 * HTB, NXCD = 8, WGM = 8;
__host__ __device__ __forceinline__ int lds_byte(int r, int c) { const int st = (r >> 4) * 2 + (c >> 5), rr = r & 15, cc = c & 31, ob = rr * 64 + cc * 2; return st * 1024 + (ob ^ (((ob >> 9) & 1) << 5)); }
__host__ __device__ __forceinline__ void stage_rc(int b, int& R, int& C) { const int st = b / 1024, sb = b % 1024, swz = sb ^ (((sb >> 9) & 1) << 5); R = (st >> 1) * 16 + swz / 64; C = (st & 1) * 32 + (swz % 64) / 2; }
__host__ __device__ __forceinline__ int perm32(int rho) { const int n = rho >> 4, i = rho & 15; return 8 * (i >> 2) + 4 * n + (i & 3); }

struct Unit { int pm, pn, bt, br, hf; };
struct Gemm { const bf16* A; const bf16* Bt; int lda, ldb, K; size_t abr; const int* rowtok; };

__device__ __forceinline__ void tile_of(int wgid, int nwg, int nM, int nN, int& pm, int& pn) {
    { const int q = nwg / NXCD, r = nwg % NXCD, xcd = wgid % NXCD, off = wgid / NXCD; wgid = (xcd < r ? xcd * (q + 1) : r * (q + 1) + (xcd - r) * q) + off; }
    const int nig = WGM * nN, gid = wgid / nig, fm = gid * WGM, gsz = (nM - fm) < WGM ? (nM - fm) : WGM;
    pm = fm + ((wgid % nig) % gsz); pn = (wgid % nig) / gsz;
}
struct StaticOrder {
    int nM, nN, nwg, G, c, nbr, split; const int* tile_e;
    __device__ void init(int nM_, int nN_, int G_, int c_, const int* te, int nbr_ = 1, int split_ = 0) { nM = nM_; nN = nN_; nwg = nM * nN; G = G_; c = c_; tile_e = te; nbr = nbr_; split = split_; }
    __device__ bool next(int i, Unit& u) const {
        long L = (nbr > 1) ? (long)c : (long)i * G + c; if (nbr > 1 && i >= nbr) return false;
        u.hf = 0;
        const int R = nwg % G, full = nwg - R;
        if (split && R > 0 && 2 * R <= G && L >= full) { const int j = (int)(L - full); if (j >= 2 * R) return false; L = full + (j % R); u.hf = 1 + j / R; }
        else if (L >= nwg) return false;
        u.br = (nbr > 1) ? i : 0;
        tile_of((int)L, nwg, nM, nN, u.pm, u.pn);
        u.bt = tile_e ? (__builtin_amdgcn_readfirstlane(tile_e[u.pm]) * nN + u.pn) : (u.br * nN + u.pn);
        return true;
    }
};

static_assert(WGM == 8 && NXCD == 8, "InprojOrder mode 2 deals the last 64 list positions as half units: with these constants they are exactly the 64 tiles of gate column tile 24");
struct InprojOrder {
    int mode, c;
    __device__ bool next(int i, Unit& u) const {
        int L, nN, pn;
        int hf = 0;
        if (mode == 2) { nN = 25; if (i < 6) L = i * 256 + c; else if (i == 6 && c < 128) { L = 1536 + (c & 63); hf = 1 + (c >> 6); } else return false; }
        else if (mode == 0) { nN = 5; if (i == 0) L = c; else if (i == 1 && c < 64) L = 256 + c; else return false; }
        else { nN = 20; if (i < 4) L = i * 256 + c; else if (i == 4 && c >= 64) L = 1024 + (c - 64); else if (i == 5 && c >= 192) L = 1216 + (c - 192); else return false; }
        u.br = 0; u.hf = hf;
        tile_of(L, 64 * nN, 64, nN, u.pm, pn);
        if (mode == 2) { u.pn = pn; u.bt = pn; }
        else if (mode == 0) { u.pn = pn < 2 ? 6 + pn : 8 + pn; u.bt = u.pn; }
        else { u.pn = pn < 6 ? pn : (pn < 8 ? pn + 2 : pn + 5); u.bt = pn; }
        return true;
    }
};

typedef int i32x4v __attribute__((ext_vector_type(4))); typedef int i32x8v __attribute__((ext_vector_type(8)));
__device__ __forceinline__ i32x8v cat16(const bf16x8 a, const bf16x8 b) { const i32x4v x = __builtin_bit_cast(i32x4v, a), y = __builtin_bit_cast(i32x4v, b); return (i32x8v){x[0], x[1], x[2], x[3], y[0], y[1], y[2], y[3]}; }
template <class Epi, bool ALIGN_EPI, bool GATHER = false, bool FP8 = false, class Order = StaticOrder>
__device__ __forceinline__ void gemm_phase(LAS unsigned char* lds, const Gemm g, const Order& S, const Epi& E, int tid) {
    asm volatile("" : "+v"(tid));
    const int wid = __builtin_amdgcn_readfirstlane(tid >> 6), lane = tid & 63, wr = wid >> 2, wc = wid & 3, fr = lane & 15, fq = lane >> 4;
    const int K = g.K, nt = K / BK;
    unsigned voffA[2], voffB[2]; int RA[2], CA[2];
#pragma unroll
    for (int i = 0; i < 2; ++i) { int R, C; stage_rc(tid * 16 + i * 8192, R, C); const int Rb = Epi::PERM ? ((R & ~31) + perm32(R & 31)) : R;
        RA[i] = R; CA[i] = C; voffA[i] = (unsigned)(R * g.lda + C) * 2u; voffB[i] = (unsigned)(Rb * g.ldb + C) * 2u; }
    unsigned voffAc[2][2], voffAn[2][2];
#define PG8_GOFF(dst, pm_) do { _Pragma("unroll") for (int _h = 0; _h < 2; ++_h) _Pragma("unroll") for (int _i = 0; _i < 2; ++_i) \
        dst[_h][_i] = (unsigned)(g.rowtok[(pm_) * BM + _h * HALF + RA[_i]] * g.lda + CA[_i]) * 2u; } while (0)
#define PG8_STAGE_A(bufoff, ptr_ng, kidx, half, usenext) do { if constexpr (GATHER) { const char* gb_ = (const char*)g.A + (size_t)(kidx) * kstep; \
        _Pragma("unroll") for (int _i = 0; _i < 2; ++_i) { const unsigned vo_ = (usenext) ? voffAn[half][_i] : voffAc[half][_i]; \
            __builtin_amdgcn_global_load_lds((const unsigned*)(gb_ + vo_), (LAS unsigned*)(lds + (bufoff) + ldsw + _i * 8192), 16, 0, 0); } } \
        else { PG8_STAGE(bufoff, (ptr_ng) + ((half) ? hsA : 0), voffA); } } while (0)
    const size_t kstep = (size_t)(BK * 2);
    const size_t hsA = (size_t)HALF * g.lda * 2, hsB = (size_t)HALF * g.ldb * 2;
    const size_t tsA = 2 * hsA, tsB = 2 * hsB;
    const unsigned ldsw = (unsigned)wid * 1024u;
    const int aoff = lds_byte(wr * 64 + fr, fq * 8), boff = lds_byte(wc * 32 + fr, fq * 8);
#define PG8_SA(b, h) (((b) * 2 + (h)) * HTB)
#define PG8_SB(b, h) ((4 + (b) * 2 + (h)) * HTB)
#define PG8_STAGE(bufoff, gbase, voff) do { _Pragma("unroll") for (int _i = 0; _i < 2; ++_i) \
        __builtin_amdgcn_global_load_lds((const unsigned*)((const char*)(gbase) + (voff)[_i]), (LAS unsigned*)(lds + (bufoff) + ldsw + _i * 8192), 16, 0, 0); } while (0)
#define PG8_LDA(dst, b, h) do { if constexpr (FP8) { _Pragma("unroll") for (int m = 0; m < 4; ++m) dst##8[m] = cat16(*(const LAS bf16x8*)(lds + PG8_SA(b, h) + aoff + m * 2048), *(const LAS bf16x8*)(lds + PG8_SA(b, h) + aoff + m * 2048 + 1024)); } \
        else { _Pragma("unroll") for (int m = 0; m < 4; ++m) _Pragma("unroll") for (int k = 0; k < 2; ++k) dst[m][k] = *(const LAS bf16x8*)(lds + PG8_SA(b, h) + aoff + m * 2048 + k * 1024); } } while (0)
#define PG8_LDB(dst, b, h) do { if constexpr (FP8) { _Pragma("unroll") for (int n = 0; n < 2; ++n) dst##8[n] = cat16(*(const LAS bf16x8*)(lds + PG8_SB(b, h) + boff + n * 2048), *(const LAS bf16x8*)(lds + PG8_SB(b, h) + boff + n * 2048 + 1024)); } \
        else { _Pragma("unroll") for (int n = 0; n < 2; ++n) _Pragma("unroll") for (int k = 0; k < 2; ++k) dst[n][k] = *(const LAS bf16x8*)(lds + PG8_SB(b, h) + boff + n * 2048 + k * 1024); } } while (0)
#define PG8_MMA(ai, bj, At, Bt) do { __builtin_amdgcn_s_setprio(1); _Pragma("unroll") for (int m = 0; m < 4; ++m) _Pragma("unroll") for (int n = 0; n < 2; ++n) { \
        if constexpr (FP8) asm volatile("v_mfma_scale_f32_16x16x128_f8f6f4 %0, %1, %2, %0, %3, %3 op_sel_hi:[0,0,0]" : "+v"(acc[ai][bj][m][n]) : "v"(Bt##8[n]), "v"(At##8[m]), "v"(mx_one)); \
        else { _Pragma("unroll") for (int k = 0; k < 2; ++k) acc[ai][bj][m][n] = __builtin_amdgcn_mfma_f32_16x16x32_bf16(Bt[n][k], At[m][k], acc[ai][bj][m][n], 0, 0, 0); } } \
        __builtin_amdgcn_s_setprio(0); } while (0)
#define PG8_WAIT_V(n) asm volatile("s_waitcnt vmcnt(" #n ")" ::: "memory")
#define PG8_WAIT_L(n) asm volatile("s_waitcnt lgkmcnt(" #n ")" ::: "memory")
#define PG8_BAR __builtin_amdgcn_s_barrier()
#define PG8_SCHED __builtin_amdgcn_sched_barrier(0)
    Unit cur, nxt; int ui = 0;
    if (!S.next(0, cur)) return;
    f32x4 acc[2][2][4][2];
#pragma unroll
    for (int a = 0; a < 2; ++a)
#pragma unroll
        for (int b = 0; b < 2; ++b)
#pragma unroll
            for (int m = 0; m < 4; ++m)
#pragma unroll
                for (int n = 0; n < 2; ++n) acc[a][b][m][n] = (f32x4){0.f, 0.f, 0.f, 0.f};
    bf16x8 At[4][2], B0[2][2], B1[2][2];
    i32x8v At8[4], B08[2], B18[2];
    const int mx_one = 0x7F7F7F7F;
    const char* cA = (const char*)g.A + (size_t)cur.br * g.abr + (size_t)cur.pm * tsA; const char* cB = (const char*)g.Bt + (size_t)cur.bt * tsB + (cur.hf == 2 ? hsB : 0);
    size_t hoC = cur.hf ? 0 : hsB;
    if constexpr (GATHER) { PG8_GOFF(voffAc, cur.pm); PG8_GOFF(voffAn, cur.pm); }
    PG8_STAGE(PG8_SB(0, 0), cB, voffB); PG8_STAGE(PG8_SB(0, 1), cB + hoC, voffB); PG8_STAGE_A(PG8_SA(0, 0), cA, 0, 0, false); PG8_STAGE_A(PG8_SA(0, 1), cA, 0, 1, false);
    if (wr == 1) PG8_BAR;
    PG8_WAIT_V(2); PG8_BAR;
    PG8_STAGE(PG8_SB(1, 0), cB + kstep, voffB); PG8_STAGE_A(PG8_SA(1, 0), cA + kstep, 1, 0, false); PG8_STAGE(PG8_SB(1, 1), cB + hoC + kstep, voffB);
    PG8_WAIT_V(6); PG8_BAR;
    for (;;) {
        const bool has_next = S.next(ui + 1, nxt);
        const char* nA = has_next ? (const char*)g.A + (size_t)nxt.br * g.abr + (size_t)nxt.pm * tsA : cA; const char* nB = has_next ? (const char*)g.Bt + (size_t)nxt.bt * tsB + (nxt.hf == 2 ? hsB : 0) : cB;
        const size_t hoN = has_next ? (nxt.hf ? 0 : hsB) : hoC; const bool whole = cur.hf == 0;
        if constexpr (GATHER) { if (has_next) PG8_GOFF(voffAn, nxt.pm); }
#pragma unroll 1
        for (int t = 0; t < nt; t += 2) {
            const bool last = (t == nt - 2);
            const bool un = last && has_next;
            const int k2 = last ? 0 : t + 2;
            const char* a1 = cA + (size_t)(t + 1) * kstep;
            const char* a2 = last ? nA : cA + (size_t)(t + 2) * kstep; const char* b2 = last ? nB : cB + (size_t)(t + 2) * kstep;
            const char* a3 = a2 + kstep; const char* b3 = b2 + kstep; const size_t ho2 = last ? hoN : hoC;
            PG8_LDB(B0, 0, 0); if (whole) PG8_LDB(B1, 0, 1); PG8_SCHED; PG8_LDA(At, 0, 0); PG8_STAGE_A(PG8_SA(1, 1), a1, t + 1, 1, false);
            PG8_WAIT_V(8); PG8_WAIT_L(0); PG8_BAR; PG8_MMA(0, 0, At, B0); if (whole) PG8_MMA(0, 1, At, B1); PG8_BAR; PG8_SCHED;
            PG8_LDA(At, 0, 1); PG8_STAGE(PG8_SB(0, 0), b2, voffB); PG8_STAGE(PG8_SB(0, 1), b2 + ho2, voffB); PG8_STAGE_A(PG8_SA(0, 0), a2, k2, 0, un);
            PG8_WAIT_V(8); PG8_WAIT_L(0); PG8_BAR; PG8_MMA(1, 0, At, B0); if (whole) PG8_MMA(1, 1, At, B1); PG8_BAR; PG8_SCHED;
            PG8_LDB(B0, 1, 0); if (whole) PG8_LDB(B1, 1, 1); PG8_SCHED; PG8_LDA(At, 1, 0); PG8_STAGE_A(PG8_SA(0, 1), a2, k2, 1, un);
            PG8_WAIT_V(8); PG8_WAIT_L(0); PG8_BAR; PG8_MMA(0, 0, At, B0); if (whole) PG8_MMA(0, 1, At, B1); PG8_BAR; PG8_SCHED;
            PG8_LDA(At, 1, 1); PG8_STAGE(PG8_SB(1, 0), b3, voffB); PG8_STAGE(PG8_SB(1, 1), b3 + ho2, voffB); PG8_STAGE_A(PG8_SA(1, 0), a3, k2 + 1, 0, un);
            PG8_WAIT_V(8); PG8_WAIT_L(0); PG8_BAR; PG8_MMA(1, 0, At, B0); if (whole) PG8_MMA(1, 1, At, B1); PG8_BAR; PG8_SCHED;
        }
        if constexpr (ALIGN_EPI) { if (wr == 0) PG8_BAR; }
        if constexpr (FP8) asm volatile("s_nop 15\n\ts_nop 15\n\ts_nop 15\n\ts_nop 15" ::: "memory");
        E(acc, cur, wr, wc, fr, fq);
        if (!has_next) break;
        if (!(Epi::CARRY && cur.br < 2)) {
#pragma unroll
        for (int a = 0; a < 2; ++a)
#pragma unroll
            for (int b = 0; b < 2; ++b)
#pragma unroll
                for (int m = 0; m < 4; ++m)
#pragma unroll
                    for (int n = 0; n < 2; ++n) acc[a][b][m][n] = (f32x4){0.f, 0.f, 0.f, 0.f};
        }
        cur = nxt; cA = nA; cB = nB; hoC = hoN; ++ui;
        if constexpr (GATHER) { _Pragma("unroll") for (int _h = 0; _h < 2; ++_h) _Pragma("unroll") for (int _i = 0; _i < 2; ++_i) voffAc[_h][_i] = voffAn[_h][_i]; }
        if constexpr (ALIGN_EPI) { if (wr == 1) PG8_BAR; }
    }
    PG8_WAIT_V(0);
    if constexpr (!ALIGN_EPI) { if (wr == 0) PG8_BAR; }
    PG8_BAR;
#undef PG8_SA
#undef PG8_SB
#undef PG8_STAGE
#undef PG8_STAGE_A
#undef PG8_GOFF
#undef PG8_LDA
#undef PG8_LDB
#undef PG8_MMA
#undef PG8_WAIT_V
#undef PG8_WAIT_L
#undef PG8_BAR
#undef PG8_SCHED
}

__device__ __forceinline__ u32x4 pack8(const f32x4 v0, const f32x4 v1) { u32x4 w; w.x = cvtpk(v0[0], v0[1]); w.y = cvtpk(v0[2], v0[3]); w.z = cvtpk(v1[0], v1[1]); w.w = cvtpk(v1[2], v1[3]); return w; }

struct EpiInProj {
    static constexpr bool PERM = true, CARRY = false;
    bf16 *QA, *KA, *VA, *MLX, *MLO, *WQ, *WK, *WV, *GT; const f32x2* rope; float ds;
    __device__ __forceinline__ void operator()(const f32x4 (&acc)[2][2][4][2], const Unit& u, int wr, int wc, int fr, int fq) const {
        const int pn = u.pn, row0 = u.pm * BM + wr * 64 + fr, c0 = wc * 32 + 8 * fq;
        bf16* base; int W, extraB, radd0, radd1, cadd0, cadd1, mode;
        float qs = 1.f; int f8 = 0;
        if (pn < 2)       { base = QA; W = 64; extraB = 7 * SEQ; radd0 = radd1 = (4 * pn + wc) * SEQ; cadd0 = 8 * fq; cadd1 = 32 + 8 * fq; mode = 1; f8 = 1; qs = 1.4426950408889634f; }
        else if (pn < 4)  { base = KA; W = 64; extraB = 7 * SEQ; radd0 = radd1 = (4 * (pn - 2) + wc) * SEQ; cadd0 = 8 * fq; cadd1 = 32 + 8 * fq; mode = 1; f8 = 1; }
        else if (pn < 6)  { base = VA; W = 128; extraB = 3 * SEQ; radd0 = ((pn - 4) * 2) * SEQ; radd1 = ((pn - 4) * 2 + 1) * SEQ; cadd0 = cadd1 = c0; mode = 0; f8 = 2; }
        else if (pn < 8)  { base = MLX; W = 512; extraB = 0; radd0 = radd1 = 0; cadd0 = (pn - 6) * 256 + c0; cadd1 = cadd0 + 128; mode = 0; }
        else if (pn < 10) { base = MLO; W = 512; extraB = 0; radd0 = radd1 = 0; cadd0 = (pn - 8) * 256 + c0; cadd1 = cadd0 + 128; mode = 0; }
        else if (pn < 12) { base = WQ; W = 64; extraB = 7 * SEQ; radd0 = radd1 = (4 * (pn - 10) + wc) * SEQ; cadd0 = 8 * fq; cadd1 = 32 + 8 * fq; mode = 1; }
        else if (pn == 12) {
            if (wc < 2)   { base = WK; W = 64; extraB = SEQ; radd0 = radd1 = wc * SEQ; cadd0 = 8 * fq; cadd1 = 32 + 8 * fq; mode = 1; }
            else          { base = WV; W = 64; extraB = SEQ; radd0 = 0; radd1 = SEQ; cadd0 = cadd1 = (wc - 2) * 32 + 8 * fq; mode = 0; }
        }
        else              { base = GT; W = 3072; extraB = 0; radd0 = radd1 = 0; cadd0 = (pn - 13) * 256 + c0; cadd1 = cadd0 + 128; mode = 2; }
#pragma unroll
        for (int ai = 0; ai < 2; ++ai)
#pragma unroll
            for (int m = 0; m < 4; ++m) {
                const int row = row0 + ai * HALF + m * 16, b = row >> 13, s = row & (SEQ - 1);
                f32x4 l0 = acc[ai][0][m][0] * ds, l1 = acc[ai][0][m][1] * ds, h0 = acc[ai][1][m][0] * ds, h1 = acc[ai][1][m][1] * ds;
                if (mode == 1) {
                    const f32x4* rp = (const f32x4*)(rope + (size_t)s * 32 + 8 * fq);
                    const f32x4 r0 = rp[0], r1 = rp[1], r2 = rp[2], r3 = rp[3];
                    f32x4 nl0, nl1, nh0, nh1;
                    nl0[0] = l0[0] * r0[0] - h0[0] * r0[1]; nh0[0] = h0[0] * r0[0] + l0[0] * r0[1];
                    nl0[1] = l0[1] * r0[2] - h0[1] * r0[3]; nh0[1] = h0[1] * r0[2] + l0[1] * r0[3];
                    nl0[2] = l0[2] * r1[0] - h0[2] * r1[1]; nh0[2] = h0[2] * r1[0] + l0[2] * r1[1];
                    nl0[3] = l0[3] * r1[2] - h0[3] * r1[3]; nh0[3] = h0[3] * r1[2] + l0[3] * r1[3];
                    nl1[0] = l1[0] * r2[0] - h1[0] * r2[1]; nh1[0] = h1[0] * r2[0] + l1[0] * r2[1];
                    nl1[1] = l1[1] * r2[2] - h1[1] * r2[3]; nh1[1] = h1[1] * r2[2] + l1[1] * r2[3];
                    nl1[2] = l1[2] * r3[0] - h1[2] * r3[1]; nh1[2] = h1[2] * r3[0] + l1[2] * r3[1];
                    nl1[3] = l1[3] * r3[2] - h1[3] * r3[3]; nh1[3] = h1[3] * r3[2] + l1[3] * r3[3];
                    l0 = nl0 * qs; l1 = nl1 * qs; h0 = nh0 * qs; h1 = nh1 * qs;
                } else if (mode == 2) {
#pragma unroll
                    for (int j = 0; j < 4; ++j) { l0[j] = sigmoidf_(l0[j]); l1[j] = sigmoidf_(l1[j]); h0[j] = sigmoidf_(h0[j]); h1[j] = sigmoidf_(h1[j]); }
                }
                const size_t rb = (size_t)row + (size_t)b * extraB;
                if (f8 == 1) {
                    unsigned char* b8 = (unsigned char*)base;
                    *(u32x2*)(b8 + (rb + radd0) * 64 + cadd0) = (u32x2){pk4_fp8(l0[0], l0[1], l0[2], l0[3]), pk4_fp8(l1[0], l1[1], l1[2], l1[3])};
                    *(u32x2*)(b8 + (rb + radd1) * 64 + cadd1) = (u32x2){pk4_fp8(h0[0], h0[1], h0[2], h0[3]), pk4_fp8(h1[0], h1[1], h1[2], h1[3])};
                } else if (f8 == 2) {
                    const int kk = s & 63, pos = ((kk >> 2) & 1) * 32 + (kk >> 5) * 16 + (kk & 3) + 4 * ((kk & 31) >> 3);
                    unsigned char* b8 = (unsigned char*)base + (((size_t)(b * 4 + (pn - 4) * 2) * 128 + (s >> 6)) * 128 + c0) * 64 + pos;
                    const unsigned w0 = pk4_fp8(l0[0], l0[1], l0[2], l0[3]), w1 = pk4_fp8(l1[0], l1[1], l1[2], l1[3]);
                    const unsigned w2 = pk4_fp8(h0[0], h0[1], h0[2], h0[3]), w3 = pk4_fp8(h1[0], h1[1], h1[2], h1[3]);
#pragma unroll
                    for (int j = 0; j < 4; ++j) { b8[j * 64] = (unsigned char)(w0 >> (8 * j)); b8[(4 + j) * 64] = (unsigned char)(w1 >> (8 * j));
                        b8[(size_t)128 * 128 * 64 + j * 64] = (unsigned char)(w2 >> (8 * j)); b8[(size_t)128 * 128 * 64 + (4 + j) * 64] = (unsigned char)(w3 >> (8 * j)); }
                } else {
                if (u.hf != 2) *(u32x4*)(base + (rb + radd0) * W + cadd0) = pack8(l0, l1);
                if (u.hf == 0) *(u32x4*)(base + (rb + radd1) * W + cadd1) = pack8(h0, h1);
                if (u.hf == 2) *(u32x4*)(base + (rb + radd1) * W + cadd1) = pack8(l0, l1);
                }
            }
    }
};


struct EpiMerge {
    static constexpr bool PERM = true, CARRY = true;
    const bf16* GT; bf16* MB;
    __device__ __forceinline__ void operator()(f32x4 (&acc)[2][2][4][2], const Unit& u, int wr, int wc, int fr, int fq) const {
        const int row0 = u.pm * BM + wr * 64 + fr, col0 = u.pn * BM + wc * 32 + 8 * fq, br = u.br, brn = br < 2 ? br + 1 : 2;
#pragma unroll
        for (int ai = 0; ai < 2; ++ai)
#pragma unroll
            for (int mp = 0; mp < 2; ++mp) {
                u32x4 gw[2][2], gn[2][2];
#pragma unroll
                for (int mm = 0; mm < 2; ++mm)
#pragma unroll
                    for (int bj = 0; bj < 2; ++bj) { const size_t row = (size_t)(row0 + ai * HALF + (mp * 2 + mm) * 16); const int col = col0 + bj * HALF;
                        gw[mm][bj] = *(const u32x4*)(GT + row * 3072 + br * 1024 + col); gn[mm][bj] = *(const u32x4*)(GT + row * 3072 + brn * 1024 + col); }
#pragma unroll
                for (int mm = 0; mm < 2; ++mm)
#pragma unroll
                    for (int bj = 0; bj < 2; ++bj) { const size_t row = (size_t)(row0 + ai * HALF + (mp * 2 + mm) * 16); const int col = col0 + bj * HALF; const int m = mp * 2 + mm;
                        const u32x4 g = gw[mm][bj], d = gn[mm][bj];
                        float f[8] = {bflo(g.x), bfhi(g.x), bflo(g.y), bfhi(g.y), bflo(g.z), bfhi(g.z), bflo(g.w), bfhi(g.w)};
#pragma unroll
                        for (int j = 0; j < 8; ++j) f[j] = fmaxf(f[j], 1e-30f);
                        if (br < 2) { const float dd[8] = {bflo(d.x), bfhi(d.x), bflo(d.y), bfhi(d.y), bflo(d.z), bfhi(d.z), bflo(d.w), bfhi(d.w)};
#pragma unroll
                            for (int j = 0; j < 8; ++j) f[j] *= __builtin_amdgcn_rcpf(fmaxf(dd[j], 1e-30f)); }
                        f32x4 v0 = acc[ai][bj][m][0], v1 = acc[ai][bj][m][1];
                        v0[0] *= f[0]; v0[1] *= f[1]; v0[2] *= f[2]; v0[3] *= f[3]; v1[0] *= f[4]; v1[1] *= f[5]; v1[2] *= f[6]; v1[3] *= f[7];
                        if (br < 2) { acc[ai][bj][m][0] = v0; acc[ai][bj][m][1] = v1; }
                        else *(u32x4*)(MB + row * 1024 + col) = pack8(v0, v1); }
            }
    }
};

struct EpiOut {
    static constexpr bool PERM = true, CARRY = false;
    const bf16* resid; bf16* Z;
    __device__ __forceinline__ void operator()(const f32x4 (&acc)[2][2][4][2], const Unit& u, int wr, int wc, int fr, int fq) const {
        const int row0 = u.pm * BM + wr * 64 + fr, col0 = u.pn * BM + wc * 32 + 8 * fq;
#pragma unroll
        for (int ai = 0; ai < 2; ++ai) {
            u32x4 rr[4][2];
#pragma unroll
            for (int m = 0; m < 4; ++m)
#pragma unroll
                for (int bj = 0; bj < 2; ++bj) rr[m][bj] = *(const u32x4*)(resid + (size_t)(row0 + ai * HALF + m * 16) * 1024 + col0 + bj * HALF);
#pragma unroll
            for (int m = 0; m < 4; ++m)
#pragma unroll
                for (int bj = 0; bj < 2; ++bj) { const u32x4 g = rr[m][bj];
                    f32x4 v0 = acc[ai][bj][m][0], v1 = acc[ai][bj][m][1];
                    v0[0] += DN_ALPHA * bflo(g.x); v0[1] += DN_ALPHA * bfhi(g.x); v0[2] += DN_ALPHA * bflo(g.y); v0[3] += DN_ALPHA * bfhi(g.y);
                    v1[0] += DN_ALPHA * bflo(g.z); v1[1] += DN_ALPHA * bfhi(g.z); v1[2] += DN_ALPHA * bflo(g.w); v1[3] += DN_ALPHA * bfhi(g.w);
                    *(u32x4*)(Z + (size_t)(row0 + ai * HALF + m * 16) * 1024 + col0 + bj * HALF) = pack8(v0, v1); }
        }
    }
};

struct EpiSwiglu {
    static constexpr bool PERM = true, CARRY = false;
    const float* bgu  ; const int* tile_e; unsigned char* ACT8_;
    __device__ __forceinline__ void operator()(const f32x4 (&acc)[2][2][4][2], const Unit& u, int wr, int wc, int fr, int fq) const {
        const int e = __builtin_amdgcn_readfirstlane(tile_e[u.pm]);
        const int row0 = u.pm * BM + wr * 64 + fr, cl0 = u.pn * BM + wc * 32 + 8 * fq;
        constexpr float ds = 1.0f / W8_GU_SCALE;
        f32x4 bv[2][2];
#pragma unroll
        for (int bj = 0; bj < 2; ++bj) { bv[bj][0] = *(const f32x4*)(bgu + (size_t)e * 2048 + cl0 + bj * HALF); bv[bj][1] = *(const f32x4*)(bgu + (size_t)e * 2048 + cl0 + bj * HALF + 4); }
#pragma unroll
        for (int ai = 0; ai < 2; ++ai)
#pragma unroll
            for (int m = 0; m < 4; ++m) {
                const size_t row = (size_t)(row0 + ai * HALF + m * 16);
#pragma unroll
                for (int bj = 0; bj < 2; ++bj) {
                    const f32x4 v0 = acc[ai][bj][m][0] * ds + bv[bj][0], v1 = acc[ai][bj][m][1] * ds + bv[bj][1];
                    float a[4];
                    { float g = fminf(v0[0], 7.f), up = fminf(fmaxf(v0[1], -7.f), 7.f); a[0] = g * sigmoidf_(1.702f * g) * (up + 1.f); }
                    { float g = fminf(v0[2], 7.f), up = fminf(fmaxf(v0[3], -7.f), 7.f); a[1] = g * sigmoidf_(1.702f * g) * (up + 1.f); }
                    { float g = fminf(v1[0], 7.f), up = fminf(fmaxf(v1[1], -7.f), 7.f); a[2] = g * sigmoidf_(1.702f * g) * (up + 1.f); }
                    { float g = fminf(v1[2], 7.f), up = fminf(fmaxf(v1[3], -7.f), 7.f); a[3] = g * sigmoidf_(1.702f * g) * (up + 1.f); }
                    *(unsigned*)(ACT8_ + row * 1024 + ((cl0 + bj * HALF) >> 1)) = pk4_fp8(a[0], a[1], a[2], a[3]);
                }
            }
    }
};

struct EpiDown {
    static constexpr bool PERM = true, CARRY = false;
    const float* bdn  ; const int* tile_e; const float* roww; unsigned char* YS;
    __device__ __forceinline__ void operator()(const f32x4 (&acc)[2][2][4][2], const Unit& u, int wr, int wc, int fr, int fq) const {
        const int e = __builtin_amdgcn_readfirstlane(tile_e[u.pm]);
        const int row0 = u.pm * BM + wr * 64 + fr, cl0 = u.pn * BM + wc * 32 + 8 * fq + (u.hf == 2 ? HALF : 0), nbj = u.hf ? 1 : 2;
        constexpr float ds = 1.0f / W8_DN_SCALE;
        f32x4 bv[2][2];
#pragma unroll
        for (int bj = 0; bj < 2; ++bj) { bv[bj][0] = *(const f32x4*)(bdn + (size_t)e * 1024 + cl0 + bj * HALF); bv[bj][1] = *(const f32x4*)(bdn + (size_t)e * 1024 + cl0 + bj * HALF + 4); }
        float rwv[2][4];
#pragma unroll
        for (int ai = 0; ai < 2; ++ai)
#pragma unroll
            for (int m = 0; m < 4; ++m) rwv[ai][m] = roww[row0 + ai * HALF + m * 16] * YS8_SCALE;
#pragma unroll
        for (int ai = 0; ai < 2; ++ai)
#pragma unroll
            for (int m = 0; m < 4; ++m) {
                const size_t row = (size_t)(row0 + ai * HALF + m * 16);
                const float rw = rwv[ai][m];
#pragma unroll
                for (int bj = 0; bj < 2; ++bj) if (bj < nbj) {
                    const f32x4 v0 = (acc[ai][bj][m][0] * ds + bv[bj][0]) * rw, v1 = (acc[ai][bj][m][1] * ds + bv[bj][1]) * rw;
                    *(u32x2*)(YS + row * 1024 + cl0 + bj * HALF) = (u32x2){pk4_fp8(v0[0], v0[1], v0[2], v0[3]), pk4_fp8(v1[0], v1[1], v1[2], v1[3])};
                }
            }
    }
};
}

namespace att {
constexpr int QBLK = 32, KVBLK = 64;
constexpr int SHM_V = 16384, SHM_K = 8192;
constexpr int NBUF = 3, OFF_V = 0, OFF_K = NBUF * SHM_V, OFF_WS = NBUF * SHM_V + NBUF * SHM_K;
constexpr float SCALE = 0.125f, THR = 8.f;
#define KSWZ(row, colB) ((row) * 128 + ((colB) ^ (((row) & 7) << 4)))
#define SBAR() __builtin_amdgcn_sched_barrier(0)
__device__ __forceinline__ int crow(int r, int hi) { return (r & 3) + 8 * (r >> 2) + 4 * hi; }

__device__ __forceinline__ void partialSM(f32x16& p0, f32x16& p1, float& m_reg, float& mn, float& alpha) {
    constexpr float C = SCALE * 1.4426950408889634f;
    float pmax = p0[0];
#pragma unroll
    for (int r = 1; r < 16; ++r) pmax = fmaxf(pmax, p0[r]);
#pragma unroll
    for (int r = 0; r < 16; ++r) pmax = fmaxf(pmax, p1[r]);
    { auto rr = __builtin_amdgcn_permlane32_swap(__float_as_uint(pmax), __float_as_uint(pmax), false, false);
      pmax = fmaxf(__uint_as_float(rr[0]), __uint_as_float(rr[1])); }
    if (__builtin_expect(__all(pmax - m_reg <= THR / SCALE), 1)) { mn = m_reg; alpha = 1.f; }
    else { mn = fmaxf(m_reg, pmax); alpha = __builtin_amdgcn_exp2f((m_reg - mn) * C); m_reg = mn; }
    const float mnC = -mn * C;
#pragma unroll
    for (int r = 0; r < 16; ++r) p0[r] = fmaf(p0[r], C, mnC);
#pragma unroll
    for (int r = 0; r < 16; ++r) p1[r] = fmaf(p1[r], C, mnC);
#pragma unroll
    for (int r = 0; r < 16; ++r) p0[r] = __builtin_amdgcn_exp2f(p0[r]);
}
__device__ __forceinline__ void finishSM(f32x16& p0, f32x16& p1, float alpha, float& l_reg, bf16x8& pa0, bf16x8& pa1, bf16x8& pa2, bf16x8& pa3) {
#pragma unroll
    for (int r = 0; r < 16; ++r) p1[r] = __builtin_amdgcn_exp2f(p1[r]);
    float ps = 0;
#pragma unroll
    for (int r = 0; r < 16; ++r) ps += p0[r];
#pragma unroll
    for (int r = 0; r < 16; ++r) ps += p1[r];
    { auto rr = __builtin_amdgcn_permlane32_swap(__float_as_uint(ps), __float_as_uint(ps), false, false);
      ps = __uint_as_float(rr[0]) + __uint_as_float(rr[1]); }
    l_reg = l_reg * alpha + ps;
#define PK4(P, BASE, OUT) do { unsigned a0 = cvtpk(P[BASE + 0], P[BASE + 1]), a1 = cvtpk(P[BASE + 2], P[BASE + 3]);   \
    unsigned b0 = cvtpk(P[BASE + 4], P[BASE + 5]), b1 = cvtpk(P[BASE + 6], P[BASE + 7]);                              \
    auto r0 = __builtin_amdgcn_permlane32_swap(a0, b0, false, false); auto r1 = __builtin_amdgcn_permlane32_swap(a1, b1, false, false); \
    u32x4 w = {r0[0], r1[0], r0[1], r1[1]}; OUT = *reinterpret_cast<bf16x8*>(&w); } while (0)
    PK4(p0, 0, pa0); PK4(p0, 8, pa1); PK4(p1, 0, pa2); PK4(p1, 8, pa3);
#undef PK4
}
__device__ __forceinline__ void qkt(f32x16& p0, f32x16& p1, const char* Ks, const bf16x8* qr, int r32, int hi) {
    p0 = f32x16{}; p1 = f32x16{};
#pragma unroll
    for (int d0 = 0; d0 < 4; ++d0) { const int cb = (d0 * 16 + hi * 8) * 2;
        const bf16x8 b0 = *reinterpret_cast<const bf16x8*>(Ks + KSWZ(r32, cb));
        const bf16x8 b1 = *reinterpret_cast<const bf16x8*>(Ks + KSWZ(32 + r32, cb));
        p0 = __builtin_amdgcn_mfma_f32_32x32x16_bf16(b0, qr[d0], p0, 0, 0, 0);
        p1 = __builtin_amdgcn_mfma_f32_32x32x16_bf16(b1, qr[d0], p1, 0, 0, 0); }
}
__device__ __forceinline__ void qkt_n(f32x16& p0, f32x16& p1, const char* Ks, const bf16x8* qr, const f32x16& negm, int r32, int hi) {
#pragma unroll
    for (int d0 = 0; d0 < 4; ++d0) { const int cb = (d0 * 16 + hi * 8) * 2;
        const bf16x8 b0 = *reinterpret_cast<const bf16x8*>(Ks + KSWZ(r32, cb));
        const bf16x8 b1 = *reinterpret_cast<const bf16x8*>(Ks + KSWZ(32 + r32, cb));
        if (d0 == 0) { p0 = __builtin_amdgcn_mfma_f32_32x32x16_bf16(b0, qr[0], negm, 0, 0, 0); p1 = __builtin_amdgcn_mfma_f32_32x32x16_bf16(b1, qr[0], negm, 0, 0, 0); }
        else { p0 = __builtin_amdgcn_mfma_f32_32x32x16_bf16(b0, qr[d0], p0, 0, 0, 0); p1 = __builtin_amdgcn_mfma_f32_32x32x16_bf16(b1, qr[d0], p1, 0, 0, 0); } }
}
template <bool FIRST> __device__ __forceinline__ void partialSM_n(f32x16& p0, f32x16& p1, float& M, f32x16& negm, float& alpha) {
    float pmax = p0[0];
#pragma unroll
    for (int r = 1; r < 16; ++r) pmax = fmaxf(pmax, p0[r]);
#pragma unroll
    for (int r = 0; r < 16; ++r) pmax = fmaxf(pmax, p1[r]);
    { auto rr = __builtin_amdgcn_permlane32_swap(__float_as_uint(pmax), __float_as_uint(pmax), false, false);
      pmax = fmaxf(__uint_as_float(rr[0]), __uint_as_float(rr[1])); }
    if (!FIRST && __builtin_expect(__all(pmax <= THR * 1.4426950408889634f), 1)) { alpha = 1.f; }
    else { const float d = FIRST ? pmax : fmaxf(pmax, 0.f); alpha = __builtin_amdgcn_exp2f(-d); M += d;
#pragma unroll
        for (int r = 0; r < 16; ++r) { p0[r] -= d; p1[r] -= d; }
        const float nm = -M;
#pragma unroll
        for (int r = 0; r < 16; ++r) negm[r] = nm; }
#pragma unroll
    for (int r = 0; r < 16; ++r) p0[r] = __builtin_amdgcn_exp2f(p0[r]);
}
__device__ __forceinline__ int v_st(int k, int c) { const int kk = (k & ~0xC) | ((k & 4) << 1) | ((k & 8) >> 1); return ((kk >> 3) * 4 + (c >> 5)) * 512 + ((kk & 7) * 32 + (c & 31)) * 2; }
__device__ __forceinline__ int v_rd_base(int lane) { return ((lane & 3) << 3) | (((lane >> 2) & 3) << 6) | (((lane >> 4) & 1) << 5) | (((lane >> 5) & 1) << 8); }
constexpr int v_rd_off(int d0, int ks, int half) { return d0 * 512 + ks * 4096 + half * 2048; }
template <int OFF> __device__ __forceinline__ s16x4 tr_read(int vb) {
    s16x4 r; asm volatile("ds_read_b64_tr_b16 %0, %1 offset:%2" : "=&v"(r) : "v"(vb), "i"(OFF) : "memory"); return r;
}
template <int D0, int KS = 4096, int HS = 2048> __device__ __forceinline__ void pv_one(f32x16& od, int vb, bf16x8 pa0, bf16x8 pa1, bf16x8 pa2, bf16x8 pa3) {
    const s16x4 l0 = tr_read<D0 * 512 + 0 * KS>(vb), h0 = tr_read<D0 * 512 + 0 * KS + HS>(vb), l1 = tr_read<D0 * 512 + 1 * KS>(vb), h1 = tr_read<D0 * 512 + 1 * KS + HS>(vb);
    const s16x4 l2 = tr_read<D0 * 512 + 2 * KS>(vb), h2 = tr_read<D0 * 512 + 2 * KS + HS>(vb), l3 = tr_read<D0 * 512 + 3 * KS>(vb), h3 = tr_read<D0 * 512 + 3 * KS + HS>(vb);
    asm volatile("s_waitcnt lgkmcnt(0)" ::: "memory"); SBAR();
#define PK(L, H) (bf16x8){L[0], L[1], L[2], L[3], H[0], H[1], H[2], H[3]}
    od = __builtin_amdgcn_mfma_f32_32x32x16_bf16(pa0, PK(l0, h0), od, 0, 0, 0);
    od = __builtin_amdgcn_mfma_f32_32x32x16_bf16(pa1, PK(l1, h1), od, 0, 0, 0);
    od = __builtin_amdgcn_mfma_f32_32x32x16_bf16(pa2, PK(l2, h2), od, 0, 0, 0);
    od = __builtin_amdgcn_mfma_f32_32x32x16_bf16(pa3, PK(l3, h3), od, 0, 0, 0);
#undef PK
}
template <int NB> __device__ __forceinline__ void pv_all(f32x16* o, int vb, bf16x8 pa0, bf16x8 pa1, bf16x8 pa2, bf16x8 pa3) {
    pv_one<0>(o[0], vb, pa0, pa1, pa2, pa3); pv_one<1>(o[1], vb, pa0, pa1, pa2, pa3);
    if constexpr (NB == 4) { pv_one<2>(o[2], vb, pa0, pa1, pa2, pa3); pv_one<3>(o[3], vb, pa0, pa1, pa2, pa3); }
}
__device__ __forceinline__ void bandmask(f32x16& p0, f32x16& p1, int kt0, int qw0, int r32, int hi) {
    if ((kt0 + 63 - qw0 <= 128) && (qw0 + 31 - kt0 <= 128)) return;
    const int qi = qw0 + r32;
#pragma unroll
    for (int r = 0; r < 16; ++r) { const int d = kt0 + crow(r, hi) - qi;
        if (d > 128 || d < -128) p0[r] = -INFINITY;
        if (d + 32 > 128 || d + 32 < -128) p1[r] = -INFINITY; }
}

template <int NB, bool WIN>
__device__ __forceinline__ void body(const bf16* __restrict__ Qb, const bf16* __restrict__ Kh, const bf16* __restrict__ Vh, int NT,
                                     int kpos0, int qpos0, float sink_l2, f32x16 (&o)[NB], char* lds, int tid) {
    constexpr int DV = 32 * NB;
    asm volatile("" : "+v"(tid));
    const int wid = tid >> 6, lane = tid & 63, r32 = lane & 31, hi = lane >> 5;
    char* V_lds = lds + OFF_V; char* K_lds = lds + OFF_K;
    float* ws = (float*)(lds + OFF_WS) + wid * 64; float* li_l = ws; float* al_l = ws + 32;
    float m_reg = -1e30f, l_reg = 0; bf16x8 qr[4];
#pragma unroll
    for (int d = 0; d < NB; ++d) o[d] = f32x16{};
    const bf16* Qw = Qb + (long)(wid * QBLK + r32) * 64 + hi * 8;
#pragma unroll
    for (int d0 = 0; d0 < 4; ++d0) qr[d0] = *reinterpret_cast<const bf16x8*>(Qw + d0 * 16);
    const int qw0 = qpos0 + wid * QBLK;
    const int ksr = tid >> 3, ksc = (tid & 7) * 8;
    const int kst = KSWZ(ksr, ksc * 2);
    const int vsr = (NB == 4) ? (tid >> 4) : (tid >> 3), vsc = (NB == 4) ? (tid & 15) * 8 : (tid & 7) * 8;
    const int vst0 = v_st(vsr, vsc), vst1 = v_st(32 + vsr, vsc);
    const int vb0 = (int)(uintptr_t)V_lds + v_rd_base(lane);
    struct { bf16x8 vs0, vs1, ks0; } sr_[1];
    unsigned vo0 = (unsigned)(vsr * DV + vsc) * 2u, ko0 = (unsigned)(ksr * 64 + ksc) * 2u;
    asm volatile("" : "+v"(vo0), "+v"(ko0));
#define SLOAD(i, k0) do { const char* vt_ = (const char*)Vh + (size_t)(k0) * (DV * 2); const char* kt_ = (const char*)Kh + (size_t)(k0) * 128; \
    sr_[i].vs0 = *reinterpret_cast<const bf16x8*>(vt_ + vo0); \
    if constexpr (NB == 4) sr_[i].vs1 = *reinterpret_cast<const bf16x8*>(vt_ + 32 * DV * 2 + vo0); \
    sr_[i].ks0 = *reinterpret_cast<const bf16x8*>(kt_ + ko0); } while (0)
#define SWRITE(b, i) do { *(bf16x8*)(V_lds + (b) * SHM_V + vst0) = sr_[i].vs0; \
    if constexpr (NB == 4) *(bf16x8*)(V_lds + (b) * SHM_V + vst1) = sr_[i].vs1; \
    *(bf16x8*)(K_lds + (b) * SHM_K + kst) = sr_[i].ks0; } while (0)
#define SWAIT() do { if constexpr (NB == 4) asm volatile("s_waitcnt vmcnt(3)" ::: "memory"); else asm volatile("s_waitcnt vmcnt(2)" ::: "memory"); } while (0)
#define RESC(a) do { if (__any((a) < 1.f)) { if (hi == 0) al_l[r32] = (a); asm volatile("s_waitcnt lgkmcnt(0)" ::: "memory"); \
    _Pragma("unroll") for (int d = 0; d < NB; ++d) _Pragma("unroll") for (int r = 0; r < 16; ++r) o[d][r] *= al_l[crow(r, hi)]; } } while (0)
#define MASK(P0, P1, t) do { if constexpr (WIN) bandmask(P0, P1, kpos0 + (t) * KVBLK, qw0, r32, hi); } while (0)
    static_assert(!WIN, "the dense body works on pre-scaled Q in the log2 domain; the windowed path is win_unit");
    f32x16 pA0, pA1, pB0, pB1; float alA, alB; bf16x8 pa0, pa1, pa2, pa3;
    f32x16 negm = f32x16{}; m_reg = 0.f;
    constexpr int SE = 0;
    __syncthreads();
    SLOAD(SE, 0); asm volatile("s_waitcnt vmcnt(0)" ::: "memory"); SWRITE(0, SE); __syncthreads();
    qkt_n(pA0, pA1, K_lds, qr, negm, r32, hi); partialSM_n<true>(pA0, pA1, m_reg, negm, alA);
    SLOAD(SE, KVBLK); asm volatile("s_waitcnt vmcnt(0)" ::: "memory"); SWRITE(1, SE); if (2 < NT) SLOAD(SE, 2 * KVBLK);
    int bp = 0, bc = 1, bn = 2;
#define ROT3() do { const int t_ = bp; bp = bc; bc = bn; bn = t_; } while (0)
    for (int j = 1; j + 1 < NT; j += 2) {
        __syncthreads();
        SWRITE(bn, SE);
        SBAR(); qkt_n(pB0, pB1, K_lds + bc * SHM_K, qr, negm, r32, hi);
        finishSM(pA0, pA1, alA, l_reg, pa0, pa1, pa2, pa3); SBAR();
        SLOAD(SE, (j + 2) * KVBLK); SBAR();
        pv_all<NB>(o, vb0 + bp * SHM_V, pa0, pa1, pa2, pa3); partialSM_n<false>(pB0, pB1, m_reg, negm, alB);
        RESC(alB);
        ROT3();
        __syncthreads();
        SWRITE(bn, SE);
        SBAR(); qkt_n(pA0, pA1, K_lds + bc * SHM_K, qr, negm, r32, hi);
        finishSM(pB0, pB1, alB, l_reg, pa0, pa1, pa2, pa3); SBAR();
        if (j + 3 < NT) SLOAD(SE, (j + 3) * KVBLK); SBAR();
        pv_all<NB>(o, vb0 + bp * SHM_V, pa0, pa1, pa2, pa3); partialSM_n<false>(pA0, pA1, m_reg, negm, alA);
        RESC(alA);
        ROT3();
    }
    __syncthreads();
    SBAR(); qkt_n(pB0, pB1, K_lds + bc * SHM_K, qr, negm, r32, hi);
    finishSM(pA0, pA1, alA, l_reg, pa0, pa1, pa2, pa3); SBAR();
    pv_all<NB>(o, vb0 + bp * SHM_V, pa0, pa1, pa2, pa3); partialSM_n<false>(pB0, pB1, m_reg, negm, alB);
    RESC(alB);
    finishSM(pB0, pB1, alB, l_reg, pa0, pa1, pa2, pa3); SBAR();
    pv_all<NB>(o, vb0 + bc * SHM_V, pa0, pa1, pa2, pa3);
#undef ROT3
    if (hi == 0) li_l[r32] = l_reg; asm volatile("s_waitcnt lgkmcnt(0)" ::: "memory");
#pragma unroll
    for (int r = 0; r < 16; ++r) { const float rl = __builtin_amdgcn_rcpf(li_l[crow(r, hi)]);
#pragma unroll
        for (int d = 0; d < NB; ++d) o[d][r] *= rl; }
#undef SLOAD
#undef SWRITE
#undef SWAIT
#undef RESC
#undef MASK
}

constexpr int K8_TILE = 4096, V8_TILE = 8192, BUF8 = K8_TILE + V8_TILE, STG8 = 2 * BUF8, OFF8_WS = 3 * STG8;
constexpr float SH8 = 6.f, LIM8 = 8.f;
__device__ __forceinline__ int sw8(int r, int c) { return r * 64 + ((c ^ ((r >> 2) & 3)) << 4); }
typedef int i32x4a __attribute__((ext_vector_type(4))); typedef int i32x8a __attribute__((ext_vector_type(8)));
__device__ __forceinline__ i32x8a frag8(const char* tile, int row, int hi) {
    const i32x4a x = *reinterpret_cast<const i32x4a*>(tile + sw8(row, 2 * hi)), y = *reinterpret_cast<const i32x4a*>(tile + sw8(row, 2 * hi + 1));
    return (i32x8a){x[0], x[1], x[2], x[3], y[0], y[1], y[2], y[3]};
}
template <bool FIRST> __device__ __forceinline__ void partialSM8(f32x16& p0, f32x16& p1, float& R, f32x16& negm, float& alpha) {
    float pmax = p0[0];
#pragma unroll
    for (int r = 1; r < 16; ++r) pmax = fmaxf(pmax, p0[r]);
#pragma unroll
    for (int r = 0; r < 16; ++r) pmax = fmaxf(pmax, p1[r]);
    { auto rr = __builtin_amdgcn_permlane32_swap(__float_as_uint(pmax), __float_as_uint(pmax), false, false);
      pmax = fmaxf(__uint_as_float(rr[0]), __uint_as_float(rr[1])); }
    if (!FIRST && __builtin_expect(__all(pmax <= LIM8), 1)) { alpha = 1.f; }
    else { const float d = FIRST ? (pmax - SH8) : fmaxf(pmax - SH8, 0.f); alpha = __builtin_amdgcn_exp2f(-d); R += d;
#pragma unroll
        for (int r = 0; r < 16; ++r) { p0[r] -= d; p1[r] -= d; }
        const float nm = -R;
#pragma unroll
        for (int r = 0; r < 16; ++r) negm[r] = nm; }
#pragma unroll
    for (int r = 0; r < 16; ++r) p0[r] = __builtin_amdgcn_exp2f(p0[r]);
}
__device__ __forceinline__ void finishSM8(f32x16& p0, f32x16& p1, i32x8a& pa) {
#pragma unroll
    for (int r = 0; r < 16; ++r) p1[r] = __builtin_amdgcn_exp2f(p1[r]);
#pragma unroll
    for (int i = 0; i < 4; ++i) {
        int w = __builtin_amdgcn_cvt_pk_fp8_f32(p0[4 * i], p0[4 * i + 1], pa[i], false); pa[i] = __builtin_amdgcn_cvt_pk_fp8_f32(p0[4 * i + 2], p0[4 * i + 3], w, true);
        w = __builtin_amdgcn_cvt_pk_fp8_f32(p1[4 * i], p1[4 * i + 1], pa[4 + i], false); pa[4 + i] = __builtin_amdgcn_cvt_pk_fp8_f32(p1[4 * i + 2], p1[4 * i + 3], w, true); }
}
__device__ __forceinline__ float max16(const f32x16& p) {
    float m = fmaxf(p[0], p[1]);
#pragma unroll
    for (int r = 2; r < 16; r += 2) m = fmaxf(fmaxf(m, p[r]), p[r + 1]);
    return m;
}
__device__ __forceinline__ void qkt8(f32x16& p0, f32x16& p1, const char* Kt, const i32x8a& qr, const f32x16& negm, int r32, int hi) {
    const i32x8a k0 = frag8(Kt, r32, hi), k1 = frag8(Kt, 32 + r32, hi);
    const int one = 0x7F7F7F7F, eighth = 0x7C7C7C7C;
    asm volatile("v_mfma_scale_f32_32x32x64_f8f6f4 %0, %1, %2, %3, %4, %5 op_sel_hi:[0,0,0]" : "=&v"(p0) : "v"(k0), "v"(qr), "v"(negm), "v"(one), "v"(eighth));
    asm volatile("v_mfma_scale_f32_32x32x64_f8f6f4 %0, %1, %2, %3, %4, %5 op_sel_hi:[0,0,0]" : "=&v"(p1) : "v"(k1), "v"(qr), "v"(negm), "v"(one), "v"(eighth));
    asm volatile("s_nop 15\n\ts_nop 15\n\ts_nop 7" : "+v"(p0), "+v"(p1));
}
__device__ __forceinline__ void pv8(f32x16 (&o)[4], f32x16& ol, const char* Vt, const i32x8a& pa, int r32, int hi) {
    const int one = 0x7F7F7F7F;
    const int e1 = 0x38383838; const i32x8a ones = (i32x8a){e1, e1, e1, e1, e1, e1, e1, e1};
    asm volatile("s_nop 4" ::: "memory");
    asm volatile("v_mfma_scale_f32_32x32x64_f8f6f4 %0, %1, %2, %0, %3, %3 op_sel_hi:[0,0,0]" : "+v"(ol) : "v"(pa), "v"(ones), "v"(one));
#pragma unroll
    for (int d0 = 0; d0 < 4; ++d0) { const i32x8a vf = frag8(Vt, d0 * 32 + r32, hi);
        asm volatile("v_mfma_scale_f32_32x32x64_f8f6f4 %0, %1, %2, %0, %3, %3 op_sel_hi:[0,0,0]" : "+v"(o[d0]) : "v"(pa), "v"(vf), "v"(one)); }
}
struct CvtJob { const float* wgu; const float* wdn; unsigned char* wgu8; unsigned char* wdn8; int on, wg, qbase; };
constexpr int OFF8_CV = OFF8_WS + 2048, CVT_ITEMS = 48;
__device__ __forceinline__ void body8(const unsigned char* __restrict__ Q8b, const unsigned char* __restrict__ K8h, const unsigned char* __restrict__ VT8h, int NT,
                                      f32x16 (&o)[4], char* lds, int tid, const CvtJob cj) {
    asm volatile("" : "+v"(tid));
    const int wid = tid >> 6, lane = tid & 63, r32 = lane & 31, hi = lane >> 5;
    float* ws = (float*)(lds + OFF8_WS) + wid * 64; float* al_l = ws + 32;
    float R = 0.f; f32x16 negm = f32x16{}, ol = f32x16{};
#pragma unroll
    for (int d = 0; d < 4; ++d) o[d] = f32x16{};
    i32x8a qr;
    { const i32x4a x = *reinterpret_cast<const i32x4a*>(Q8b + (size_t)(wid * QBLK + r32) * 64 + hi * 32), y = *reinterpret_cast<const i32x4a*>(Q8b + (size_t)(wid * QBLK + r32) * 64 + hi * 32 + 16);
      qr = (i32x8a){x[0], x[1], x[2], x[3], y[0], y[1], y[2], y[3]}; }
    const int wid_s = __builtin_amdgcn_readfirstlane(wid);
    unsigned lsrc = (unsigned)((lane >> 2) * 64 + (((lane & 3) ^ ((lane >> 4) & 3)) << 4)); asm volatile("" : "+v"(lsrc));
#define SDMA8(b_, s_) do { _Pragma("unroll") for (int c_ = 0; c_ < 3; ++c_) { const int q_ = wid_s * 3 + c_, t_ = q_ >= 12 ? 1 : 0, r_ = q_ - 12 * t_; \
        const unsigned char* src_ = (r_ < 4) ? K8h + (size_t)(2 * (s_) + t_) * K8_TILE + r_ * 1024 : VT8h + (size_t)(2 * (s_) + t_) * V8_TILE + (r_ - 4) * 1024; \
        __builtin_amdgcn_global_load_lds((const unsigned*)(src_ + lsrc), (LAS unsigned*)(lds + (b_) * STG8 + q_ * 1024), 16, 0, 0); } } while (0)
#define SDMA_WAIT() asm volatile("s_waitcnt vmcnt(0)" ::: "memory")
#define RESC8(a) do { if (__any((a) < 1.f)) { if (hi == 0) al_l[r32] = (a); asm volatile("s_nop 15\n\ts_nop 15\n\ts_nop 15\n\ts_nop 15\n\ts_waitcnt lgkmcnt(0)" : "+v"(o[0]), "+v"(o[1]), "+v"(o[2]), "+v"(o[3]), "+v"(ol) :: "memory"); \
    _Pragma("unroll") for (int r = 0; r < 16; ++r) { const float a_ = al_l[crow(r, hi)]; ol[r] *= a_; _Pragma("unroll") for (int d = 0; d < 4; ++d) o[d][r] *= a_; } } } while (0)
    f32x16 pA0, pA1, pB0, pB1; float alA, alB; i32x8a pa = (i32x8a){0, 0, 0, 0, 0, 0, 0, 0};
    __syncthreads();
    SDMA8(0, 0); SDMA8(1, 1); SDMA_WAIT(); __syncthreads();
    qkt8(pA0, pA1, lds, qr, negm, r32, hi); partialSM8<true>(pA0, pA1, R, negm, alA);
    const int NS = NT >> 1;
    int b0 = 0, b1 = 1, b2 = 2;
#define ROT3() do { const int t_ = b0; b0 = b1; b1 = b2; b2 = t_; } while (0)
    const int mx_one = 0x7F7F7F7F, mx_eighth = 0x7C7C7C7C, e1_ = 0x38383838; const i32x8a ones = (i32x8a){e1_, e1_, e1_, e1_, e1_, e1_, e1_, e1_};
#define QKT_ASM(P, KF) asm volatile("v_mfma_scale_f32_32x32x64_f8f6f4 %0, %1, %2, %3, %4, %5 op_sel_hi:[0,0,0]" : "=&v"(P) : "v"(KF), "v"(qr), "v"(negm), "v"(mx_one), "v"(mx_eighth))
#define PV_ASM(O, VF) asm volatile("v_mfma_scale_f32_32x32x64_f8f6f4 %0, %1, %2, %0, %3, %3 op_sel_hi:[0,0,0]" : "+v"(O) : "v"(pa), "v"(VF), "v"(mx_one))
#define STEP8(PC0, PC1, PN0, PN1, ALN, KT_, VT_, LOADSTMT) do { const char* kt_ = (KT_); const char* vt_ = (VT_); \
    QKT_ASM(PN0, kf0); QKT_ASM(PN1, kf1); SBAR(); \
    LOADSTMT; \
    const i32x8a v0_ = frag8(vt_, r32, hi), v1_ = frag8(vt_, 32 + r32, hi); SBAR(); \
    finishSM8(PC0, PC1, pa); SBAR(); \
    asm volatile("s_nop 7" : "+v"(PN0), "+v"(PN1), "+v"(pa)); \
    PV_ASM(ol, ones); SBAR(); \
    const float m0_ = max16(PN0); SBAR(); \
    PV_ASM(o[0], v0_); const i32x8a v2_ = frag8(vt_, 64 + r32, hi); SBAR(); \
    const float m1_ = max16(PN1); SBAR(); \
    PV_ASM(o[1], v1_); const i32x8a v3_ = frag8(vt_, 96 + r32, hi); SBAR(); \
    float pm_ = fmaxf(m0_, m1_); \
    { auto rr_ = __builtin_amdgcn_permlane32_swap(__float_as_uint(pm_), __float_as_uint(pm_), false, false); pm_ = fmaxf(__uint_as_float(rr_[0]), __uint_as_float(rr_[1])); } SBAR(); \
    PV_ASM(o[2], v2_); SBAR(); PV_ASM(o[3], v3_); kf0 = frag8(kt_, r32, hi); kf1 = frag8(kt_, 32 + r32, hi); SBAR(); \
    if (__builtin_expect(!__all(pm_ <= LIM8), 0)) { const float d_ = fmaxf(pm_ - SH8, 0.f); ALN = __builtin_amdgcn_exp2f(-d_); R += d_; \
        _Pragma("unroll") for (int r = 0; r < 16; ++r) { PN0[r] -= d_; PN1[r] -= d_; } \
        const float nm_ = -R; _Pragma("unroll") for (int r = 0; r < 16; ++r) negm[r] = nm_; \
        RESC8(ALN); } \
    _Pragma("unroll") for (int r = 0; r < 16; ++r) PN0[r] = __builtin_amdgcn_exp2f(PN0[r]); } while (0)
    i32x8a kf0 = frag8(lds + BUF8, r32, hi), kf1 = frag8(lds + BUF8, 32 + r32, hi);
#define CVT_DECODE(t_) const int g_ = (cj.qbase + (t_)) * 2048 + cj.wg; const int e_ = g_ / 6144, r_ = g_ - e_ * 6144; const bool gu_ = r_ < 4096; const int r2_ = gu_ ? r_ : r_ - 4096; \
        const int k0_ = 128 * (gu_ ? (r2_ >> 9) : (r2_ >> 8)), n0_ = 4 * (gu_ ? (r2_ & 511) : (r2_ & 255)), NN_ = gu_ ? 2048 : 1024
    int pend = 0;
    for (int i = 0; i + 1 < NS; ++i) {
        if (pend == 3) asm volatile("s_waitcnt vmcnt(3)" ::: "memory"); else if (pend == 2) asm volatile("s_waitcnt vmcnt(2)" ::: "memory");
        else if (pend == 1) asm volatile("s_waitcnt vmcnt(1)" ::: "memory"); else SDMA_WAIT();
        __syncthreads();
        if (i + 2 < NS) SDMA8(b2, i + 2);
        asm volatile("" ::: "memory");
        pend = 0;
        if (cj.on) {
            char* ring = lds + OFF8_CV + wid_s * 6144;
            if (i >= 2 && i < CVT_ITEMS + 2) {
                CVT_DECODE(i - 2);
                unsigned char* dst_ = gu_ ? cj.wgu8 + (size_t)e_ * 2048 * DM : cj.wdn8 + (size_t)e_ * DM * DFF; const float wsc_ = gu_ ? W8_GU_SCALE : W8_DN_SCALE;
                const float* sl = (const float*)(ring + ((i - 2) % 3) * 2048);
                {
                    const float* sp_ = sl + ((lane & 1) * 8) * 32 + ((lane >> 1) & 7) * 4 + (lane >> 4);
                    const u32x2 o_ = (u32x2){pk4_fp8(sp_[0 * 32] * wsc_, sp_[1 * 32] * wsc_, sp_[2 * 32] * wsc_, sp_[3 * 32] * wsc_), pk4_fp8(sp_[4 * 32] * wsc_, sp_[5 * 32] * wsc_, sp_[6 * 32] * wsc_, sp_[7 * 32] * wsc_)};
                    *(u32x2*)(dst_ + (size_t)(n0_ + (lane >> 4)) * 1024 + k0_ + ((lane >> 1) & 7) * 16 + (lane & 1) * 8) = o_; }
                asm volatile("s_waitcnt lgkmcnt(0)" ::: "memory");
                pend += 1;
            }
            if (i < CVT_ITEMS) {
                CVT_DECODE(i);
                const float* src_ = gu_ ? cj.wgu + (size_t)e_ * DM * 2048 : cj.wdn + (size_t)e_ * DFF * DM;
                char* slot = ring + (i % 3) * 2048;
#pragma unroll
                for (int j = 0; j < 2; ++j) { const int k_ = (lane & 7) * 16 + 8 * j + (lane >> 3);
                    __builtin_amdgcn_global_load_lds((const unsigned*)(src_ + (size_t)(k0_ + k_) * NN_ + n0_), (LAS unsigned*)(slot + j * 1024), 16, 0, 0); }
                pend += 2;
            }
        }
        SBAR();
        STEP8(pA0, pA1, pB0, pB1, alB, lds + b1 * STG8, lds + b0 * STG8 + K8_TILE, (void)0);
        STEP8(pB0, pB1, pA0, pA1, alA, lds + b1 * STG8 + BUF8, lds + b0 * STG8 + BUF8 + K8_TILE, (void)0);
        ROT3();
    }
#undef STEP8
#undef QKT_ASM
#undef PV_ASM
#undef CVT_DECODE
    SBAR(); qkt8(pB0, pB1, lds + b0 * STG8 + BUF8, qr, negm, r32, hi);
    finishSM8(pA0, pA1, pa); SBAR();
    pv8(o, ol, lds + b0 * STG8 + K8_TILE, pa, r32, hi); partialSM8<false>(pB0, pB1, R, negm, alB);
    RESC8(alB);
    finishSM8(pB0, pB1, pa); SBAR();
    pv8(o, ol, lds + b0 * STG8 + BUF8 + K8_TILE, pa, r32, hi);
    asm volatile("s_nop 15\n\ts_nop 15\n\ts_nop 15\n\ts_nop 15" : "+v"(o[0]), "+v"(o[1]), "+v"(o[2]), "+v"(o[3]), "+v"(ol));
#undef ROT3
#undef SDMA8
#undef SDMA_WAIT
#undef RESC8
#pragma unroll
    for (int r = 0; r < 16; ++r) { const float rl = __builtin_amdgcn_rcpf(ol[r]);
#pragma unroll
        for (int d = 0; d < 4; ++d) o[d][r] *= rl; }
}

__device__ __forceinline__ int v_st64(int k, int c) { const int kk = (k & ~0xC) | ((k & 4) << 1) | ((k & 8) >> 1); return ((kk >> 3) * 2 + (c >> 5)) * 512 + ((kk & 7) * 32 + (c & 31)) * 2; }
constexpr int WIN_K = 0, WIN_V = 65536, WIN_WS = 131072;
#define WIN_LOAD(WKK, WVV, Kh_, Vh_, NT_, tid_) do { unsigned go_ = (unsigned)(((tid_) >> 3) * 64 + ((tid_) & 7) * 8) * 2u; asm volatile("" : "+v"(go_)); \
    _Pragma("unroll") for (int t_ = 0; t_ < 8; ++t_) { WKK[t_] = *reinterpret_cast<const bf16x8*>((const char*)(Kh_) + (size_t)t_ * 8192 + go_); \
        WVV[t_] = *reinterpret_cast<const bf16x8*>((const char*)(Vh_) + (size_t)t_ * 8192 + go_); } } while (0)
#define WIN_STAGE(WKK, WVV, NT_, lds_, tid_) do { const int ksr_ = (tid_) >> 3, ksc_ = ((tid_) & 7) * 8; const int kst_ = KSWZ(ksr_, ksc_ * 2), vst_ = att::v_st64(ksr_, ksc_); \
    __syncthreads(); \
    _Pragma("unroll") for (int t_ = 0; t_ < 8; ++t_) { *(bf16x8*)((lds_) + att::WIN_K + t_ * 8192 + kst_) = WKK[t_]; *(bf16x8*)((lds_) + att::WIN_V + t_ * 8192 + vst_) = WVV[t_]; } \
    __syncthreads(); } while (0)
__device__ __forceinline__ void win_compute(const bf16* __restrict__ Qb, int NT, int kpos0, int qpos0, float sink_l2, f32x16 (&o)[2], char* lds, int tid) {
    const int wid = tid >> 6, lane = tid & 63, r32 = lane & 31, hi = lane >> 5;
    float* ws = (float*)(lds + WIN_WS) + wid * 64; float* li_l = ws; float* al_l = ws + 32;
    bf16x8 qr[4];
    const bf16* Qw = Qb + (long)(wid * QBLK + r32) * 64 + hi * 8;
#pragma unroll
    for (int d0 = 0; d0 < 4; ++d0) qr[d0] = *reinterpret_cast<const bf16x8*>(Qw + d0 * 16);
    const int qw0 = qpos0 + wid * QBLK;
    int t_lo = (qw0 - 128 - kpos0) >> 6; if (t_lo < 0) t_lo = 0;
    int t_hi = (qw0 + 31 + 128 - kpos0) >> 6; if (t_hi > NT - 1) t_hi = NT - 1;
    float m_reg = -1e30f, l_reg = 0.f; o[0] = f32x16{}; o[1] = f32x16{};
    const int vb0 = (int)(uintptr_t)(lds + WIN_V) + v_rd_base(lane);
    for (int t = t_lo; t <= t_hi; ++t) {
        f32x16 p0, p1; float mn, al; bf16x8 pa0, pa1, pa2, pa3;
        qkt(p0, p1, lds + WIN_K + t * 8192, qr, r32, hi);
        bandmask(p0, p1, kpos0 + t * KVBLK, qw0, r32, hi);
        partialSM(p0, p1, m_reg, mn, al);
        if (__any(al < 1.f)) { if (hi == 0) al_l[r32] = al; asm volatile("s_waitcnt lgkmcnt(0)" ::: "memory");
#pragma unroll
            for (int d = 0; d < 2; ++d)
#pragma unroll
                for (int r = 0; r < 16; ++r) o[d][r] *= al_l[crow(r, hi)]; }
        finishSM(p0, p1, al, l_reg, pa0, pa1, pa2, pa3);
        const int vb = vb0 + t * 8192;
        pv_one<0, 2048, 1024>(o[0], vb, pa0, pa1, pa2, pa3); pv_one<1, 2048, 1024>(o[1], vb, pa0, pa1, pa2, pa3);
    }
    l_reg += __builtin_amdgcn_exp2f(sink_l2 - m_reg * (SCALE * 1.4426950408889634f));
    if (hi == 0) li_l[r32] = l_reg; asm volatile("s_waitcnt lgkmcnt(0)" ::: "memory");
#pragma unroll
    for (int r = 0; r < 16; ++r) { const float rl = __builtin_amdgcn_rcpf(li_l[crow(r, hi)]);
        o[0][r] *= rl; o[1][r] *= rl; }
}
}

#define XB_TMO      128
#define XB_XCNT(j)  (256  + 64 * (j))
#define XB_XSUB(j)  (1280 + 64 * (j))
#define XB_XGEN(j)  (2304 + 64 * (j))
#define XB_TOP      3328
#define XB_TOPGEN   3392
#define XCD_BAR_WORDS 3456
#define XB_SPIN_CAP (1u << 22)
__device__ __forceinline__ unsigned xb_ld(unsigned* p)              { return __hip_atomic_load(p, __ATOMIC_RELAXED, __HIP_MEMORY_SCOPE_AGENT); }
__device__ __forceinline__ unsigned xb_add(unsigned* p, unsigned v) { return __hip_atomic_fetch_add(p, v, __ATOMIC_RELAXED, __HIP_MEMORY_SCOPE_AGENT); }
__device__ __forceinline__ unsigned xb_xcc_id() { return (unsigned)__builtin_amdgcn_s_getreg((3 << 11) | 20) & 0xFu; }
#define XB_SPIN(cond, bar) do { unsigned _sp = 0; while (cond) { __builtin_amdgcn_s_sleep(1); \
    if ((++_sp & 255u) == 0u) { if (xb_ld(&(bar)[XB_TMO])) break; if (_sp > XB_SPIN_CAP) { atomicAdd(&(bar)[XB_TMO], 1u); break; } } } } while (0)
struct XcdBarrier { unsigned* bar; unsigned x; volatile LAS unsigned* st; };
__device__ __forceinline__ XcdBarrier xcd_barrier_post(unsigned* bar, volatile LAS unsigned* st) {
    XcdBarrier b; b.bar = bar; b.x = xb_xcc_id(); b.st = st;
    if (threadIdx.x == 0) (void)xb_add(&bar[XB_XCNT(b.x)], 1u);
    return b;
}
__device__ __forceinline__ void xcd_barrier_complete(unsigned* bar, unsigned x, unsigned& nloc, unsigned& nx) {
    const unsigned G = gridDim.x * gridDim.y * gridDim.z;
    unsigned sum, cnt, mine, sp = 0u;
    for (;;) {
        sum = 0u; cnt = 0u; mine = 0u;
#pragma unroll
        for (unsigned j = 0; j < 16; ++j) { const unsigned c = xb_ld(&bar[XB_XCNT(j)]); sum += c; cnt += (c > 0u) ? 1u : 0u; mine = (j == x) ? c : mine; }
        if (sum == G) break;
        __builtin_amdgcn_s_sleep(1);
        if ((++sp & 255u) == 0u) { if (xb_ld(&bar[XB_TMO])) break; if (sp > XB_SPIN_CAP) { atomicAdd(&bar[XB_TMO], 1u); break; } }
    }
    nloc = mine > 0u ? mine : 1u; nx = cnt > 0u ? cnt : 1u;
}
__device__ __forceinline__ void xcd_barrier(unsigned* bar_in, volatile LAS unsigned* st) {
    asm volatile("s_waitcnt vmcnt(0)" ::: "memory");
    __syncthreads();
    if (threadIdx.x == 0) {
        GAS unsigned* barg_ = (GAS unsigned*)bar_in; asm volatile("" : "+s"(barg_)); unsigned* bar = (unsigned*)barg_;
        const unsigned bx_ = xb_xcc_id();
        __builtin_amdgcn_s_waitcnt(0);
        unsigned nloc = st[0], nx = st[1];
        if (nloc == 0u) { xcd_barrier_complete(bar, bx_, nloc, nx); st[0] = nloc; st[1] = nx; }
        const unsigned old = xb_add(&bar[XB_XSUB(bx_)], 1u);
        const unsigned gen = old / nloc;
        if (old + 1u == (gen + 1u) * nloc) {
            __builtin_amdgcn_fence(__ATOMIC_RELEASE, "agent");
            asm volatile("s_waitcnt vmcnt(0)" ::: "memory");
            const unsigned og = xb_add(&bar[XB_TOP], 1u);
            const unsigned tg = og / nx;
            if (og + 1u == (tg + 1u) * nx) xb_add(&bar[XB_TOPGEN], 1u);
            else XB_SPIN(xb_ld(&bar[XB_TOPGEN]) == tg, bar);
            __builtin_amdgcn_fence(__ATOMIC_ACQUIRE, "agent");
            xb_add(&bar[XB_XGEN(bx_)], 1u);
            asm volatile("s_waitcnt vmcnt(0)" ::: "memory");
        } else {
            XB_SPIN(xb_ld(&bar[XB_XGEN(bx_)]) == gen, bar);
            __builtin_amdgcn_fence(__ATOMIC_ACQUIRE, "agent");
            asm volatile("s_waitcnt vmcnt(0)" ::: "memory");
        }
    }
    __syncthreads();
}

struct Args {
    const float* in[28]; float* out; unsigned char* ws;
    float lam_init[4];
    int lay_lo, lay_hi, ph_lo, ph_hi;
    int single, pad;
};
enum { I_X = 0, I_WIN, I_LAMBDA, I_SUBLN, I_WPA, I_CONVW, I_CONVB, I_MLWQ, I_MLWK, I_MLWV, I_MLWG, I_MLBG, I_MLNORM, I_MLSKIP, I_WPB, I_SINKS, I_WPC, I_WOUT,
       I_LN1G, I_LN1B, I_RW, I_RB, I_WGU, I_BGU, I_WDN, I_BDN, I_LN2G, I_LN2B };

__device__ __forceinline__ void transpose_item(const float* W, int K, int N, bf16* WT, int k0, int n0, int c0, LAS float* scr, int lane) {
#pragma unroll 8
    for (int i = 0; i < 32; ++i) { const int kk = 2 * i + (lane >> 5); scr[kk * 33 + (lane & 31)] = W[(size_t)(k0 + kk) * N + c0 + (lane & 31)]; }
    LDS_WAIT(); asm volatile("" ::: "memory");
    const int c = lane & 7;
#pragma unroll
    for (int j = 0; j < 4; ++j) { const int n = (lane >> 3) + 8 * j; const LAS float* s = scr + (8 * c) * 33 + n;
        u32x4 o; o.x = cvtpk(s[0 * 33], s[1 * 33]); o.y = cvtpk(s[2 * 33], s[3 * 33]); o.z = cvtpk(s[4 * 33], s[5 * 33]); o.w = cvtpk(s[6 * 33], s[7 * 33]);
        *(u32x4*)(WT + (size_t)(n0 + n) * K + k0 + 8 * c) = o; }
    LDS_WAIT(); asm volatile("" ::: "memory");
}
__device__ __forceinline__ int inproj_src_col32(int n0) {
    const int tile = n0 >> 8, nt = n0 & 255;
    if (tile <= 3 || tile == 10 || tile == 11) { const int half = nt >> 7, hd = (nt & 127) >> 5; return tile * 256 + hd * 64 + half * 32; }
    if (tile == 12) { const int half = nt >> 7, q = nt & 127; if (q < 64) return WA_K_COL + (q >> 5) * 64 + half * 32; return WA_V_COL + half * 64 + (q - 64); }
    return n0;
}
__device__ __forceinline__ void sincos_acc(float ang, float& sn, float& cs) {
    const double x = (double)ang;
    const double kq = rint(x * 0.63661977236758134308);
    const double r = fma(-kq, 1.57079632679489661923, x);
    const float rf = (float)r, z = rf * rf;
    const float sp = rf + rf * z * (-1.6666654611e-1f + z * (8.3321608736e-3f + z * (-1.9515295891e-4f)));
    const float cp = 1.0f - 0.5f * z + z * z * (4.166664568298827e-2f + z * (-1.388731625493765e-3f + z * 2.443315711809948e-5f));
    const int q = ((int)kq) & 3;
    sn = (q == 0) ? sp : (q == 1) ? cp : (q == 2) ? -sp : -cp;
    cs = (q == 0) ? cp : (q == 1) ? -sp : (q == 2) ? -cp : sp;
}

constexpr int LDT = 136;
constexpr int TILE_B = 128 * LDT * 2;
__device__ __forceinline__ void wave_mm(f32x4 (&acc)[8], const LAS bf16* A, const LAS bf16* Bt, int lane) {
    const int fr = lane & 15, fq = lane >> 4;
#pragma unroll
    for (int j = 0; j < 8; ++j) acc[j] = (f32x4){0.f, 0.f, 0.f, 0.f};
#pragma unroll
    for (int k0 = 0; k0 < 128; k0 += 32) {
        const bf16x8 a = *(const LAS bf16x8*)(A + fr * LDT + k0 + fq * 8);
#pragma unroll
        for (int j = 0; j < 8; ++j) { const bf16x8 b = *(const LAS bf16x8*)(Bt + (j * 16 + fr) * LDT + k0 + fq * 8);
            acc[j] = __builtin_amdgcn_mfma_f32_16x16x32_bf16(a, b, acc[j], 0, 0, 0); }
    }
}
__device__ __forceinline__ void stage_rows(LAS bf16* dst, const bf16* src, int gs, int tid) {
#pragma unroll
    for (int i = 0; i < 4; ++i) { const int q = tid + 512 * i, r = q >> 4, c = (q & 15) * 8;
        *(LAS u32x4*)(dst + r * LDT + c) = *(const u32x4*)(src + (size_t)r * gs + c); }
}
template <bool SCALED> __device__ __forceinline__ void stage_tr(LAS bf16* dst, const bf16* src, int gs, const LAS float* rscale, int tid) {
#pragma unroll
    for (int i = 0; i < 4; ++i) { const int q = tid + 512 * i, r = q & 127, c = (q >> 7) * 8;
        const u32x4 w = *(const u32x4*)(src + (size_t)r * gs + c);
        const unsigned ww[4] = {w.x, w.y, w.z, w.w};
        const float sc = SCALED ? rscale[r] : 1.f;
#pragma unroll
        for (int j = 0; j < 4; ++j) {
            if (SCALED) { dst[(c + 2 * j) * LDT + r] = tobf1(bflo(ww[j]) * sc); dst[(c + 2 * j + 1) * LDT + r] = tobf1(bfhi(ww[j]) * sc); }
            else { dst[(c + 2 * j) * LDT + r] = (bf16)(ww[j] & 0xffffu); dst[(c + 2 * j + 1) * LDT + r] = (bf16)(ww[j] >> 16); } }
    }
}
__device__ __forceinline__ float logsigmoidf_(float x) { return fminf(x, 0.f) - log1pf(__expf(-fabsf(x))); }
template <bool WITH_MAX> __device__ __forceinline__ void scan_dir(const LAS float* ls, const LAS float* ig, LAS float* bcum, LAS float* pmx, int dir, int lane) {
    const int n0 = dir ? 127 - 2 * lane : 2 * lane, n1 = dir ? 126 - 2 * lane : 2 * lane + 1;
    const float x0 = ls[n0], x1 = ls[n1], s = x0 + x1; float inc = s;
#pragma unroll
    for (int off = 1; off < 64; off <<= 1) { const float t = shup(inc, off, lane); if (lane >= off) inc += t; }
    const float ex = inc - s, b0 = ex + x0, b1 = b0 + x1;
    bcum[n0] = b0; bcum[n1] = b1;
    if (WITH_MAX) {
        const float d0 = ig[n0] - b0, d1 = ig[n1] - b1; float minc = fmaxf(d0, d1);
#pragma unroll
        for (int off = 1; off < 64; off <<= 1) { const float t = shup(minc, off, lane); if (lane >= off) minc = fmaxf(minc, t); }
        float mex = shup(minc, 1, lane); if (lane == 0) mex = -INFINITY;
        pmx[n0] = fmaxf(mex, d0); pmx[n1] = fmaxf(fmaxf(mex, d0), d1);
    }
}

enum { PH_INPROJ = 1, PH_MLQKV, PH_MLGATES, PH_MLLOC, PH_MLSCAN, PH_MLOUT, PH_DIFF, PH_WIN, PH_MERGE, PH_OUT, PH_LN1, PH_SORT, PH_GU, PH_DOWN, PH_LN2, PH_END };

__global__ void __launch_bounds__(NTHR, 2) mega(Args args) {
    extern __shared__ __attribute__((aligned(16))) unsigned char lds_raw[];
    LAS unsigned char* lds = (LAS unsigned char*)lds_raw;
    volatile LAS unsigned* CTLW = (volatile LAS unsigned*)(lds + PH_LDS);
    const int tid0 = threadIdx.x;
    const int wave_s = __builtin_amdgcn_readfirstlane(tid0 >> 6);
    const int G = gridDim.x, bx = blockIdx.x;
#define PH_LOCALS unsigned lz_ = 0u; asm volatile("" : "+v"(lz_)); int tid = wave_s * 64 + (int)__builtin_amdgcn_mbcnt_hi(~0u, __builtin_amdgcn_mbcnt_lo(~0u, lz_)); asm volatile("" : "+v"(tid)); GAS unsigned char* wsg_ = (GAS unsigned char*)args.ws; asm volatile("" : "+s"(wsg_)); unsigned char* ws = (unsigned char*)wsg_; const int lane = tid & 63; const int wave = __builtin_amdgcn_readfirstlane(tid >> 6); \
    const int gw = vcu * NWAVES + wave, NGW = G * NWAVES, gt = vcu * NTHR + tid, NGT = G * NTHR; (void)lane; (void)gw; (void)NGW; (void)gt; (void)NGT;
    const int vcu = (bx % 8) * (G / 8) + bx / 8;
    for (int u = tid0; u < 64; u += NTHR) CTLW[u] = 0u;
    __syncthreads();
    if (args.single) (void)xcd_barrier_post((unsigned*)(args.ws + OFF_CTL) + 4096, CTLW + 8);
#define SEAM() do { if (args.single) xcd_barrier((unsigned*)(args.ws + OFF_CTL) + 4096, CTLW + 8); } while (0)

#define WIN_T ((bf16*)((bf16*)(ws + OFF_WIN)))
#define WP_T ((bf16*)((bf16*)(ws + OFF_WP)))
#define WOUT_T ((bf16*)((bf16*)(ws + OFF_WOUT)))
#define WGU_T ((bf16*)((bf16*)(ws + OFF_WGU)))
#define WDN_T ((bf16*)((bf16*)(ws + OFF_WDN)))
#define WML_T ((bf16*)((bf16*)(ws + OFF_WML)))
#define ROPE ((f32x2*)((f32x2*)(ws + OFF_ROPE)))
#define XB ((bf16*)((bf16*)(ws + OFF_XB)))
#define XF ((float*)((float*)(ws + OFF_XF)))
#define ZB ((bf16*)(ws + OFF_ZB))
#define X1 ((float*)(ws + OFF_X1))
#define QA ((bf16*)((bf16*)(ws + OFF_QA)))
#define KA ((bf16*)((bf16*)(ws + OFF_KA)))
#define VA ((bf16*)((bf16*)(ws + OFF_VA)))
#define MLX ((bf16*)((bf16*)(ws + OFF_MLX)))
#define MLO ((bf16*)((bf16*)(ws + OFF_MLO)))
#define XC ((bf16*)((bf16*)(ws + OFF_XC)))
#define WQb ((bf16*)((bf16*)(ws + OFF_WQ)))
#define WKb ((bf16*)((bf16*)(ws + OFF_WK)))
#define WVb ((bf16*)((bf16*)(ws + OFF_WV)))
#define GT ((bf16*)((bf16*)(ws + OFF_GT)))
#define YA ((bf16*)((bf16*)(ws + OFF_Y3)))
#define YB ((bf16*)(YA + (size_t)TOK * 512))
#define YC ((bf16*)(YB + (size_t)TOK * 512))
#define MF ((float*)((float*)(ws + OFF_MF)))
#define MB ((bf16*)((bf16*)(ws + OFF_MB)))
#define MQ ((bf16*)((bf16*)(ws + OFF_MQ)))
#define MK ((bf16*)(MQ + (size_t)TOK * 512))
#define MV ((bf16*)(MK + (size_t)TOK * 512))
#define G4 ((float*)((float*)(ws + OFF_G4)))
#define GATE4(k_) ((GP[((((size_t)0 * 4 + (k_)) * BATCH + b) * 4 + h) * SEQ + s0 + gt_] + GP[((((size_t)1 * 4 + (k_)) * BATCH + b) * 4 + h) * SEQ + s0 + gt_]) + (GP[((((size_t)2 * 4 + (k_)) * BATCH + b) * 4 + h) * SEQ + s0 + gt_] + GP[((((size_t)3 * 4 + (k_)) * BATCH + b) * 4 + h) * SEQ + s0 + gt_]))
#define GP ((float*)(ws + OFF_WGU + 320 * MiB))
#define CLOC ((bf16*)(ws + OFF_CLOC))
#define CPT ((bf16*)((bf16*)(ws + OFF_CPT)))
#define NLOC ((float*)((float*)(ws + OFF_NLOC)))
#define NPREV ((float*)((float*)(ws + OFF_NPREV)))
#define MLOC ((float*)((float*)(ws + OFF_MLOC)))
#define GCH ((float*)((float*)(ws + OFF_GCH)))
#define MPREV ((float*)((float*)(ws + OFF_MPREV)))
#define STASH ((float*)((float*)(ws + OFF_STASH)))
#define BLKCNT ((int*)((int*)(ws + OFF_BLKCNT)))
#define TILEE ((int*)((int*)(ws + OFF_TILEE)))
#define ROWW ((float*)((float*)(ws + OFF_ROWW)))
#define TOKE ((int*)((int*)(ws + OFF_TOKE)))
#define TOKW ((float*)((float*)(ws + OFF_TOKW)))
#define TOKLP ((int*)((int*)(ws + OFF_TOKLP)))
#define TOKROW ((int*)((int*)(ws + OFF_TOKROW)))
#define XG ((bf16*)((bf16*)(ws + OFF_XG)))
#define ROWTOK ((int*)(ws + OFF_ROWTOK))
#define XB8 ((unsigned char*)(ws + OFF_XB8))
#define WGU8 ((unsigned char*)(ws + OFF_WGU))
#define WIN8 ((unsigned char*)(ws + OFF_WGU + 256 * MiB))
#define XB8I ((unsigned char*)(ws + OFF_WGU + 288 * MiB))
#define WDN8 ((unsigned char*)(ws + OFF_WDN))
#define ACT8 ((unsigned char*)(ws + OFF_ACT))
#define ACT ((bf16*)((bf16*)(ws + OFF_ACT)))
#define YS ((bf16*)((bf16*)(ws + OFF_YS)))
    for (int rep_ = 0, nrep_ = (((PHASE_MASK & 1ull) && args.lay_lo < 0) ? (int)(1 + (REPEAT_MASK & 1ull)) : 0); rep_ < nrep_; ++rep_) {
        PH_LOCALS
        LAS float* scr = (LAS float*)(lds + wave * 16896);
        constexpr int I_IN = 8 * 200, I_P = 4 * 32, I_O = 8 * 32, I_GU = 8 * 64, I_DN = 8 * 32, I_ML = 1 * 4;
        constexpr int N0 = DEPTH * I_IN, N1 = N0 + 3 * DEPTH * I_P, N2 = N1 + DEPTH * I_O, N3 = N2 + NEXP * I_GU, N4 = N3 + NEXP * I_DN, N5 = N4 + 3 * 16 * I_ML;
#define TR_DECODE(it_, SRC, NN, DST, KK, K0, N0_, C0, WSC) do { const int it__ = (it_); WSC = 0.f; \
            if (it__ < N0) { const int l_ = it__ / I_IN, r_ = it__ % I_IN, kb = r_ / 200, nb = r_ % 200; \
                SRC = args.in[I_WIN] + (size_t)l_ * DM * DIN; NN = DIN; DST = WIN_T + (size_t)l_ * DIN * DM; KK = DM; K0 = 128 * kb; N0_ = 32 * nb; C0 = inproj_src_col32(32 * nb); \
                { DST = (bf16*)(WIN8 + (size_t)l_ * 6400 * DM); WSC = W8_IN_SCALE; } } \
            else if (it__ < N1) { const int q = it__ - N0, br = q / (DEPTH * I_P), r2 = q % (DEPTH * I_P), l_ = r2 / I_P, r_ = r2 % I_P, kb = r_ / 32, nb = r_ % 32; \
                SRC = (br == 0 ? args.in[I_WPA] : br == 1 ? args.in[I_WPB] : args.in[I_WPC]) + (size_t)l_ * 512 * DM; NN = DM; DST = WP_T + ((size_t)l_ * 3 + br) * DM * 512; KK = 512; K0 = 128 * kb; N0_ = 32 * nb; C0 = 32 * nb; } \
            else if (it__ < N2) { const int q = it__ - N1, l_ = q / I_O, r_ = q % I_O, kb = r_ / 32, nb = r_ % 32; \
                SRC = args.in[I_WOUT] + (size_t)l_ * DM * DM; NN = DM; DST = WOUT_T + (size_t)l_ * DM * DM; KK = DM; K0 = 128 * kb; N0_ = 32 * nb; C0 = 32 * nb; } \
            else if (it__ < N4) { const int q0_ = it__ - N2; constexpr int PER_L = NEXP * (I_GU + I_DN); const int ql = q0_ % PER_L, l_ = 0;     \
                if (ql < NEXP * I_GU) { const int mt = l_ * NEXP + ql / I_GU, r_ = ql % I_GU, kb = r_ / 64, nb = r_ % 64; \
                    SRC = args.in[I_WGU] + (size_t)mt * DM * 2048; NN = 2048; DST = (bf16*)(WGU8 + (size_t)mt * 2048 * DM); KK = DM; K0 = 128 * kb; N0_ = 32 * nb; C0 = 32 * nb; WSC = W8_GU_SCALE; } \
                else { const int q = ql - NEXP * I_GU, mt = l_ * NEXP + q / I_DN, r_ = q % I_DN, kb = r_ / 32, nb = r_ % 32; \
                    SRC = args.in[I_WDN] + (size_t)mt * DFF * DM; NN = DM; DST = (bf16*)(WDN8 + (size_t)mt * DM * DFF); KK = DFF; K0 = 128 * kb; N0_ = 32 * nb; C0 = 32 * nb; WSC = W8_DN_SCALE; } } \
            else { const int q = it__ - N4, which = q / (16 * I_ML), r2 = q % (16 * I_ML), lh = r2 / I_ML, r_ = r2 % I_ML, kb = r_ / 4, nb = r_ % 4; \
                SRC = (which == 0 ? args.in[I_MLWQ] : which == 1 ? args.in[I_MLWK] : args.in[I_MLWV]) + (size_t)lh * 128 * 128; NN = 128; \
                DST = WML_T + (((size_t)(lh >> 2) * 3 + which) * 4 + (lh & 3)) * 128 * 128; KK = 128; K0 = 128 * kb; N0_ = 32 * nb; C0 = 32 * nb; } } while (0)
        {
#define TR_LOAD(dstv, SRC, NN_, K0, C0) do { const float* sp_ = (SRC) + (size_t)((K0) + (lane >> 3)) * (NN_) + (C0) + (lane & 7) * 4; \
                _Pragma("unroll") for (int i = 0; i < 16; ++i) dstv[i] = *(const f32x4*)(sp_ + (size_t)(8 * i) * (NN_)); } while (0)
#define TR_PROC(v, dst, KK, k0, n0, wsc) do { \
                _Pragma("unroll") for (int i = 0; i < 16; ++i) _Pragma("unroll") for (int e = 0; e < 4; ++e) scr[(8 * i + (lane >> 3)) * 33 + (lane & 7) * 4 + e] = v[i][e]; \
                LDS_WAIT(); asm volatile("" ::: "memory"); \
                if (wsc == 0.f) { const int c = lane & 15;                         \
                  _Pragma("unroll") for (int j = 0; j < 8; ++j) { const int n = (lane >> 4) + 4 * j; const LAS float* sp = scr + (8 * c) * 33 + n; \
                      u32x4 o; o.x = cvtpk(sp[0 * 33], sp[1 * 33]); o.y = cvtpk(sp[2 * 33], sp[3 * 33]); o.z = cvtpk(sp[4 * 33], sp[5 * 33]); o.w = cvtpk(sp[6 * 33], sp[7 * 33]); \
                      *(u32x4*)(dst + (size_t)(n0 + n) * KK + k0 + 8 * c) = o; } } \
                else {                                                             \
                  _Pragma("unroll") for (int j = 0; j < 4; ++j) { const int q = lane + 64 * j, n = q >> 3, part = q & 7; const LAS float* sp = scr + (part * 16) * 33 + n; \
                      u32x4 o; \
                      o.x = pk4_fp8(sp[0 * 33] * wsc, sp[1 * 33] * wsc, sp[2 * 33] * wsc, sp[3 * 33] * wsc); o.y = pk4_fp8(sp[4 * 33] * wsc, sp[5 * 33] * wsc, sp[6 * 33] * wsc, sp[7 * 33] * wsc); \
                      o.z = pk4_fp8(sp[8 * 33] * wsc, sp[9 * 33] * wsc, sp[10 * 33] * wsc, sp[11 * 33] * wsc); o.w = pk4_fp8(sp[12 * 33] * wsc, sp[13 * 33] * wsc, sp[14 * 33] * wsc, sp[15 * 33] * wsc); \
                      *(u32x4*)((unsigned char*)dst + (size_t)(n0 + n) * KK + k0 + part * 16) = o; } } \
                LDS_WAIT(); asm volatile("" ::: "memory"); } while (0)
#define TR_STATE(S) const float* src##S = nullptr; bf16* dst##S = nullptr; int NN##S = 0, KK##S = 0, k0##S = 0, n0##S = 0, c0##S = 0; float wsc##S = 0.f; f32x4 v##S[16]
#define TR_FETCH(S, it_) do { if ((it_) < N5) { TR_DECODE((it_), src##S, NN##S, dst##S, KK##S, k0##S, n0##S, c0##S, wsc##S); TR_LOAD(v##S, src##S, NN##S, k0##S, c0##S); } } while (0)
            TR_STATE(A); TR_STATE(B);
            TR_FETCH(A, gw); TR_FETCH(B, gw + NGW);
#pragma unroll 1
            for (int it = gw; it < N5; it += 2 * NGW) {
                TR_PROC(vA, dstA, KKA, k0A, n0A, wscA); TR_FETCH(A, it + 2 * NGW);
                if (it + NGW < N5) { TR_PROC(vB, dstB, KKB, k0B, n0B, wscB); TR_FETCH(B, it + 3 * NGW); }
            }
#undef TR_PROC
#undef TR_STATE
#undef TR_FETCH
#undef TR_LOAD
        }
#undef TR_DECODE
        for (size_t i = gt; i < (size_t)TOK * DM / 8; i += NGT) {
            const f32x4 a = *(const f32x4*)(args.in[I_X] + i * 8), b = *(const f32x4*)(args.in[I_X] + i * 8 + 4);
            *(u32x4*)(XB + i * 8) = pg8::pack8(a, b);
            *(u32x2*)(XB8I + i * 8) = (u32x2){pk4_fp8(a[0], a[1], a[2], a[3]), pk4_fp8(b[0], b[1], b[2], b[3])};
        }
        for (int p = gw; p < DEPTH * NEXP; p += NGW) {
            const int l = p >> 5, e = p & 31;
            const float* rw = args.in[I_RW] + (size_t)l * DM * NEXP; const float* g1 = args.in[I_LN1G] + (size_t)l * DM; const float* b1 = args.in[I_LN1B] + (size_t)l * DM;
            bf16* wh = (bf16*)(ws + OFF_RWGH) + (size_t)p * DM; bf16* wl = (bf16*)(ws + OFF_RWGL) + (size_t)p * DM;
            float cg = 0.f, cb = 0.f;
            for (int k = lane; k < DM; k += 64) { const float w = rw[(size_t)k * NEXP + e], wg = g1[k] * w; const bf16 h = tobf1(wg);
                wh[k] = h; wl[k] = tobf1(wg - bf1(h)); cg += wg; cb += b1[k] * w; }
            cg = wave_sum(cg, lane); cb = wave_sum(cb, lane);
            if (lane == 0) { float* cgcb = (float*)(ws + OFF_CGCB) + (size_t)l * 64; cgcb[e] = cg; cgcb[32 + e] = cb + args.in[I_RB][(size_t)l * NEXP + e]; }
        }
        for (int i = gt; i < DEPTH * 16 * 1536; i += NGT) { const int l = i / (16 * 1536), r = i % (16 * 1536), g = r / 1536, k = r % 1536;
            ((bf16*)(ws + OFF_WGT))[i] = tobf1(args.in[I_MLWG][((size_t)l * 1536 + k) * 16 + g]); }
        for (int i = gt; i < SEQ * 32; i += NGT) {
            const int s = i >> 5, j = i & 31;
            const float inv = exp2f(-(float)(2 * j) * (13.287712379549449f / 64.0f));
            const float ang = (float)s * inv; float sn, cs; sincos_acc(ang, sn, cs);
            ROPE[i] = (f32x2){cs, sn};
        }
        SEAM();
    }

    for (int l = (args.lay_lo < 0 ? 0 : args.lay_lo); l < args.lay_hi; ++l) {
        const int plo = args.ph_lo, phi = args.ph_hi;
#define IN(k) (((PHASE_MASK >> (k)) & 1ull) && plo <= (k) && (k) < phi)
#define PHASE(k) for (int rep_ = 0, nrep_ = (IN(k) ? (int)(1 + ((REPEAT_MASK >> (k)) & 1ull)) : 0); rep_ < nrep_; ++rep_)
        PHASE(PH_INPROJ) {
            PH_LOCALS
            {   pg8::Gemm g{(const bf16*)XB8I, (const bf16*)(WIN8 + (size_t)l * 6400 * DM), DM / 2, DM / 2, DM / 2, 0, nullptr};
                pg8::InprojOrder S{2, bx};
                pg8::EpiInProj E{QA, KA, VA, MLX, MLO, WQb, WKb, WVb, GT, ROPE, 1.0f / W8_IN_SCALE};
                pg8::gemm_phase<pg8::EpiInProj, true, false, true, pg8::InprojOrder>(lds, g, S, E, tid); }
            SEAM();
        }
        PHASE(PH_MLQKV) {
            PH_LOCALS
            LAS bf16* BA1 = (LAS bf16*)lds; LAS bf16* BA2 = (LAS bf16*)(lds + TILE_B); LAS bf16* BW0 = (LAS bf16*)(lds + 2 * TILE_B); LAS bf16* BW1 = (LAS bf16*)(lds + 3 * TILE_B);
            const float* cw = args.in[I_CONVW] + (size_t)l * 5 * 512; const float* cb = args.in[I_CONVB] + (size_t)l * 512;
            for (int u = vcu; u < 512; u += G) {
                const int tt = u >> 2, h = u & 3; const size_t t0 = (size_t)tt * 128;
                const int b = (int)(t0 >> 13), s0 = (int)(t0 & (SEQ - 1));
                const int c8 = (tid & 15) * 8, ch = h * 128 + c8;
                __syncthreads();
                {   f32x4 cwv[5][2]; f32x4 cbv[2];
#pragma unroll
                    for (int k = 0; k < 5; ++k) { cwv[k][0] = *(const f32x4*)(cw + k * 512 + ch); cwv[k][1] = *(const f32x4*)(cw + k * 512 + ch + 4); }
                    cbv[0] = *(const f32x4*)(cb + ch); cbv[1] = *(const f32x4*)(cb + ch + 4);
                    u32x4 xra[4][5];
#pragma unroll
                    for (int i = 0; i < 4; ++i) { const int r = (tid >> 4) + 32 * i, s = s0 + r;
#pragma unroll
                        for (int k = 0; k < 5; ++k) { const int ss = s + k - 2; xra[i][k] = (ss >= 0 && ss < SEQ) ? *(const u32x4*)(MLX + (t0 + r + k - 2) * 512 + ch) : (u32x4){0u, 0u, 0u, 0u}; } }
                    const bf16* wbase = WML_T + (((size_t)l * 3) * 4 + h) * 128 * 128;
                    u32x4 w0r[4], w1r[4], w2r[4];
#pragma unroll
                    for (int i = 0; i < 4; ++i) { const int r = (tid >> 4) + 32 * i; w0r[i] = *(const u32x4*)(wbase + (size_t)r * 128 + c8);
                        w1r[i] = *(const u32x4*)(wbase + (size_t)4 * 128 * 128 + (size_t)r * 128 + c8); w2r[i] = *(const u32x4*)(wbase + (size_t)8 * 128 * 128 + (size_t)r * 128 + c8); }
#pragma unroll
                    for (int i = 0; i < 4; ++i) {
                        const int r = (tid >> 4) + 32 * i;
                        u32x4 xr[5];
#pragma unroll
                        for (int k = 0; k < 5; ++k) xr[k] = xra[i][k];
                        float a[8] = {cbv[0][0], cbv[0][1], cbv[0][2], cbv[0][3], cbv[1][0], cbv[1][1], cbv[1][2], cbv[1][3]};
#pragma unroll
                        for (int k = 0; k < 5; ++k) { const u32x4 w = xr[k];
                            a[0] += bflo(w.x) * cwv[k][0][0]; a[1] += bfhi(w.x) * cwv[k][0][1]; a[2] += bflo(w.y) * cwv[k][0][2]; a[3] += bfhi(w.y) * cwv[k][0][3];
                            a[4] += bflo(w.z) * cwv[k][1][0]; a[5] += bfhi(w.z) * cwv[k][1][1]; a[6] += bflo(w.w) * cwv[k][1][2]; a[7] += bfhi(w.w) * cwv[k][1][3]; }
#pragma unroll
                        for (int j = 0; j < 8; ++j) a[j] = a[j] * sigmoidf_(a[j]);
                        u32x4 o; o.x = cvtpk(a[0], a[1]); o.y = cvtpk(a[2], a[3]); o.z = cvtpk(a[4], a[5]); o.w = cvtpk(a[6], a[7]);
                        *(LAS u32x4*)(BA1 + r * LDT + c8) = o; *(LAS u32x4*)(BA2 + r * LDT + c8) = xr[2];
                        *(LAS u32x4*)(BW0 + r * LDT + c8) = w0r[i]; *(LAS u32x4*)(BW1 + r * LDT + c8) = w1r[i];
                        *(u32x4*)(XC + (t0 + r) * 512 + ch) = o;
                    }
                    __syncthreads();
                    const bf16* wgt = (const bf16*)(ws + OFF_WGT) + (size_t)l * 16 * 1536;
                    LAS bf16* OTs = (LAS bf16*)(lds + 4 * TILE_B) + wave * 512;
                    f32x4 accg = (f32x4){0.f, 0.f, 0.f, 0.f};
#pragma unroll
                    for (int which = 0; which < 3; ++which) {
                        if (which == 2) { __syncthreads();
#pragma unroll
                            for (int i = 0; i < 4; ++i) { const int r = (tid >> 4) + 32 * i; *(LAS u32x4*)(BW0 + r * LDT + c8) = w2r[i]; }
                            __syncthreads(); }
                        const int fr = lane & 15, fq = lane >> 4;
                        bf16x8 wg[4];
#pragma unroll
                        for (int c = 0; c < 4; ++c) wg[c] = *(const bf16x8*)(wgt + (size_t)fr * 1536 + (which * 4 + h) * 128 + c * 32 + 8 * fq);
                        f32x4 acc[8];
                        wave_mm(acc, (which == 2 ? BA2 : BA1) + wave * 16 * LDT, which == 1 ? BW1 : BW0, lane);
                        bf16* dst = (which == 0 ? MQ : which == 1 ? MK : MV) + ((size_t)(b * 4 + h) * SEQ + s0) * 128;
#pragma unroll
                        for (int j = 0; j < 8; ++j)
#pragma unroll
                            for (int r = 0; r < 4; ++r) dst[(size_t)(wave * 16 + 4 * fq + r) * 128 + j * 16 + fr] = tobf1(acc[j][r]);
#pragma unroll
                        for (int c = 0; c < 4; ++c) {
#pragma unroll
                            for (int jj = 0; jj < 2; ++jj)
#pragma unroll
                                for (int r = 0; r < 4; ++r) OTs[(4 * fq + r) * 32 + jj * 16 + fr] = tobf1(acc[2 * c + jj][r]);
                            LDS_WAIT(); asm volatile("" ::: "memory");
                            const bf16x8 av = *(const LAS bf16x8*)(OTs + fr * 32 + fq * 8);
                            accg = __builtin_amdgcn_mfma_f32_16x16x32_bf16(av, wg[c], accg, 0, 0, 0);
                            LDS_WAIT(); asm volatile("" ::: "memory");
                        }
                    }
                    {   int fr = lane & 15; asm volatile("" : "+v"(fr));
                        const int fq = lane >> 4, ty = fr >> 2, hh = fr & 3; const float bias = (h == 0) ? args.in[I_MLBG][(size_t)l * 16 + fr] : 0.f;
#pragma unroll
                        for (int r = 0; r < 4; ++r) GP[((((size_t)h * 4 + ty) * BATCH + b) * 4 + hh) * SEQ + s0 + wave * 16 + 4 * fq + r] = accg[r] + bias; }
                }
            }
            SEAM();
        }
        PHASE(PH_MLLOC) {
            PH_LOCALS
            LAS bf16* BA = (LAS bf16*)lds; LAS bf16* BBf = (LAS bf16*)(lds + TILE_B); LAS bf16* BBb = (LAS bf16*)(lds + 2 * TILE_B);
            LAS float* sm = (LAS float*)(lds + 3 * TILE_B);
            LAS float* sLSf = sm, *sLSb = sm + 128, *sIGf = sm + 256, *sIGb = sm + 384, *sBf = sm + 512, *sBb = sm + 640, *sEf = sm + 768, *sEb = sm + 896, *sNP = sm + 1024;
            for (int u = vcu; u < 512; u += G) {
                asm volatile("" : "+v"(tid));
                const int lane = tid & 63, wave = __builtin_amdgcn_readfirstlane(tid >> 6);
                const int b = u >> 8, h = (u >> 6) & 3, c = u & 63; const int s0 = c * 128;
                const int seqf = (0 * 2 + b) * 4 + h, seqb = (1 * 2 + b) * 4 + h;
                const size_t rb = ((size_t)(b * 4 + h) * SEQ + s0) * 128;
                u32x4 kr[4], vr[4];
#pragma unroll
                for (int i = 0; i < 4; ++i) { const int r = tid & 127, c8 = ((tid >> 7) + 4 * i) * 8; kr[i] = *(const u32x4*)(MK + rb + (size_t)r * 128 + c8); vr[i] = *(const u32x4*)(MV + rb + (size_t)r * 128 + c8); }
                const int gt_ = tid & 127;
                const float g0_ = GATE4(0), g1_ = GATE4(1);
                const float g2_ = GATE4(2), g3_ = GATE4(3);
                __syncthreads();
                if (tid < 128) { sIGf[tid] = g0_; sLSf[tid] = logsigmoidf_(g1_); sIGb[tid] = g2_; sLSb[tid] = logsigmoidf_(g3_); }
                __syncthreads();
                if (wave == 0) scan_dir<false>(sLSf, sIGf, sBf, nullptr, 0, lane);
                if (wave == 1) scan_dir<false>(sLSb, sIGb, sBb, nullptr, 1, lane);
                __syncthreads();
                const float gtf = sBf[127], gtb = sBb[0];
                const float wf0 = gtf - sBf[lane] + sIGf[lane], wf1 = gtf - sBf[lane + 64] + sIGf[lane + 64];
                const float wb0 = gtb - sBb[lane] + sIGb[lane], wb1 = gtb - sBb[lane + 64] + sIGb[lane + 64];
                const float mlf = wave_max(fmaxf(wf0, wf1), lane), mlb = wave_max(fmaxf(wb0, wb1), lane);
                if (wave == 0) { sEf[lane] = __expf(wf0 - mlf) * 0.08838834764831845f; sEf[lane + 64] = __expf(wf1 - mlf) * 0.08838834764831845f; }
                if (wave == 1) { sEb[lane] = __expf(wb0 - mlb) * 0.08838834764831845f; sEb[lane + 64] = __expf(wb1 - mlb) * 0.08838834764831845f; }
                __syncthreads();
#pragma unroll
                for (int i = 0; i < 4; ++i) { const int r = tid & 127, c8 = ((tid >> 7) + 4 * i) * 8; const float ef = sEf[r], eb = sEb[r];
                    const unsigned kw[4] = {kr[i].x, kr[i].y, kr[i].z, kr[i].w}, vw[4] = {vr[i].x, vr[i].y, vr[i].z, vr[i].w};
#pragma unroll
                    for (int j = 0; j < 4; ++j) {
                        BA[(c8 + 2 * j) * LDT + r] = (bf16)(vw[j] & 0xffffu); BA[(c8 + 2 * j + 1) * LDT + r] = (bf16)(vw[j] >> 16);
                        const float k0 = bflo(kw[j]), k1 = bfhi(kw[j]);
                        BBf[(c8 + 2 * j) * LDT + r] = tobf1(k0 * ef); BBf[(c8 + 2 * j + 1) * LDT + r] = tobf1(k1 * ef);
                        BBb[(c8 + 2 * j) * LDT + r] = tobf1(k0 * eb); BBb[(c8 + 2 * j + 1) * LDT + r] = tobf1(k1 * eb); } }
                __syncthreads();
                const int fr = lane & 15, fq = lane >> 4;
#pragma unroll
                for (int dir = 0; dir < 2; ++dir) {
                    f32x4 acc[8];
                    wave_mm(acc, BA + wave * 16 * LDT, dir ? BBb : BBf, lane);
                    bf16* dst = CLOC + ((size_t)(dir ? seqb : seqf) * 64 + c) * 16384;
#pragma unroll
                    for (int j = 0; j < 8; ++j)
#pragma unroll
                        for (int r = 0; r < 4; ++r) dst[(wave * 16 + 4 * fq + r) * 128 + j * 16 + fr] = tobf1(acc[j][r]);
                    const int kd = tid & 127, part = tid >> 7; float sacc = 0.f;
#pragma unroll
                    for (int q = 0; q < 4; ++q) { const u32x4 w = *(const LAS u32x4*)((dir ? BBb : BBf) + kd * LDT + part * 32 + q * 8);
                        sacc += (bflo(w.x) + bfhi(w.x)) + (bflo(w.y) + bfhi(w.y)) + (bflo(w.z) + bfhi(w.z)) + (bflo(w.w) + bfhi(w.w)); }
                    sNP[dir * 512 + part * 128 + kd] = sacc;
                }
                __syncthreads();
                if (tid < 256) { const int dir = tid >> 7, kd = tid & 127; const LAS float* p = sNP + dir * 512;
                    NLOC[((size_t)(dir ? seqb : seqf) * 64 + c) * 128 + kd] = (p[kd] + p[128 + kd]) + (p[256 + kd] + p[384 + kd]); }
                if (tid == 0) { MLOC[seqf * 64 + c] = mlf; GCH[seqf * 64 + c] = gtf; MLOC[seqb * 64 + c] = mlb; GCH[seqb * 64 + c] = gtb; }
            }
            SEAM();
        }
        PHASE(PH_MLSCAN) {
            PH_LOCALS
            LAS float* sG = (LAS float*)lds; LAS float* sM = sG + 64; LAS float* sA = sG + 128; LAS float* sBl = sG + 192; LAS float* sMp = sG + 256;
            const int seq = vcu >> 4, dir = seq >> 3;
            __syncthreads();
            if (tid < 64) { sG[tid] = GCH[seq * 64 + tid]; sM[tid] = MLOC[seq * 64 + tid]; }
            __syncthreads();
            if (tid == 0) { float m = 0.f;
                for (int cc = 0; cc < 64; ++cc) { const int c = dir ? 63 - cc : cc; const float gc = sG[c], ml = sM[c];
                    const float mn = fmaxf(gc + m, ml); sA[cc] = __expf(gc + m - mn); sBl[cc] = __expf(ml - mn); sMp[cc] = m; m = mn; } }
            __syncthreads();
            {
                const int e2 = ((vcu & 15) * NTHR + tid) * 2;
                f32x2 C = {0.f, 0.f};
                for (int half = 0; half < 2; ++half) {
                    unsigned cl[32];
#pragma unroll
                    for (int i = 0; i < 32; ++i) { const int cc = half * 32 + i, c = dir ? 63 - cc : cc; cl[i] = *(const unsigned*)(CLOC + ((size_t)seq * 64 + c) * 16384 + e2); }
#pragma unroll
                    for (int i = 0; i < 32; ++i) { const int cc = half * 32 + i, c = dir ? 63 - cc : cc;
                        *(unsigned*)(CPT + ((size_t)seq * 64 + c) * 16384 + e2) = cvtpk(C[0], C[1]);
                        C = C * sA[cc] + (f32x2){bflo(cl[i]), bfhi(cl[i])} * sBl[cc]; }
                }
            }
            if ((vcu & 15) == 0) {
                if (tid < 64) { const int c = dir ? 63 - tid : tid; MPREV[seq * 64 + c] = sMp[tid]; }
                if (tid < 128) { float n = 0.f;
                    for (int half = 0; half < 2; ++half) { float nl[32];
#pragma unroll
                        for (int i = 0; i < 32; ++i) { const int cc = half * 32 + i, c = dir ? 63 - cc : cc; nl[i] = NLOC[((size_t)seq * 64 + c) * 128 + tid]; }
#pragma unroll
                        for (int i = 0; i < 32; ++i) { const int cc = half * 32 + i, c = dir ? 63 - cc : cc;
                            NPREV[((size_t)seq * 64 + c) * 128 + tid] = n; n = n * sA[cc] + nl[i] * sBl[cc]; } } }
            }
            SEAM();
        }
        PHASE(PH_MLOUT) {
            PH_LOCALS
            LAS bf16* BQ = (LAS bf16*)lds; LAS bf16* BK = (LAS bf16*)(lds + TILE_B); LAS bf16* BV = (LAS bf16*)(lds + 2 * TILE_B); LAS bf16* BC = (LAS bf16*)(lds + 3 * TILE_B);
            LAS float* sm = (LAS float*)(lds + 4 * TILE_B);
            LAS float* sLSf = sm, *sLSb = sm + 128, *sIf = sm + 256, *sIb = sm + 384, *sBf = sm + 512, *sBb = sm + 640, *sPf = sm + 768, *sPb = sm + 896;
            LAS float* sNf = sm + 1024, *sNb = sm + 1152, *sQNf = sm + 1280, *sQNb = sm + 1408;
            const float* normw = args.in[I_MLNORM] + (size_t)l * 512; const float* skipw = args.in[I_MLSKIP] + (size_t)l * 512;
            for (int u = vcu; u < 512; u += G) {
                asm volatile("" : "+v"(tid));
                const int lane = tid & 63, wave = __builtin_amdgcn_readfirstlane(tid >> 6);
                const int b = u >> 8, h = (u >> 6) & 3, c = u & 63; const int s0 = c * 128;
                const int seqf = (0 * 2 + b) * 4 + h, seqb = (1 * 2 + b) * 4 + h;
                const size_t rb = ((size_t)(b * 4 + h) * SEQ + s0) * 128;
                const int gt_ = tid & 127;
                const float g0_ = GATE4(0), g1_ = GATE4(1);
                const float g2_ = GATE4(2), g3_ = GATE4(3);
                const float np0_ = NPREV[((size_t)seqf * 64 + c) * 128 + gt_], np1_ = NPREV[((size_t)seqb * 64 + c) * 128 + gt_];
                __syncthreads();
                stage_rows(BQ, MQ + rb, 128, tid); stage_rows(BK, MK + rb, 128, tid); stage_tr<false>(BV, MV + rb, 128, nullptr, tid);
                stage_rows(BC, CPT + ((size_t)seqf * 64 + c) * 16384, 128, tid);
                if (tid < 128) { sIf[tid] = g0_; sLSf[tid] = logsigmoidf_(g1_); sIb[tid] = g2_; sLSb[tid] = logsigmoidf_(g3_); sNf[tid] = np0_; sNb[tid] = np1_; }
                __syncthreads();
                if (wave == 0) scan_dir<true>(sLSf, sIf, sBf, sPf, 0, lane);
                if (wave == 1) scan_dir<true>(sLSb, sIb, sBb, sPb, 1, lane);
                {
                    const int t = tid >> 2, part = tid & 3; float af = 0.f, ab = 0.f;
                    for (int k = 0; k < 32; ++k) { const float q = bf1(BQ[t * LDT + part * 32 + k]); af += q * sNf[part * 32 + k]; ab += q * sNb[part * 32 + k]; }
                    af += shx(af, 1, lane); af += shx(af, 2, lane); ab += shx(ab, 1, lane); ab += shx(ab, 2, lane);
                    if (part == 0) { sQNf[t] = af; sQNb[t] = ab; }
                }
                __syncthreads();
                const float mpf = MPREV[seqf * 64 + c], mpb = MPREV[seqb * 64 + c];
                const int fr = lane & 15, fq = lane >> 4;
                u32x4 cbr[4];
#pragma unroll
                for (int i = 0; i < 4; ++i) { const int q = tid + 512 * i; cbr[i] = *(const u32x4*)(CPT + ((size_t)seqb * 64 + c) * 16384 + (size_t)(q >> 4) * 128 + (q & 15) * 8); }
                f32x4 accS[8];
                wave_mm(accS, BQ + wave * 16 * LDT, BK, lane);
                float rowBf[4], rowBb[4], mtf[4], mtb[4], inf_[4], inb_[4], rsf[4], rsb[4];
#pragma unroll
                for (int r = 0; r < 4; ++r) { const int t = wave * 16 + 4 * fq + r;
                    rowBf[r] = sBf[t]; rowBb[r] = sBb[t];
                    mtf[r] = rowBf[r] + fmaxf(mpf, sPf[t]); mtb[r] = rowBb[r] + fmaxf(mpb, sPb[t]);
                    inf_[r] = __expf(rowBf[r] + mpf - mtf[r]); inb_[r] = __expf(rowBb[r] + mpb - mtb[r]);
                    rsf[r] = 0.f; rsb[r] = 0.f; }
#pragma unroll
                for (int j = 0; j < 8; ++j) { const int s = j * 16 + fr; const float cf = sIf[s] - sBf[s], cb = sIb[s] - sBb[s];
#pragma unroll
                    for (int r = 0; r < 4; ++r) { const int t = wave * 16 + 4 * fq + r; const float sv = accS[j][r];
                        rsf[r] += (s <= t) ? __expf(rowBf[r] + cf - mtf[r]) * sv : 0.f;
                        rsb[r] += (s >= t) ? __expf(rowBb[r] + cb - mtb[r]) * sv : 0.f; } }
                float scf[4], scb[4], cif[4], cib[4];
#pragma unroll
                for (int r = 0; r < 4; ++r) { const int t = wave * 16 + 4 * fq + r;
                    float a = rsf[r] * 0.08838834764831845f, bq = rsb[r] * 0.08838834764831845f;
                    a += shx(a, 1, lane); a += shx(a, 2, lane); a += shx(a, 4, lane); a += shx(a, 8, lane);
                    bq += shx(bq, 1, lane); bq += shx(bq, 2, lane); bq += shx(bq, 4, lane); bq += shx(bq, 8, lane);
                    const float denf = inf_[r] * sQNf[t] + a, denb = inb_[r] * sQNb[t] + bq;
                    scf[r] = 1.0f / fmaxf(fabsf(denf), __expf(-mtf[r])); scb[r] = 1.0f / fmaxf(fabsf(denb), __expf(-mtb[r]));
                    cif[r] = scf[r] * inf_[r]; cib[r] = scb[r] * inb_[r];
                    scf[r] *= 0.08838834764831845f; scb[r] *= 0.08838834764831845f; }
                __syncthreads();
#pragma unroll
                for (int j = 0; j < 8; ++j) { const int s = j * 16 + fr; const float cf = sIf[s] - sBf[s], cb = sIb[s] - sBb[s];
#pragma unroll
                    for (int r = 0; r < 4; ++r) { const int t = wave * 16 + 4 * fq + r; const float sv = accS[j][r];
                        const float a = (s <= t) ? __expf(rowBf[r] + cf - mtf[r]) * scf[r] : 0.f;
                        const float bq = (s >= t) ? __expf(rowBb[r] + cb - mtb[r]) * scb[r] : 0.f;
                        BK[t * LDT + s] = tobf1((a + bq) * sv); } }
                __syncthreads();
                f32x4 hacc[8];
                wave_mm(hacc, BK + wave * 16 * LDT, BV, lane);
                f32x4 xacc[8];
                wave_mm(xacc, BQ + wave * 16 * LDT, BC, lane);
#pragma unroll
                for (int j = 0; j < 8; ++j)
#pragma unroll
                    for (int r = 0; r < 4; ++r) hacc[j][r] += cif[r] * xacc[j][r];
                __syncthreads();
#pragma unroll
                for (int i = 0; i < 4; ++i) { const int q = tid + 512 * i; *(LAS u32x4*)(BV + (q >> 4) * LDT + (q & 15) * 8) = cbr[i]; }
                __syncthreads();
                wave_mm(xacc, BQ + wave * 16 * LDT, BV, lane);
#pragma unroll
                for (int j = 0; j < 8; ++j)
#pragma unroll
                    for (int r = 0; r < 4; ++r) hacc[j][r] += cib[r] * xacc[j][r];
#pragma unroll
                for (int r = 0; r < 4; ++r) {
                    float sacc = 0.f;
#pragma unroll
                    for (int j = 0; j < 8; ++j) sacc += hacc[j][r];
                    sacc += shx(sacc, 1, lane); sacc += shx(sacc, 2, lane); sacc += shx(sacc, 4, lane); sacc += shx(sacc, 8, lane);
                    const float mu = sacc * (1.f / 128.f); float q = 0.f;
#pragma unroll
                    for (int j = 0; j < 8; ++j) { const float d = hacc[j][r] - mu; q += d * d; }
                    q += shx(q, 1, lane); q += shx(q, 2, lane); q += shx(q, 4, lane); q += shx(q, 8, lane);
                    const float rstd = 1.0f / sqrtf(q * (1.f / 128.f) + LN_EPS);
#pragma unroll
                    for (int j = 0; j < 8; ++j) hacc[j][r] = (hacc[j][r] - mu) * rstd;
                }
                __syncthreads();
                {   LAS float* HN = (LAS float*)lds;
#pragma unroll
                    for (int j = 0; j < 8; ++j)
#pragma unroll
                        for (int r = 0; r < 4; ++r) HN[(wave * 16 + 4 * fq + r) * 132 + j * 16 + fr] = hacc[j][r];
                    __syncthreads();
                    const int t = tid >> 2, cq = (tid & 3) * 32; const size_t tokrow = (size_t)b * SEQ + s0 + t; const int col0 = h * 128 + cq;
                    u32x4 xcv[4], mov[4];
#pragma unroll
                    for (int i = 0; i < 4; ++i) { xcv[i] = *(const u32x4*)(XC + tokrow * 512 + col0 + i * 8); mov[i] = *(const u32x4*)(MLO + tokrow * 512 + col0 + i * 8); }
#pragma unroll
                    for (int i = 0; i < 4; ++i) {
                        const f32x4 h0 = *(const LAS f32x4*)(HN + t * 132 + cq + i * 8), h1 = *(const LAS f32x4*)(HN + t * 132 + cq + i * 8 + 4);
                        const f32x4 n0 = *(const f32x4*)(normw + col0 + i * 8), n1 = *(const f32x4*)(normw + col0 + i * 8 + 4);
                        const f32x4 k0 = *(const f32x4*)(skipw + col0 + i * 8), k1 = *(const f32x4*)(skipw + col0 + i * 8 + 4);
                        const unsigned xw[4] = {xcv[i].x, xcv[i].y, xcv[i].z, xcv[i].w}, mw[4] = {mov[i].x, mov[i].y, mov[i].z, mov[i].w};
                        float o[8];
#pragma unroll
                        for (int j = 0; j < 4; ++j) {
                            const float ha = (j < 2 ? h0[2 * j] : h1[2 * j - 4]), hb = (j < 2 ? h0[2 * j + 1] : h1[2 * j - 3]);
                            const float na = (j < 2 ? n0[2 * j] : n1[2 * j - 4]), nb = (j < 2 ? n0[2 * j + 1] : n1[2 * j - 3]);
                            const float ka = (j < 2 ? k0[2 * j] : k1[2 * j - 4]), kb = (j < 2 ? k0[2 * j + 1] : k1[2 * j - 3]);
                            o[2 * j] = sigmoidf_(bflo(mw[j])) * (ha * na + ka * bflo(xw[j]));
                            o[2 * j + 1] = sigmoidf_(bfhi(mw[j])) * (hb * nb + kb * bfhi(xw[j])); }
                        u32x4 ow; ow.x = cvtpk(o[0], o[1]); ow.y = cvtpk(o[2], o[3]); ow.z = cvtpk(o[4], o[5]); ow.w = cvtpk(o[6], o[7]);
                        *(u32x4*)(YB + tokrow * 512 + col0 + i * 8) = ow;
                    }
                }
            }
            __syncthreads();
        }
        PHASE(PH_DIFF) {
            PH_LOCALS
            const float* lp = args.in[I_LAMBDA] + (size_t)l * 256;
            const float s1 = wave_sum(lp[lane] * lp[64 + lane], lane), s2 = wave_sum(lp[128 + lane] * lp[192 + lane], lane);
            const float lam_init = args.lam_init[l], lam = __expf(s1) - __expf(s2) + lam_init;
            const float* subln = args.in[I_SUBLN] + (size_t)l * 128;
            for (int u = vcu; u < 256; u += G) {
                const int b = u >> 7, h = (u >> 5) & 3, qb = u & 31;
                f32x16 o[4];
                const unsigned char* q8 = (const unsigned char*)QA; const unsigned char* k8 = (const unsigned char*)KA; const unsigned char* v8 = (const unsigned char*)VA + (size_t)(b * 4 + h) * SEQ * 128;
                att::CvtJob cj; cj.on = (l + 1 < DEPTH) ? 1 : 0; const int ln_ = cj.on ? l + 1 : l;
                cj.wgu = args.in[I_WGU] + (size_t)ln_ * NEXP * DM * 2048; cj.wdn = args.in[I_WDN] + (size_t)ln_ * NEXP * DFF * DM;
                cj.wgu8 = WGU8 + (size_t)ln_ * NEXP * 2048 * DM; cj.wdn8 = WDN8 + (size_t)ln_ * NEXP * DM * DFF; cj.wg = bx * 8 + wave; cj.qbase = 0;
                {   const size_t hb = ((size_t)(b * 8 + h * 2 + 0) * SEQ) * 64;
                    att::body8(q8 + hb + (size_t)qb * 256 * 64, k8 + hb, v8, SEQ / 64, o, (char*)lds_raw, tid, cj); }
                {   int t2 = tid; asm volatile("" : "+v"(t2));
                    GAS float* st = (GAS float*)(STASH + (size_t)bx * (16 * 512 * 4) + (size_t)t2 * 4);
#pragma unroll
                for (int d = 0; d < 4; ++d)
#pragma unroll
                    for (int q4 = 0; q4 < 4; ++q4) *(GAS f32x4*)(st + (size_t)(d * 4 + q4) * 2048) = (f32x4){o[d][q4 * 4], o[d][q4 * 4 + 1], o[d][q4 * 4 + 2], o[d][q4 * 4 + 3]}; }
                {   const size_t hb = ((size_t)(b * 8 + h * 2 + 1) * SEQ) * 64; cj.qbase = att::CVT_ITEMS;
                    att::body8(q8 + hb + (size_t)qb * 256 * 64, k8 + hb, v8, SEQ / 64, o, (char*)lds_raw, tid, cj); }
                float ss[16];
#pragma unroll
                for (int r = 0; r < 16; ++r) ss[r] = 0.f;
                int t3 = tid; asm volatile("" : "+v"(t3));
                const int r32 = t3 & 31, hi = (t3 >> 5) & 1;
                GAS float* st = (GAS float*)(STASH + (size_t)bx * (16 * 512 * 4) + (size_t)t3 * 4);
#pragma unroll
                for (int d = 0; d < 4; ++d)
#pragma unroll
                    for (int q4 = 0; q4 < 4; ++q4) { const f32x4 v = *(const GAS f32x4*)(st + (size_t)(d * 4 + q4) * 2048);
#pragma unroll
                        for (int k = 0; k < 4; ++k) { const float x = v[k] - lam * o[d][q4 * 4 + k]; o[d][q4 * 4 + k] = x; ss[q4 * 4 + k] += x * x; } }
#pragma unroll
                for (int r = 0; r < 16; ++r) { float v = ss[r]; v += shx(v, 1, lane); v += shx(v, 2, lane); v += shx(v, 4, lane); v += shx(v, 8, lane); v += shx(v, 16, lane);
                    ss[r] = (1.0f / sqrtf(v * (1.f / 128.f) + LN_EPS)) * (1.f - lam_init); }
                GAS bf16* yo = (GAS bf16*)(YA + ((size_t)b * SEQ + qb * 256 + wave * 32 + 4 * hi) * 512 + h * 128 + r32);
                asm volatile("" : "+v"(yo));
#pragma unroll
                for (int d = 0; d < 4; ++d) { const float gsc = subln[d * 32 + r32];
#pragma unroll
                    for (int r = 0; r < 16; ++r) yo[((r & 3) + 8 * (r >> 2)) * 512 + d * 32] = tobf1(o[d][r] * ss[r] * gsc); }
            }
            __syncthreads();
        }
        PHASE(PH_WIN) {
            PH_LOCALS
            const float* sinks = args.in[I_SINKS] + (size_t)l * 8;
            bf16x8 wkk[8], wvv[8];
            int vcu_l = vcu; asm volatile("" : "+s"(vcu_l));
#define WIN_DECODE(u_, b_, qh_, q0_, klo_, NT_) const int b_ = (u_) >> 8, qh_ = ((u_) >> 5) & 7, q0_ = ((u_) & 31) * 256; \
                const int klo_ = (q0_ - 128 < 0) ? 0 : q0_ - 128; const int NT_ = (((q0_ + 384 > SEQ) ? SEQ : q0_ + 384) - klo_) / 64
            {   WIN_DECODE(vcu_l * 2, b0_, qh0_, q00_, klo0_, NT0_);
                WIN_LOAD(wkk, wvv, WKb + ((size_t)(b0_ * 2 + (qh0_ >> 2)) * SEQ + klo0_) * 64, WVb + ((size_t)(b0_ * 2 + (qh0_ >> 2)) * SEQ + klo0_) * 64, NT0_, tid); }
#pragma unroll
            for (int i = 0; i < 2; ++i) {
                const int u = vcu_l * 2 + i;
                WIN_DECODE(u, b, qh, q0, klo, NT);
                WIN_STAGE(wkk, wvv, NT, (char*)lds_raw, tid);
                if (i == 0) { WIN_DECODE(u + 1, b1_, qh1_, q01_, klo1_, NT1_);
                    WIN_LOAD(wkk, wvv, WKb + ((size_t)(b1_ * 2 + (qh1_ >> 2)) * SEQ + klo1_) * 64, WVb + ((size_t)(b1_ * 2 + (qh1_ >> 2)) * SEQ + klo1_) * 64, NT1_, tid); }
                f32x16 o[2];
                att::win_compute(WQb + ((size_t)(b * 8 + qh) * SEQ + q0) * 64, NT, klo, q0, sinks[qh] * 1.4426950408889634f, o, (char*)lds_raw, tid);
                const int r32 = tid & 31, hi = (tid >> 5) & 1;
                GAS bf16* yo = (GAS bf16*)(YC + ((size_t)b * SEQ + q0 + wave * 32 + 4 * hi) * 512 + qh * 64 + r32);
                asm volatile("" : "+v"(yo));
#pragma unroll
                for (int d = 0; d < 2; ++d)
#pragma unroll
                    for (int r = 0; r < 16; ++r) yo[((r & 3) + 8 * (r >> 2)) * 512 + d * 32] = tobf1(o[d][r]);
            }
#undef WIN_DECODE
            SEAM();
        }
        PHASE(PH_MERGE) {
            PH_LOCALS
            pg8::Gemm g{YA, WP_T + (size_t)l * 3 * DM * 512, 512, 512, 512, (size_t)TOK * 512 * 2, nullptr};
            pg8::StaticOrder S; S.init(TOK / 256, DM / 256, G, bx, nullptr, 3);
            pg8::EpiMerge E{GT, MB};
            pg8::gemm_phase<pg8::EpiMerge, true>(lds, g, S, E, tid);
            SEAM();
        }
        PHASE(PH_OUT) {
            PH_LOCALS
            pg8::Gemm g{MB, WOUT_T + (size_t)l * DM * DM, DM, DM, DM, 0, nullptr};
            pg8::StaticOrder S; S.init(TOK / 256, DM / 256, G, bx, nullptr);
            pg8::EpiOut E{XB, ZB};
            pg8::gemm_phase<pg8::EpiOut, true>(lds, g, S, E, tid);
            SEAM();
        }
        PHASE(PH_LN1) {
            PH_LOCALS
            LAS float* PART = (LAS float*)lds;
            LAS float* RAW = (LAS float*)(lds + 8 * 32 * 33 * 4);
            LAS float* LG = (LAS float*)(lds + 8 * 32 * 33 * 4 + 64 * 33 * 4) + wave * (8 * 33);
            LAS int* LCNT = (LAS int*)(lds + 8 * 32 * 33 * 4 + 64 * 33 * 4 + 8 * 8 * 33 * 4);
            const float* g1 = args.in[I_LN1G] + (size_t)l * DM; const float* b1 = args.in[I_LN1B] + (size_t)l * DM;
            const float* cgcb = (const float*)(ws + OFF_CGCB) + (size_t)l * 64;
            const int tok0 = bx * (TOK / GRID);
            u32x2 zall[8][4];
#pragma unroll
            for (int q = 0; q < 8; ++q)
#pragma unroll
                for (int j = 0; j < 4; ++j) zall[q][j] = *(const u32x2*)(ZB + (size_t)(tok0 + wave * 8 + q) * DM + 4 * lane + 256 * j);
            __syncthreads();
            if (tid < 32) LCNT[tid] = 0;
            {
                const int tg = wave & 1, kq = wave >> 1, r32 = lane & 31, hi = lane >> 5;
                const bf16* zr = ZB + (size_t)(tok0 + tg * 32 + r32) * DM + kq * 256 + hi * 8;
                const bf16* whp = (const bf16*)(ws + OFF_RWGH) + ((size_t)l * NEXP + r32) * DM + kq * 256 + hi * 8;
                const bf16* wlp = (const bf16*)(ws + OFF_RWGL) + ((size_t)l * NEXP + r32) * DM + kq * 256 + hi * 8;
                f32x16 acc = f32x16{};
#pragma unroll 8
                for (int ks = 0; ks < 16; ++ks) {
                    const bf16x8 a_h = *(const bf16x8*)(zr + ks * 16);
                    const bf16x8 bh = *(const bf16x8*)(whp + ks * 16), bl = *(const bf16x8*)(wlp + ks * 16);
                    acc = __builtin_amdgcn_mfma_f32_32x32x16_bf16(a_h, bh, acc, 0, 0, 0);
                    acc = __builtin_amdgcn_mfma_f32_32x32x16_bf16(a_h, bl, acc, 0, 0, 0);
                }
#pragma unroll
                for (int r = 0; r < 16; ++r) PART[(wave * 32 + ((r & 3) + 8 * (r >> 2) + 4 * hi)) * 33 + r32] = acc[r];
            }
            __syncthreads();
            for (int i = tid; i < 64 * 32; i += NTHR) { const int t = i >> 5, e = i & 31, tg = t >> 5, tr = t & 31;
                RAW[t * 33 + e] = (PART[((0 * 2 + tg) * 32 + tr) * 33 + e] + PART[((1 * 2 + tg) * 32 + tr) * 33 + e]) + (PART[((2 * 2 + tg) * 32 + tr) * 33 + e] + PART[((3 * 2 + tg) * 32 + tr) * 33 + e]); }
            __syncthreads();
            f32x4 gv[4], bv[4];
#pragma unroll
            for (int j = 0; j < 4; ++j) { gv[j] = *(const f32x4*)(g1 + 4 * lane + 256 * j); bv[j] = *(const f32x4*)(b1 + 4 * lane + 256 * j); }
            const float cge = cgcb[lane & 31], cbe = cgcb[32 + (lane & 31)];
#pragma unroll
            for (int i0 = 0; i0 < 8; i0 += 2) {
                f32x4 v[2][4];
#pragma unroll
                for (int q = 0; q < 2; ++q)
#pragma unroll
                    for (int j = 0; j < 4; ++j) { const u32x2 w = zall[i0 + q][j]; v[q][j] = (f32x4){bflo(w.x), bfhi(w.x), bflo(w.y), bfhi(w.y)}; }
#pragma unroll
                for (int q = 0; q < 2; ++q) {
                    const int tl = wave * 8 + i0 + q, t = tok0 + tl;
                    float s = 0.f;
#pragma unroll
                    for (int j = 0; j < 4; ++j) s += (v[q][j][0] + v[q][j][1]) + (v[q][j][2] + v[q][j][3]);
                    const float mean = wave_sum(s, lane) * (1.f / DM); float s2 = 0.f;
#pragma unroll
                    for (int j = 0; j < 4; ++j) { v[q][j] = v[q][j] - mean; s2 += (v[q][j][0] * v[q][j][0] + v[q][j][1] * v[q][j][1]) + (v[q][j][2] * v[q][j][2] + v[q][j][3] * v[q][j][3]); }
                    const float rstd = 1.f / sqrtf(wave_sum(s2, lane) * (1.f / DM) + LN_EPS);
#pragma unroll
                    for (int j = 0; j < 4; ++j) { const f32x4 o = v[q][j] * rstd * gv[j] + bv[j];
                        u32x2 w; w.x = cvtpk(o[0], o[1]); w.y = cvtpk(o[2], o[3]);
                        *(u32x2*)(XB + (size_t)t * DM + 4 * lane + 256 * j) = w;
                        *(unsigned*)(XB8 + (size_t)t * DM + 4 * lane + 256 * j) = pk4_fp8(o[0], o[1], o[2], o[3]); }
                    if (lane < 32) LG[(i0 + q) * 33 + lane] = rstd * (RAW[tl * 33 + lane] - mean * cge) + cbe;
                }
            }
            LDS_WAIT(); asm volatile("" ::: "memory");
            if (lane < 8) {
                const int t = tok0 + wave * 8 + lane;
                float v0 = -INFINITY, v1 = -INFINITY, v2 = -INFINITY, v3 = -INFINITY; int e0 = 0, e1 = 0, e2 = 0, e3 = 0;
#pragma unroll 4
                for (int e = 0; e < 32; ++e) { const float x = LG[lane * 33 + e];
                    if (x > v0) { v3 = v2; e3 = e2; v2 = v1; e2 = e1; v1 = v0; e1 = e0; v0 = x; e0 = e; }
                    else if (x > v1) { v3 = v2; e3 = e2; v2 = v1; e2 = e1; v1 = x; e1 = e; }
                    else if (x > v2) { v3 = v2; e3 = e2; v2 = x; e2 = e; }
                    else if (x > v3) { v3 = x; e3 = e; } }
                const float p1 = __expf(v1 - v0), p2 = __expf(v2 - v0), p3 = __expf(v3 - v0), inv = 1.f / (1.f + p1 + p2 + p3);
                const int l0 = atomicAdd((int*)&LCNT[e0], 1), l1 = atomicAdd((int*)&LCNT[e1], 1), l2 = atomicAdd((int*)&LCNT[e2], 1), l3 = atomicAdd((int*)&LCNT[e3], 1);
                *(int4*)(TOKE + t * 4) = make_int4(e0, e1, e2, e3);
                *(float4*)(TOKW + t * 4) = make_float4(inv, p1 * inv, p2 * inv, p3 * inv);
                *(int4*)(TOKLP + t * 4) = make_int4(l0, l1, l2, l3);
            }
            __syncthreads();
            if (tid < 32) BLKCNT[bx * 32 + tid] = LCNT[tid];
            SEAM();
        }
        PHASE(PH_SORT) {
            PH_LOCALS
            LAS int* sTot = (LAS int*)lds; LAS int* sBase = sTot + 32; LAS int* sOff = sTot + 64; LAS int* sRow = sTot + 128;
            LAS int* sPT = sTot + 512; LAS int* sPB = sTot + 1024;
            __syncthreads();
            {   const int e = tid & 31, part = tid >> 5; int tot = 0, base = 0;
#pragma unroll
                for (int i = 0; i < 16; ++i) { const int b2 = part * 16 + i; const int c = BLKCNT[b2 * 32 + e]; tot += c; base += (b2 < bx) ? c : 0; }
                sPT[tid] = tot; sPB[tid] = base; }
            __syncthreads();
            if (tid < 32) { int tot = 0, base = 0;
#pragma unroll
                for (int p = 0; p < 16; ++p) { tot += sPT[p * 32 + tid]; base += sPB[p * 32 + tid]; } sTot[tid] = tot; sBase[tid] = base; }
            __syncthreads();
            if (tid == 0) { int off = 0, nt = 0;
#pragma unroll 1
                for (int e = 0; e < 32; ++e) { sOff[e] = off; const int n = (sTot[e] + 255) >> 8;
                    if (bx == 0) {
#pragma unroll 1
                        for (int i = 0; i < n; ++i) TILEE[nt + i] = e; }
                    nt += n; off += n * 256; }
                if (bx == 0) TILEE[512] = nt; }
            __syncthreads();
            if (tid < 256) { const int t = bx * 64 + (tid >> 2), k = tid & 3; const int e = TOKE[t * 4 + k];
                const int row = sOff[e] + sBase[e] + TOKLP[t * 4 + k]; TOKROW[t * 4 + k] = row; ROWW[row] = TOKW[t * 4 + k]; ROWTOK[row] = t; }
            if (bx < 32 && tid < 256) { const int lo = sOff[bx] + sTot[bx], hi = sOff[bx] + (((sTot[bx] + 255) >> 8) << 8);
                if (lo + tid < hi) ROWTOK[lo + tid] = 0; }
            SEAM();
        }
        PHASE(PH_GU) {
            PH_LOCALS
            const int ntiles = __builtin_amdgcn_readfirstlane(TILEE[512]);
            pg8::Gemm g{(const bf16*)XB8, (const bf16*)(WGU8 + (size_t)l * NEXP * 2048 * DM), DM / 2, DM / 2, DM / 2, 0, ROWTOK};
            pg8::StaticOrder S; S.init(ntiles, 8, G, bx, TILEE);
            pg8::EpiSwiglu E{args.in[I_BGU] + (size_t)l * NEXP * 2048, TILEE, ACT8};
            pg8::gemm_phase<pg8::EpiSwiglu, true, true, true>(lds, g, S, E, tid);
            SEAM();
        }
        PHASE(PH_DOWN) {
            PH_LOCALS
            const int ntiles = __builtin_amdgcn_readfirstlane(TILEE[512]);
            pg8::Gemm g{(const bf16*)ACT8, (const bf16*)(WDN8 + (size_t)l * NEXP * DM * DFF), DFF / 2, DFF / 2, DFF / 2, 0, nullptr};
            pg8::StaticOrder S; S.init(ntiles, 4, G, bx, TILEE, 1, 1);
            pg8::EpiDown E{args.in[I_BDN] + (size_t)l * NEXP * DM, TILEE, ROWW, (unsigned char*)YS};
            pg8::gemm_phase<pg8::EpiDown, true, false, true>(lds, g, S, E, tid);
            SEAM();
        }
        PHASE(PH_LN2) {
            PH_LOCALS
            const float* g2 = args.in[I_LN2G] + (size_t)l * DM; const float* b2 = args.in[I_LN2B] + (size_t)l * DM;
            f32x4 gv[4], bv[4];
#pragma unroll
            for (int j = 0; j < 4; ++j) { gv[j] = *(const f32x4*)(g2 + 4 * lane + 256 * j); bv[j] = *(const f32x4*)(b2 + 4 * lane + 256 * j); }
            const int tw0 = bx * (TOK / GRID) + wave * 8;
            const int myrow = TOKROW[tw0 * 4 + (lane & 31)];
#pragma unroll 1
            for (int i0 = 0; i0 < 8; i0 += 4) {
                u32x2 xb4[4][4]; unsigned ys4[4][4][4];
#pragma unroll
                for (int q = 0; q < 4; ++q) { const int t = tw0 + i0 + q;
#pragma unroll
                    for (int j = 0; j < 4; ++j) xb4[q][j] = *(const u32x2*)(XB + (size_t)t * DM + 4 * lane + 256 * j);
#pragma unroll
                    for (int k = 0; k < 4; ++k) { const int row = __builtin_amdgcn_readlane(myrow, (i0 + q) * 4 + k); const unsigned char* yr = (const unsigned char*)YS + (size_t)row * DM;
#pragma unroll
                        for (int j = 0; j < 4; ++j) ys4[q][k][j] = *(const unsigned*)(yr + 4 * lane + 256 * j); } }
#pragma unroll
                for (int q = 0; q < 4; ++q) {
                    const int t = tw0 + i0 + q;
                    f32x4 v[4];
#pragma unroll
                    for (int j = 0; j < 4; ++j) { const u32x2 w = xb4[q][j]; v[j] = (f32x4){bflo(w.x), bfhi(w.x), bflo(w.y), bfhi(w.y)} * DN_ALPHA;
                        f32x4 ya = (f32x4){0.f, 0.f, 0.f, 0.f};
#pragma unroll
                        for (int k = 0; k < 4; ++k) { const unsigned y = ys4[q][k][j]; const f32x2 lo = __builtin_amdgcn_cvt_pk_f32_fp8((int)y, false), hi2 = __builtin_amdgcn_cvt_pk_f32_fp8((int)y, true);
                            ya[0] += lo[0]; ya[1] += lo[1]; ya[2] += hi2[0]; ya[3] += hi2[1]; }
                        v[j] = v[j] + ya * (1.0f / YS8_SCALE); }
                    float sacc = 0.f;
#pragma unroll
                    for (int j = 0; j < 4; ++j) sacc += (v[j][0] + v[j][1]) + (v[j][2] + v[j][3]);
                    const float mean = wave_sum(sacc, lane) * (1.f / DM); float s2 = 0.f;
#pragma unroll
                    for (int j = 0; j < 4; ++j) { v[j] = v[j] - mean; s2 += (v[j][0] * v[j][0] + v[j][1] * v[j][1]) + (v[j][2] * v[j][2] + v[j][3] * v[j][3]); }
                    const float rstd = 1.f / sqrtf(wave_sum(s2, lane) * (1.f / DM) + LN_EPS);
#pragma unroll
                    for (int j = 0; j < 4; ++j) { const f32x4 o = v[j] * rstd * gv[j] + bv[j];
                        if (l == DEPTH - 1) *(f32x4*)(args.out + (size_t)t * DM + 4 * lane + 256 * j) = o;
                        u32x2 w; w.x = cvtpk(o[0], o[1]); w.y = cvtpk(o[2], o[3]);
                        *(u32x2*)(XB + (size_t)t * DM + 4 * lane + 256 * j) = w;
                        *(unsigned*)(XB8I + (size_t)t * DM + 4 * lane + 256 * j) = pk4_fp8(o[0], o[1], o[2], o[3]); }
                }
            }
            if (l + 1 < args.lay_hi) SEAM();
        }
#undef IN
#undef PHASE
    }
}

extern "C" void kernel_launch(void* const* d_in, const int* in_sizes, int n_in, void* d_out, int out_size, void* d_ws, size_t ws_size, hipStream_t stream) {
    static int ok = 0;
    if (ok == 0) {
        if (n_in != 28 || in_sizes[0] != TOK * DM || out_size != TOK * DM || ws_size < WS_END) {
            fprintf(stderr, "kernel_launch: unexpected shapes: n_in %d in0 %d out %d ws %zu (need %zu)\n", n_in, n_in > 0 ? in_sizes[0] : -1, out_size, ws_size, (size_t)WS_END); ok = -1; return; }
        int dev = 0, cus = 0, per_cu = 0;
        hipGetDevice(&dev); hipDeviceGetAttribute(&cus, hipDeviceAttributeMultiprocessorCount, dev);
        if (hipFuncSetAttribute((const void*)mega, hipFuncAttributeMaxDynamicSharedMemorySize, LDS_BYTES) != hipSuccess) { fprintf(stderr, "kernel_launch: hipFuncSetAttribute failed\n"); ok = -1; return; }
        if (hipOccupancyMaxActiveBlocksPerMultiprocessor(&per_cu, (const void*)mega, NTHR, LDS_BYTES) != hipSuccess || per_cu < 1) fprintf(stderr, "kernel_launch: occupancy query says %d blocks/CU\n", per_cu);
        (void)hipGetLastError();
        if (cus < GRID) { fprintf(stderr, "kernel_launch: device has %d CUs, need %d\n", cus, GRID); ok = -1; return; }
        ok = 1;
    }
    if (ok < 0) return;
    hipMemsetAsync((char*)d_ws + OFF_CTL, 0, CTL_BYTES, stream);
    Args a{};
    for (int i = 0; i < 28; ++i) a.in[i] = (const float*)d_in[i];
    a.out = (float*)d_out; a.ws = (unsigned char*)d_ws;
    for (int l = 0; l < 4; ++l) a.lam_init[l] = (float)(0.8 - 0.6 * exp(-0.3 * (double)l));
#if MK_MULTI
    a.single = 0;
    a.lay_lo = -1; a.lay_hi = 0; a.ph_lo = 0; a.ph_hi = 0;
    hipLaunchKernelGGL(mega, dim3(GRID), dim3(NTHR), LDS_BYTES, stream, a);
    for (int l = 0; l < DEPTH; ++l) for (int p = 1; p < PH_END; ++p) { a.lay_lo = l; a.lay_hi = l + 1; a.ph_lo = p; a.ph_hi = p + 1; hipLaunchKernelGGL(mega, dim3(GRID), dim3(NTHR), LDS_BYTES, stream, a); }
#else
    a.single = 1; a.lay_lo = -1; a.lay_hi = DEPTH; a.ph_lo = 1; a.ph_hi = PH_END;
    hipLaunchKernelGGL(mega, dim3(GRID), dim3(NTHR), LDS_BYTES, stream, a);
#endif
    const hipError_t le = hipPeekAtLastError();
    if (le != hipSuccess) fprintf(stderr, "kernel_launch: launch failed: %s\n", hipGetErrorName(le));
}
```

```cpp
#include <hip/hip_runtime.h>
#include <cstdio>
#include <cstdint>
#include <cmath>

#ifndef MK_MULTI
#define MK_MULTI 0
#endif

#ifndef REPEAT_MASK
#define REPEAT_MASK 0ull
#endif
#ifndef PHASE_MASK
#define PHASE_MASK 0xffffffffull
#endif
#define LAS __attribute__((address_space(3)))
#define GAS __attribute__((address_space(1)))
typedef unsigned short bf16;
typedef short bf16x8 __attribute__((ext_vector_type(8)));
typedef short s16x4 __attribute__((ext_vector_type(4)));
typedef float f32x2 __attribute__((ext_vector_type(2)));
typedef float f32x4 __attribute__((ext_vector_type(4)));
typedef float f32x16 __attribute__((ext_vector_type(16)));
typedef unsigned u32x2 __attribute__((ext_vector_type(2)));
typedef unsigned u32x4 __attribute__((ext_vector_type(4)));

constexpr int BATCH = 2, SEQ = 8192, DM = 1024, TOK = BATCH * SEQ, DEPTH = 4, DIN = 6400;
constexpr int NEXP = 32, DFF = 1024;
constexpr int WA_K_COL = 3072, WA_V_COL = 3200;
constexpr float DN_ALPHA = 1.6817928305074290f;
constexpr float LN_EPS = 1e-5f;
constexpr int NTHR = 512, NWAVES = 8, GRID = 256;
constexpr int MAXROWS = 73728;

constexpr size_t MiB = 1ull << 20;
constexpr size_t OFF_CTL = 0, CTL_BYTES = 1 * MiB;
constexpr size_t OFF_ROPE = 1 * MiB;
constexpr size_t OFF_WML = 3 * MiB;
constexpr size_t OFF_MISC = 5 * MiB;
constexpr size_t OFF_G4 = OFF_MISC;
constexpr size_t OFF_NLOC = OFF_MISC + 1 * MiB;
constexpr size_t OFF_NPREV = OFF_NLOC + 512 * 1024;
constexpr size_t OFF_MLOC = OFF_MISC + 2 * MiB;
constexpr size_t OFF_GCH = OFF_MLOC + 4096;
constexpr size_t OFF_MPREV = OFF_GCH + 4096;
constexpr size_t OFF_BLKCNT = OFF_MLOC + 16384;
constexpr size_t OFF_CGCB = OFF_MLOC + 49152;
constexpr size_t OFF_TILEE = OFF_MLOC + 65536;
constexpr size_t OFF_RWGH = OFF_MISC + 2 * MiB + 512 * 1024;
constexpr size_t OFF_RWGL = OFF_RWGH + 256 * 1024;
constexpr size_t OFF_ROWW = OFF_MLOC + 131072;
constexpr size_t OFF_TOKE = OFF_MISC + 3 * MiB;
constexpr size_t OFF_TOKW = OFF_TOKE + 256 * 1024;
constexpr size_t OFF_TOKLP = OFF_TOKW + 256 * 1024;
constexpr size_t OFF_TOKROW = OFF_TOKLP + 256 * 1024;
constexpr size_t OFF_WIN = 9 * MiB;
constexpr size_t OFF_WP = OFF_WIN + 50 * MiB;
constexpr size_t OFF_WOUT = OFF_WP + 12 * MiB;
constexpr size_t OFF_WGU = OFF_WOUT + 8 * MiB;
constexpr size_t OFF_WDN = OFF_WGU + 512 * MiB;
constexpr size_t OFF_XB = OFF_WDN + 256 * MiB;
constexpr size_t OFF_XF = OFF_XB + 32 * MiB;
constexpr size_t OFF_QA = OFF_XF + 64 * MiB;
constexpr size_t OFF_KA = OFF_QA + 16 * MiB;
constexpr size_t OFF_VA = OFF_KA + 16 * MiB;
constexpr size_t OFF_MLX = OFF_VA + 16 * MiB;
constexpr size_t OFF_MLO = OFF_MLX + 16 * MiB;
constexpr size_t OFF_XC = OFF_MLO + 16 * MiB;
constexpr size_t OFF_WQ = OFF_XC + 16 * MiB;
constexpr size_t OFF_WK = OFF_WQ + 16 * MiB;
constexpr size_t OFF_WV = OFF_WK + 4 * MiB;
constexpr size_t OFF_GT = OFF_WV + 4 * MiB;
constexpr size_t OFF_Y3 = OFF_GT + 96 * MiB;
constexpr size_t OFF_MF = OFF_Y3 + 48 * MiB;
constexpr size_t OFF_MB = OFF_MF + 64 * MiB;
constexpr size_t OFF_MQ = OFF_MB + 32 * MiB;
constexpr size_t OFF_CLOC = OFF_MQ + 48 * MiB;
constexpr size_t OFF_CPT = OFF_CLOC + 64 * MiB;
constexpr size_t OFF_STASH = OFF_CPT + 32 * MiB;
constexpr size_t OFF_XG = OFF_STASH + 32 * MiB;
constexpr size_t OFF_ACT = OFF_XG + 144 * MiB;
constexpr size_t OFF_YS = OFF_ACT + 144 * MiB;
constexpr size_t OFF_ZB = OFF_YS + 144 * MiB;
constexpr size_t OFF_X1 = OFF_ZB + 64 * MiB;
constexpr size_t OFF_WGT = OFF_X1 + 64 * MiB;
constexpr size_t OFF_ROWTOK = OFF_WGT + 1 * MiB;
constexpr size_t OFF_XB8 = OFF_ROWTOK + 1 * MiB;
constexpr size_t WS_END = OFF_XB8 + 16 * MiB;

constexpr int PH_LDS = 147456;
constexpr int LDS_BYTES = PH_LDS + 256;

typedef float f32x2_cv __attribute__((ext_vector_type(2))); typedef __bf16 bf16x2_cv __attribute__((ext_vector_type(2)));
__device__ __forceinline__ unsigned cvtpk(float lo, float hi) { const f32x2_cv v = {lo, hi}; const bf16x2_cv b = __builtin_convertvector(v, bf16x2_cv); return __builtin_bit_cast(unsigned, b); }
__device__ __forceinline__ float bflo(unsigned u) { return __uint_as_float(u << 16); }
__device__ __forceinline__ float bfhi(unsigned u) { return __uint_as_float(u & 0xffff0000u); }
__device__ __forceinline__ float bf1(bf16 h) { return __uint_as_float(((unsigned)h) << 16); }
__device__ __forceinline__ bf16 tobf1(float f) { return (bf16)(cvtpk(f, 0.f) & 0xffffu); }
__device__ __forceinline__ float sigmoidf_(float x) { return __builtin_amdgcn_rcpf(1.0f + __builtin_amdgcn_exp2f(-1.4426950408889634f * x)); }
__device__ __forceinline__ float shx(float v, int mask, int lane) { return __int_as_float(__builtin_amdgcn_ds_bpermute((lane ^ mask) << 2, __float_as_int(v))); }
__device__ __forceinline__ float shup(float v, int off, int lane) { return __int_as_float(__builtin_amdgcn_ds_bpermute((lane - off) << 2, __float_as_int(v))); }
__device__ __forceinline__ float wave_sum(float v, int lane) {
#pragma unroll
    for (int o = 1; o < 64; o <<= 1) v += shx(v, o, lane);
    return v;
}
__device__ __forceinline__ float wave_max(float v, int lane) {
#pragma unroll
    for (int o = 1; o < 64; o <<= 1) v = fmaxf(v, shx(v, o, lane));
    return v;
}
#define LDS_WAIT() asm volatile("s_waitcnt lgkmcnt(0)" ::: "memory")

__device__ __forceinline__ unsigned pk4_fp8(float a, float b, float c, float d) { int w = __builtin_amdgcn_cvt_pk_fp8_f32(a, b, 0, false); w = __builtin_amdgcn_cvt_pk_fp8_f32(c, d, w, true); return (unsigned)w; }
constexpr float W8_GU_SCALE = 32.f, W8_DN_SCALE = 64.f, W8_IN_SCALE = 32.f, YS8_SCALE = 16.f;

namespace pg8 {
constexpr int BM = 256, BK = 64, HALF = 128, HTB = HALF * BK * 2, STAGE_BYTES = 8 * HTB, NXCD = 8, WGM = 8;
__host__ __device__ __forceinline__ int lds_byte(int r, int c) { const int st = (r >> 4) * 2 + (c >> 5), rr = r & 15, cc = c & 31, ob = rr * 64 + cc * 2; return st * 1024 + (ob ^ (((ob >> 9) & 1) << 5)); }
__host__ __device__ __forceinline__ void stage_rc(int b, int& R, int& C) { const int st = b / 1024, sb = b % 1024, swz = sb ^ (((sb >> 9) & 1) << 5); R = (st >> 1) * 16 + swz / 64; C = (st & 1) * 32 + (swz % 64) / 2; }
__host__ __device__ __forceinline__ int perm32(int rho) { const int n = rho >> 4, i = rho & 15; return 8 * (i >> 2) + 4 * n + (i & 3); }

struct Unit { int pm, pn, bt, br, hf; };
struct Gemm { const bf16* A; const bf16* Bt; int lda, ldb, K; size_t abr; const int* rowtok; };

__device__ __forceinline__ void tile_of(int wgid, int nwg, int nM, int nN, int& pm, int& pn) {
    { const int q = nwg / NXCD, r = nwg % NXCD, xcd = wgid % NXCD, off = wgid / NXCD; wgid = (xcd < r ? xcd * (q + 1) : r * (q + 1) + (xcd - r) * q) + off; }
    const int nig = WGM * nN, gid = wgid / nig, fm = gid * WGM, gsz = (nM - fm) < WGM ? (nM - fm) : WGM;
    pm = fm + ((wgid % nig) % gsz); pn = (wgid % nig) / gsz;
}
struct StaticOrder {
    int nM, nN, nwg, G, c, nbr, split; const int* tile_e;
    __device__ void init(int nM_, int nN_, int G_, int c_, const int* te, int nbr_ = 1, int split_ = 0) { nM = nM_; nN = nN_; nwg = nM * nN; G = G_; c = c_; tile_e = te; nbr = nbr_; split = split_; }
    __device__ bool next(int i, Unit& u) const {
        long L = (nbr > 1) ? (long)c : (long)i * G + c; if (nbr > 1 && i >= nbr) return false;
        u.hf = 0;
        const int R = nwg % G, full = nwg - R;
        if (split && R > 0 && 2 * R <= G && L >= full) { const int j = (int)(L - full); if (j >= 2 * R) return false; L = full + (j % R); u.hf = 1 + j / R; }
        else if (L >= nwg) return false;
        u.br = (nbr > 1) ? i : 0;
        tile_of((int)L, nwg, nM, nN, u.pm, u.pn);
        u.bt = tile_e ? (__builtin_amdgcn_readfirstlane(tile_e[u.pm]) * nN + u.pn) : (u.br * nN + u.pn);
        return true;
    }
};

static_assert(WGM == 8 && NXCD == 8, "InprojOrder mode 2 deals the last 64 list positions as half units: with these constants they are exactly the 64 tiles of gate column tile 24");
struct InprojOrder {
    int mode, c;
    __device__ bool next(int i, Unit& u) const {
        int L, nN, pn;
        int hf = 0;
        if (mode == 2) { nN = 25; if (i < 6) L = i * 256 + c; else if (i == 6 && c < 128) { L = 1536 + (c & 63); hf = 1 + (c >> 6); } else return false; }
        else if (mode == 0) { nN = 5; if (i == 0) L = c; else if (i == 1 && c < 64) L = 256 + c; else return false; }
        else { nN = 20; if (i < 4) L = i * 256 + c; else if (i == 4 && c >= 64) L = 1024 + (c - 64); else if (i == 5 && c >= 192) L = 1216 + (c - 192); else return false; }
        u.br = 0; u.hf = hf;
        tile_of(L, 64 * nN, 64, nN, u.pm, pn);
        if (mode == 2) { u.pn = pn; u.bt = pn; }
        else if (mode == 0) { u.pn = pn < 2 ? 6 + pn : 8 + pn; u.bt = u.pn; }
        else { u.pn = pn < 6 ? pn : (pn < 8 ? pn + 2 : pn + 5); u.bt = pn; }
        return true;
    }
};

typedef int i32x4v __attribute__((ext_vector_type(4))); typedef int i32x8v __attribute__((ext_vector_type(8)));
__device__ __forceinline__ i32x8v cat16(const bf16x8 a, const bf16x8 b) { const i32x4v x = __builtin_bit_cast(i32x4v, a), y = __builtin_bit_cast(i32x4v, b); return (i32x8v){x[0], x[1], x[2], x[3], y[0], y[1], y[2], y[3]}; }
template <class Epi, bool ALIGN_EPI, bool GATHER = false, bool FP8 = false, class Order = StaticOrder>
__device__ __forceinline__ void gemm_phase(LAS unsigned char* lds, const Gemm g, const Order& S, const Epi& E, int tid) {
    asm volatile("" : "+v"(tid));
    const int wid = __builtin_amdgcn_readfirstlane(tid >> 6), lane = tid & 63, wr = wid >> 2, wc = wid & 3, fr = lane & 15, fq = lane >> 4;
    const int K = g.K, nt = K / BK;
    unsigned voffA[2], voffB[2]; int RA[2], CA[2];
#pragma unroll
    for (int i = 0; i < 2; ++i) { int R, C; stage_rc(tid * 16 + i * 8192, R, C); const int Rb = Epi::PERM ? ((R & ~31) + perm32(R & 31)) : R;
        RA[i] = R; CA[i] = C; voffA[i] = (unsigned)(R * g.lda + C) * 2u; voffB[i] = (unsigned)(Rb * g.ldb + C) * 2u; }
    unsigned voffAc[2][2], voffAn[2][2];
#define PG8_GOFF(dst, pm_) do { _Pragma("unroll") for (int _h = 0; _h < 2; ++_h) _Pragma("unroll") for (int _i = 0; _i < 2; ++_i) \
        dst[_h][_i] = (unsigned)(g.rowtok[(pm_) * BM + _h * HALF + RA[_i]] * g.lda + CA[_i]) * 2u; } while (0)
#define PG8_STAGE_A(bufoff, ptr_ng, kidx, half, usenext) do { if constexpr (GATHER) { const char* gb_ = (const char*)g.A + (size_t)(kidx) * kstep; \
        _Pragma("unroll") for (int _i = 0; _i < 2; ++_i) { const unsigned vo_ = (usenext) ? voffAn[half][_i] : voffAc[half][_i]; \
            __builtin_amdgcn_global_load_lds((const unsigned*)(gb_ + vo_), (LAS unsigned*)(lds + (bufoff) + ldsw + _i * 8192), 16, 0, 0); } } \
        else { PG8_STAGE(bufoff, (ptr_ng) + ((half) ? hsA : 0), voffA); } } while (0)
    const size_t kstep = (size_t)(BK * 2);
    const size_t hsA = (size_t)HALF * g.lda * 2, hsB = (size_t)HALF * g.ldb * 2;
    const size_t tsA = 2 * hsA, tsB = 2 * hsB;
    const unsigned ldsw = (unsigned)wid * 1024u;
    const int aoff = lds_byte(wr * 64 + fr, fq * 8), boff = lds_byte(wc * 32 + fr, fq * 8);
#define PG8_SA(b, h) (((b) * 2 + (h)) * HTB)
#define PG8_SB(b, h) ((4 + (b) * 2 + (h)) * HTB)
#define PG8_STAGE(bufoff, gbase, voff) do { _Pragma("unroll") for (int _i = 0; _i < 2; ++_i) \
        __builtin_amdgcn_global_load_lds((const unsigned*)((const char*)(gbase) + (voff)[_i]), (LAS unsigned*)(lds + (bufoff) + ldsw + _i * 8192), 16, 0, 0); } while (0)
#define PG8_LDA(dst, b, h) do { if constexpr (FP8) { _Pragma("unroll") for (int m = 0; m < 4; ++m) dst##8[m] = cat16(*(const LAS bf16x8*)(lds + PG8_SA(b, h) + aoff + m * 2048), *(const LAS bf16x8*)(lds + PG8_SA(b, h) + aoff + m * 2048 + 1024)); } \
        else { _Pragma("unroll") for (int m = 0; m < 4; ++m) _Pragma("unroll") for (int k = 0; k < 2; ++k) dst[m][k] = *(const LAS bf16x8*)(lds + PG8_SA(b, h) + aoff + m * 2048 + k * 1024); } } while (0)
#define PG8_LDB(dst, b, h) do { if constexpr (FP8) { _Pragma("unroll") for (int n = 0; n < 2; ++n) dst##8[n] = cat16(*(const LAS bf16x8*)(lds + PG8_SB(b, h) + boff + n * 2048), *(const LAS bf16x8*)(lds + PG8_SB(b, h) + boff + n * 2048 + 1024)); } \
        else { _Pragma("unroll") for (int n = 0; n < 2; ++n) _Pragma("unroll") for (int k = 0; k < 2; ++k) dst[n][k] = *(const LAS bf16x8*)(lds + PG8_SB(b, h) + boff + n * 2048 + k * 1024); } } while (0)
#define PG8_MMA(ai, bj, At, Bt) do { __builtin_amdgcn_s_setprio(1); _Pragma("unroll") for (int m = 0; m < 4; ++m) _Pragma("unroll") for (int n = 0; n < 2; ++n) { \
        if constexpr (FP8) asm volatile("v_mfma_scale_f32_16x16x128_f8f6f4 %0, %1, %2, %0, %3, %3 op_sel_hi:[0,0,0]" : "+v"(acc[ai][bj][m][n]) : "v"(Bt##8[n]), "v"(At##8[m]), "v"(mx_one)); \
        else { _Pragma("unroll") for (int k = 0; k < 2; ++k) acc[ai][bj][m][n] = __builtin_amdgcn_mfma_f32_16x16x32_bf16(Bt[n][k], At[m][k], acc[ai][bj][m][n], 0, 0, 0); } } \
        __builtin_amdgcn_s_setprio(0); } while (0)
#define PG8_WAIT_V(n) asm volatile("s_waitcnt vmcnt(" #n ")" ::: "memory")
#define PG8_WAIT_L(n) asm volatile("s_waitcnt lgkmcnt(" #n ")" ::: "memory")
#define PG8_BAR __builtin_amdgcn_s_barrier()
#define PG8_SCHED __builtin_amdgcn_sched_barrier(0)
    Unit cur, nxt; int ui = 0;
    if (!S.next(0, cur)) return;
    f32x4 acc[2][2][4][2];
#pragma unroll
    for (int a = 0; a < 2; ++a)
#pragma unroll
        for (int b = 0; b < 2; ++b)
#pragma unroll
            for (int m = 0; m < 4; ++m)
#pragma unroll
                for (int n = 0; n < 2; ++n) acc[a][b][m][n] = (f32x4){0.f, 0.f, 0.f, 0.f};
    bf16x8 At[4][2], B0[2][2], B1[2][2];
    i32x8v At8[4], B08[2], B18[2];
    const int mx_one = 0x7F7F7F7F;
    const char* cA = (const char*)g.A + (size_t)cur.br * g.abr + (size_t)cur.pm * tsA; const char* cB = (const char*)g.Bt + (size_t)cur.bt * tsB + (cur.hf == 2 ? hsB : 0);
    size_t hoC = cur.hf ? 0 : hsB;
    if constexpr (GATHER) { PG8_GOFF(voffAc, cur.pm); PG8_GOFF(voffAn, cur.pm); }
    PG8_STAGE(PG8_SB(0, 0), cB, voffB); PG8_STAGE(PG8_SB(0, 1), cB + hoC, voffB); PG8_STAGE_A(PG8_SA(0, 0), cA, 0, 0, false); PG8_STAGE_A(PG8_SA(0, 1), cA, 0, 1, false);
    if (wr == 1) PG8_BAR;
    PG8_WAIT_V(2); PG8_BAR;
    PG8_STAGE(PG8_SB(1, 0), cB + kstep, voffB); PG8_STAGE_A(PG8_SA(1, 0), cA + kstep, 1, 0, false); PG8_STAGE(PG8_SB(1, 1), cB + hoC + kstep, voffB);
    PG8_WAIT_V(6); PG8_BAR;
    for (;;) {
        const bool has_next = S.next(ui + 1, nxt);
        const char* nA = has_next ? (const char*)g.A + (size_t)nxt.br * g.abr + (size_t)nxt.pm * tsA : cA; const char* nB = has_next ? (const char*)g.Bt + (size_t)nxt.bt * tsB + (nxt.hf == 2 ? hsB : 0) : cB;
        const size_t hoN = has_next ? (nxt.hf ? 0 : hsB) : hoC; const bool whole = cur.hf == 0;
        if constexpr (GATHER) { if (has_next) PG8_GOFF(voffAn, nxt.pm); }
#pragma unroll 1
        for (int t = 0; t < nt; t += 2) {
            const bool last = (t == nt - 2);
            const bool un = last && has_next;
            const int k2 = last ? 0 : t + 2;
            const char* a1 = cA + (size_t)(t + 1) * kstep;
            const char* a2 = last ? nA : cA + (size_t)(t + 2) * kstep; const char* b2 = last ? nB : cB + (size_t)(t + 2) * kstep;
            const char* a3 = a2 + kstep; const char* b3 = b2 + kstep; const size_t ho2 = last ? hoN : hoC;
            PG8_LDB(B0, 0, 0); if (whole) PG8_LDB(B1, 0, 1); PG8_SCHED; PG8_LDA(At, 0, 0); PG8_STAGE_A(PG8_SA(1, 1), a1, t + 1, 1, false);
            PG8_WAIT_V(8); PG8_WAIT_L(0); PG8_BAR; PG8_MMA(0, 0, At, B0); if (whole) PG8_MMA(0, 1, At, B1); PG8_BAR; PG8_SCHED;
            PG8_LDA(At, 0, 1); PG8_STAGE(PG8_SB(0, 0), b2, voffB); PG8_STAGE(PG8_SB(0, 1), b2 + ho2, voffB); PG8_STAGE_A(PG8_SA(0, 0), a2, k2, 0, un);
            PG8_WAIT_V(8); PG8_WAIT_L(0); PG8_BAR; PG8_MMA(1, 0, At, B0); if (whole) PG8_MMA(1, 1, At, B1); PG8_BAR; PG8_SCHED;
            PG8_LDB(B0, 1, 0); if (whole) PG8_LDB(B1, 1, 1); PG8_SCHED; PG8_LDA(At, 1, 0); PG8_STAGE_A(PG8_SA(0, 1), a2, k2, 1, un);
            PG8_WAIT_V(8); PG8_WAIT_L(0); PG8_BAR; PG8_MMA(0, 0, At, B0); if (whole) PG8_MMA(0, 1, At, B1); PG8_BAR; PG8_SCHED;
            PG8_LDA(At, 1, 1); PG8_STAGE(PG8_SB(1, 0), b3, voffB); PG8_STAGE(PG8_SB(1, 1), b3 + ho2, voffB); PG8_STAGE_A(PG8_SA(1, 0), a3, k2 + 1, 0, un);
            PG8_WAIT_V(8); PG8_WAIT_L(0); PG8_BAR; PG8_MMA(1, 0, At, B0); if (whole) PG8_MMA(1, 1, At, B1); PG8_BAR; PG8_SCHED;
        }
        if constexpr (ALIGN_EPI) { if (wr == 0) PG8_BAR; }
        if constexpr (FP8) asm volatile("s_nop 15\n\ts_nop 15\n\ts_nop 15\n\ts_nop 15" ::: "memory");
        E(acc, cur, wr, wc, fr, fq);
        if (!has_next) break;
        if (!(Epi::CARRY && cur.br < 2)) {
#pragma unroll
        for (int a = 0; a < 2; ++a)
#pragma unroll
            for (int b = 0; b < 2; ++b)
#pragma unroll
                for (int m = 0; m < 4; ++m)
#pragma unroll
                    for (int n = 0; n < 2; ++n) acc[a][b][m][n] = (f32x4){0.f, 0.f, 0.f, 0.f};
        }
        cur = nxt; cA = nA; cB = nB; hoC = hoN; ++ui;
        if constexpr (GATHER) { _Pragma("unroll") for (int _h = 0; _h < 2; ++_h) _Pragma("unroll") for (int _i = 0; _i < 2; ++_i) voffAc[_h][_i] = voffAn[_h][_i]; }
        if constexpr (ALIGN_EPI) { if (wr == 1) PG8_BAR; }
    }
    PG8_WAIT_V(0);
    if constexpr (!ALIGN_EPI) { if (wr == 0) PG8_BAR; }
    PG8_BAR;
#undef PG8_SA
#undef PG8_SB
#undef PG8_STAGE
#undef PG8_STAGE_A
#undef PG8_GOFF
#undef PG8_LDA
#undef PG8_LDB
#undef PG8_MMA
#undef PG8_WAIT_V
#undef PG8_WAIT_L
#undef PG8_BAR
#undef PG8_SCHED
}

__device__ __forceinline__ u32x4 pack8(const f32x4 v0, const f32x4 v1) { u32x4 w; w.x = cvtpk(v0[0], v0[1]); w.y = cvtpk(v0[2], v0[3]); w.z = cvtpk(v1[0], v1[1]); w.w = cvtpk(v1[2], v1[3]); return w; }

struct EpiInProj {
    static constexpr bool PERM = true, CARRY = false;
    bf16 *QA, *KA, *VA, *MLX, *MLO, *WQ, *WK, *WV, *GT; const f32x2* rope; float ds;
    __device__ __forceinline__ void operator()(const f32x4 (&acc)[2][2][4][2], const Unit& u, int wr, int wc, int fr, int fq) const {
        const int pn = u.pn, row0 = u.pm * BM + wr * 64 + fr, c0 = wc * 32 + 8 * fq;
        bf16* base; int W, extraB, radd0, radd1, cadd0, cadd1, mode;
        float qs = 1.f; int f8 = 0;
        if (pn < 2)       { base = QA; W = 64; extraB = 7 * SEQ; radd0 = radd1 = (4 * pn + wc) * SEQ; cadd0 = 8 * fq; cadd1 = 32 + 8 * fq; mode = 1; f8 = 1; qs = 1.4426950408889634f; }
        else if (pn < 4)  { base = KA; W = 64; extraB = 7 * SEQ; radd0 = radd1 = (4 * (pn - 2) + wc) * SEQ; cadd0 = 8 * fq; cadd1 = 32 + 8 * fq; mode = 1; f8 = 1; }
        else if (pn < 6)  { base = VA; W = 128; extraB = 3 * SEQ; radd0 = ((pn - 4) * 2) * SEQ; radd1 = ((pn - 4) * 2 + 1) * SEQ; cadd0 = cadd1 = c0; mode = 0; f8 = 2; }
        else if (pn < 8)  { base = MLX; W = 512; extraB = 0; radd0 = radd1 = 0; cadd0 = (pn - 6) * 256 + c0; cadd1 = cadd0 + 128; mode = 0; }
        else if (pn < 10) { base = MLO; W = 512; extraB = 0; radd0 = radd1 = 0; cadd0 = (pn - 8) * 256 + c0; cadd1 = cadd0 + 128; mode = 0; }
        else if (pn < 12) { base = WQ; W = 64; extraB = 7 * SEQ; radd0 = radd1 = (4 * (pn - 10) + wc) * SEQ; cadd0 = 8 * fq; cadd1 = 32 + 8 * fq; mode = 1; }
        else if (pn == 12) {
            if (wc < 2)   { base = WK; W = 64; extraB = SEQ; radd0 = radd1 = wc * SEQ; cadd0 = 8 * fq; cadd1 = 32 + 8 * fq; mode = 1; }
            else          { base = WV; W = 64; extraB = SEQ; radd0 = 0; radd1 = SEQ; cadd0 = cadd1 = (wc - 2) * 32 + 8 * fq; mode = 0; }
        }
        else              { base = GT; W = 3072; extraB = 0; radd0 = radd1 = 0; cadd0 = (pn - 13) * 256 + c0; cadd1 = cadd0 + 128; mode = 2; }
#pragma unroll
        for (int ai = 0; ai < 2; ++ai)
#pragma unroll
            for (int m = 0; m < 4; ++m) {
                const int row = row0 + ai * HALF + m * 16, b = row >> 13, s = row & (SEQ - 1);
                f32x4 l0 = acc[ai][0][m][0] * ds, l1 = acc[ai][0][m][1] * ds, h0 = acc[ai][1][m][0] * ds, h1 = acc[ai][1][m][1] * ds;
                if (mode == 1) {
                    const f32x4* rp = (const f32x4*)(rope + (size_t)s * 32 + 8 * fq);
                    const f32x4 r0 = rp[0], r1 = rp[1], r2 = rp[2], r3 = rp[3];
                    f32x4 nl0, nl1, nh0, nh1;
                    nl0[0] = l0[0] * r0[0] - h0[0] * r0[1]; nh0[0] = h0[0] * r0[0] + l0[0] * r0[1];
                    nl0[1] = l0[1] * r0[2] - h0[1] * r0[3]; nh0[1] = h0[1] * r0[2] + l0[1] * r0[3];
                    nl0[2] = l0[2] * r1[0] - h0[2] * r1[1]; nh0[2] = h0[2] * r1[0] + l0[2] * r1[1];
                    nl0[3] = l0[3] * r1[2] - h0[3] * r1[3]; nh0[3] = h0[3] * r1[2] + l0[3] * r1[3];
                    nl1[0] = l1[0] * r2[0] - h1[0] * r2[1]; nh1[0] = h1[0] * r2[0] + l1[0] * r2[1];
                    nl1[1] = l1[1] * r2[2] - h1[1] * r2[3]; nh1[1] = h1[1] * r2[2] + l1[1] * r2[3];
                    nl1[2] = l1[2] * r3[0] - h1[2] * r3[1]; nh1[2] = h1[2] * r3[0] + l1[2] * r3[1];
                    nl1[3] = l1[3] * r3[2] - h1[3] * r3[3]; nh1[3] = h1[3] * r3[2] + l1[3] * r3[3];
                    l0 = nl0 * qs; l1 = nl1 * qs; h0 = nh0 * qs; h1 = nh1 * qs;
                } else if (mode == 2) {
#pragma unroll
                    for (int j = 0; j < 4; ++j) { l0[j] = sigmoidf_(l0[j]); l1[j] = sigmoidf_(l1[j]); h0[j] = sigmoidf_(h0[j]); h1[j] = sigmoidf_(h1[j]); }
                }
                const size_t rb = (size_t)row + (size_t)b * extraB;
                if (f8 == 1) {
                    unsigned char* b8 = (unsigned char*)base;
                    *(u32x2*)(b8 + (rb + radd0) * 64 + cadd0) = (u32x2){pk4_fp8(l0[0], l0[1], l0[2], l0[3]), pk4_fp8(l1[0], l1[1], l1[2], l1[3])};
                    *(u32x2*)(b8 + (rb + radd1) * 64 + cadd1) = (u32x2){pk4_fp8(h0[0], h0[1], h0[2], h0[3]), pk4_fp8(h1[0], h1[1], h1[2], h1[3])};
                } else if (f8 == 2) {
                    const int kk = s & 63, pos = ((kk >> 2) & 1) * 32 + (kk >> 5) * 16 + (kk & 3) + 4 * ((kk & 31) >> 3);
                    unsigned char* b8 = (unsigned char*)base + (((size_t)(b * 4 + (pn - 4) * 2) * 128 + (s >> 6)) * 128 + c0) * 64 + pos;
                    const unsigned w0 = pk4_fp8(l0[0], l0[1], l0[2], l0[3]), w1 = pk4_fp8(l1[0], l1[1], l1[2], l1[3]);
                    const unsigned w2 = pk4_fp8(h0[0], h0[1], h0[2], h0[3]), w3 = pk4_fp8(h1[0], h1[1], h1[2], h1[3]);
#pragma unroll
                    for (int j = 0; j < 4; ++j) { b8[j * 64] = (unsigned char)(w0 >> (8 * j)); b8[(4 + j) * 64] = (unsigned char)(w1 >> (8 * j));
                        b8[(size_t)128 * 128 * 64 + j * 64] = (unsigned char)(w2 >> (8 * j)); b8[(size_t)128 * 128 * 64 + (4 + j) * 64] = (unsigned char)(w3 >> (8 * j)); }
                } else {
                if (u.hf != 2) *(u32x4*)(base + (rb + radd0) * W + cadd0) = pack8(l0, l1);
                if (u.hf == 0) *(u32x4*)(base + (rb + radd1) * W + cadd1) = pack8(h0, h1);
                if (u.hf == 2) *(u32x4*)(base + (rb + radd1) * W + cadd1) = pack8(l0, l1);
                }
            }
    }
};


struct EpiMerge {
    static constexpr bool PERM = true, CARRY = true;
    const bf16* GT; bf16* MB;
    __device__ __forceinline__ void operator()(f32x4 (&acc)[2][2][4][2], const Unit& u, int wr, int wc, int fr, int fq) const {
        const int row0 = u.pm * BM + wr * 64 + fr, col0 = u.pn * BM + wc * 32 + 8 * fq, br = u.br, brn = br < 2 ? br + 1 : 2;
#pragma unroll
        for (int ai = 0; ai < 2; ++ai)
#pragma unroll
            for (int mp = 0; mp < 2; ++mp) {
                u32x4 gw[2][2], gn[2][2];
#pragma unroll
                for (int mm = 0; mm < 2; ++mm)
#pragma unroll
                    for (int bj = 0; bj < 2; ++bj) { const size_t row = (size_t)(row0 + ai * HALF + (mp * 2 + mm) * 16); const int col = col0 + bj * HALF;
                        gw[mm][bj] = *(const u32x4*)(GT + row * 3072 + br * 1024 + col); gn[mm][bj] = *(const u32x4*)(GT + row * 3072 + brn * 1024 + col); }
#pragma unroll
                for (int mm = 0; mm < 2; ++mm)
#pragma unroll
                    for (int bj = 0; bj < 2; ++bj) { const size_t row = (size_t)(row0 + ai * HALF + (mp * 2 + mm) * 16); const int col = col0 + bj * HALF; const int m = mp * 2 + mm;
                        const u32x4 g = gw[mm][bj], d = gn[mm][bj];
                        float f[8] = {bflo(g.x), bfhi(g.x), bflo(g.y), bfhi(g.y), bflo(g.z), bfhi(g.z), bflo(g.w), bfhi(g.w)};
#pragma unroll
                        for (int j = 0; j < 8; ++j) f[j] = fmaxf(f[j], 1e-30f);
                        if (br < 2) { const float dd[8] = {bflo(d.x), bfhi(d.x), bflo(d.y), bfhi(d.y), bflo(d.z), bfhi(d.z), bflo(d.w), bfhi(d.w)};
#pragma unroll
                            for (int j = 0; j < 8; ++j) f[j] *= __builtin_amdgcn_rcpf(fmaxf(dd[j], 1e-30f)); }
                        f32x4 v0 = acc[ai][bj][m][0], v1 = acc[ai][bj][m][1];
                        v0[0] *= f[0]; v0[1] *= f[1]; v0[2] *= f[2]; v0[3] *= f[3]; v1[0] *= f[4]; v1[1] *= f[5]; v1[2] *= f[6]; v1[3] *= f[7];
                        if (br < 2) { acc[ai][bj][m][0] = v0; acc[ai][bj][m][1] = v1; }
                        else *(u32x4*)(MB + row * 1024 + col) = pack8(v0, v1); }
            }
    }
};

struct EpiOut {
    static constexpr bool PERM = true, CARRY = false;
    const bf16* resid; bf16* Z;
    __device__ __forceinline__ void operator()(const f32x4 (&acc)[2][2][4][2], const Unit& u, int wr, int wc, int fr, int fq) const {
        const int row0 = u.pm * BM + wr * 64 + fr, col0 = u.pn * BM + wc * 32 + 8 * fq;
#pragma unroll
        for (int ai = 0; ai < 2; ++ai) {
            u32x4 rr[4][2];
#pragma unroll
            for (int m = 0; m < 4; ++m)
#pragma unroll
                for (int bj = 0; bj < 2; ++bj) rr[m][bj] = *(const u32x4*)(resid + (size_t)(row0 + ai * HALF + m * 16) * 1024 + col0 + bj * HALF);
#pragma unroll
            for (int m = 0; m < 4; ++m)
#pragma unroll
                for (int bj = 0; bj < 2; ++bj) { const u32x4 g = rr[m][bj];
                    f32x4 v0 = acc[ai][bj][m][0], v1 = acc[ai][bj][m][1];
                    v0[0] += DN_ALPHA * bflo(g.x); v0[1] += DN_ALPHA * bfhi(g.x); v0[2] += DN_ALPHA * bflo(g.y); v0[3] += DN_ALPHA * bfhi(g.y);
                    v1[0] += DN_ALPHA * bflo(g.z); v1[1] += DN_ALPHA * bfhi(g.z); v1[2] += DN_ALPHA * bflo(g.w); v1[3] += DN_ALPHA * bfhi(g.w);
                    *(u32x4*)(Z + (size_t)(row0 + ai * HALF + m * 16) * 1024 + col0 + bj * HALF) = pack8(v0, v1); }
        }
    }
};

struct EpiSwiglu {
    static constexpr bool PERM = true, CARRY = false;
    const float* bgu  ; const int* tile_e; unsigned char* ACT8_;
    __device__ __forceinline__ void operator()(const f32x4 (&acc)[2][2][4][2], const Unit& u, int wr, int wc, int fr, int fq) const {
        const int e = __builtin_amdgcn_readfirstlane(tile_e[u.pm]);
        const int row0 = u.pm * BM + wr * 64 + fr, cl0 = u.pn * BM + wc * 32 + 8 * fq;
        constexpr float ds = 1.0f / W8_GU_SCALE;
        f32x4 bv[2][2];
#pragma unroll
        for (int bj = 0; bj < 2; ++bj) { bv[bj][0] = *(const f32x4*)(bgu + (size_t)e * 2048 + cl0 + bj * HALF); bv[bj][1] = *(const f32x4*)(bgu + (size_t)e * 2048 + cl0 + bj * HALF + 4); }
#pragma unroll
        for (int ai = 0; ai < 2; ++ai)
#pragma unroll
            for (int m = 0; m < 4; ++m) {
                const size_t row = (size_t)(row0 + ai * HALF + m * 16);
#pragma unroll
                for (int bj = 0; bj < 2; ++bj) {
                    const f32x4 v0 = acc[ai][bj][m][0] * ds + bv[bj][0], v1 = acc[ai][bj][m][1] * ds + bv[bj][1];
                    float a[4];
                    { float g = fminf(v0[0], 7.f), up = fminf(fmaxf(v0[1], -7.f), 7.f); a[0] = g * sigmoidf_(1.702f * g) * (up + 1.f); }
                    { float g = fminf(v0[2], 7.f), up = fminf(fmaxf(v0[3], -7.f), 7.f); a[1] = g * sigmoidf_(1.702f * g) * (up + 1.f); }
                    { float g = fminf(v1[0], 7.f), up = fminf(fmaxf(v1[1], -7.f), 7.f); a[2] = g * sigmoidf_(1.702f * g) * (up + 1.f); }
                    { float g = fminf(v1[2], 7.f), up = fminf(fmaxf(v1[3], -7.f), 7.f); a[3] = g * sigmoidf_(1.702f * g) * (up + 1.f); }
                    *(unsigned*)(ACT8_ + row * 1024 + ((cl0 + bj * HALF) >> 1)) = pk4_fp8(a[0], a[1], a[2], a[3]);
                }
            }
    }
};

struct EpiDown {
    static constexpr bool PERM = true, CARRY = false;
    const float* bdn  ; const int* tile_e; const float* roww; unsigned char* YS;
    __device__ __forceinline__ void operator()(const f32x4 (&acc)[2][2][4][2], const Unit& u, int wr, int wc, int fr, int fq) const {
        const int e = __builtin_amdgcn_readfirstlane(tile_e[u.pm]);
        const int row0 = u.pm * BM + wr * 64 + fr, cl0 = u.pn * BM + wc * 32 + 8 * fq + (u.hf == 2 ? HALF : 0), nbj = u.hf ? 1 : 2;
        constexpr float ds = 1.0f / W8_DN_SCALE;
        f32x4 bv[2][2];
#pragma unroll
        for (int bj = 0; bj < 2; ++bj) { bv[bj][0] = *(const f32x4*)(bdn + (size_t)e * 1024 + cl0 + bj * HALF); bv[bj][1] = *(const f32x4*)(bdn + (size_t)e * 1024 + cl0 + bj * HALF + 4); }
        float rwv[2][4];
#pragma unroll
        for (int ai = 0; ai < 2; ++ai)
#pragma unroll
            for (int m = 0; m < 4; ++m) rwv[ai][m] = roww[row0 + ai * HALF + m * 16] * YS8_SCALE;
#pragma unroll
        for (int ai = 0; ai < 2; ++ai)
#pragma unroll
            for (int m = 0; m < 4; ++m) {
                const size_t row = (size_t)(row0 + ai * HALF + m * 16);
                const float rw = rwv[ai][m];
#pragma unroll
                for (int bj = 0; bj < 2; ++bj) if (bj < nbj) {
                    const f32x4 v0 = (acc[ai][bj][m][0] * ds + bv[bj][0]) * rw, v1 = (acc[ai][bj][m][1] * ds + bv[bj][1]) * rw;
                    *(u32x2*)(YS + row * 1024 + cl0 + bj * HALF) = (u32x2){pk4_fp8(v0[0], v0[1], v0[2], v0[3]), pk4_fp8(v1[0], v1[1], v1[2], v1[3])};
                }
            }
    }
};
}

namespace att {
constexpr int QBLK = 32, KVBLK = 64;
constexpr int SHM_V = 16384, SHM_K = 8192;
constexpr int NBUF = 3, OFF_V = 0, OFF_K = NBUF * SHM_V, OFF_WS = NBUF * SHM_V + NBUF * SHM_K;
constexpr float SCALE = 0.125f, THR = 8.f;
#define KSWZ(row, colB) ((row) * 128 + ((colB) ^ (((row) & 7) << 4)))
#define SBAR() __builtin_amdgcn_sched_barrier(0)
__device__ __forceinline__ int crow(int r, int hi) { return (r & 3) + 8 * (r >> 2) + 4 * hi; }

__device__ __forceinline__ void partialSM(f32x16& p0, f32x16& p1, float& m_reg, float& mn, float& alpha) {
    constexpr float C = SCALE * 1.4426950408889634f;
    float pmax = p0[0];
#pragma unroll
    for (int r = 1; r < 16; ++r) pmax = fmaxf(pmax, p0[r]);
#pragma unroll
    for (int r = 0; r < 16; ++r) pmax = fmaxf(pmax, p1[r]);
    { auto rr = __builtin_amdgcn_permlane32_swap(__float_as_uint(pmax), __float_as_uint(pmax), false, false);
      pmax = fmaxf(__uint_as_float(rr[0]), __uint_as_float(rr[1])); }
    if (__builtin_expect(__all(pmax - m_reg <= THR / SCALE), 1)) { mn = m_reg; alpha = 1.f; }
    else { mn = fmaxf(m_reg, pmax); alpha = __builtin_amdgcn_exp2f((m_reg - mn) * C); m_reg = mn; }
    const float mnC = -mn * C;
#pragma unroll
    for (int r = 0; r < 16; ++r) p0[r] = fmaf(p0[r], C, mnC);
#pragma unroll
    for (int r = 0; r < 16; ++r) p1[r] = fmaf(p1[r], C, mnC);
#pragma unroll
    for (int r = 0; r < 16; ++r) p0[r] = __builtin_amdgcn_exp2f(p0[r]);
}
__device__ __forceinline__ void finishSM(f32x16& p0, f32x16& p1, float alpha, float& l_reg, bf16x8& pa0, bf16x8& pa1, bf16x8& pa2, bf16x8& pa3) {
#pragma unroll
    for (int r = 0; r < 16; ++r) p1[r] = __builtin_amdgcn_exp2f(p1[r]);
    float ps = 0;
#pragma unroll
    for (int r = 0; r < 16; ++r) ps += p0[r];
#pragma unroll
    for (int r = 0; r < 16; ++r) ps += p1[r];
    { auto rr = __builtin_amdgcn_permlane32_swap(__float_as_uint(ps), __float_as_uint(ps), false, false);
      ps = __uint_as_float(rr[0]) + __uint_as_float(rr[1]); }
    l_reg = l_reg * alpha + ps;
#define PK4(P, BASE, OUT) do { unsigned a0 = cvtpk(P[BASE + 0], P[BASE + 1]), a1 = cvtpk(P[BASE + 2], P[BASE + 3]);   \
    unsigned b0 = cvtpk(P[BASE + 4], P[BASE + 5]), b1 = cvtpk(P[BASE + 6], P[BASE + 7]);                              \
    auto r0 = __builtin_amdgcn_permlane32_swap(a0, b0, false, false); auto r1 = __builtin_amdgcn_permlane32_swap(a1, b1, false, false); \
    u32x4 w = {r0[0], r1[0], r0[1], r1[1]}; OUT = *reinterpret_cast<bf16x8*>(&w); } while (0)
    PK4(p0, 0, pa0); PK4(p0, 8, pa1); PK4(p1, 0, pa2); PK4(p1, 8, pa3);
#undef PK4
}
__device__ __forceinline__ void qkt(f32x16& p0, f32x16& p1, const char* Ks, const bf16x8* qr, int r32, int hi) {
    p0 = f32x16{}; p1 = f32x16{};
#pragma unroll
    for (int d0 = 0; d0 < 4; ++d0) { const int cb = (d0 * 16 + hi * 8) * 2;
        const bf16x8 b0 = *reinterpret_cast<const bf16x8*>(Ks + KSWZ(r32, cb));
        const bf16x8 b1 = *reinterpret_cast<const bf16x8*>(Ks + KSWZ(32 + r32, cb));
        p0 = __builtin_amdgcn_mfma_f32_32x32x16_bf16(b0, qr[d0], p0, 0, 0, 0);
        p1 = __builtin_amdgcn_mfma_f32_32x32x16_bf16(b1, qr[d0], p1, 0, 0, 0); }
}
__device__ __forceinline__ void qkt_n(f32x16& p0, f32x16& p1, const char* Ks, const bf16x8* qr, const f32x16& negm, int r32, int hi) {
#pragma unroll
    for (int d0 = 0; d0 < 4; ++d0) { const int cb = (d0 * 16 + hi * 8) * 2;
        const bf16x8 b0 = *reinterpret_cast<const bf16x8*>(Ks + KSWZ(r32, cb));
        const bf16x8 b1 = *reinterpret_cast<const bf16x8*>(Ks + KSWZ(32 + r32, cb));
        if (d0 == 0) { p0 = __builtin_amdgcn_mfma_f32_32x32x16_bf16(b0, qr[0], negm, 0, 0, 0); p1 = __builtin_amdgcn_mfma_f32_32x32x16_bf16(b1, qr[0], negm, 0, 0, 0); }
        else { p0 = __builtin_amdgcn_mfma_f32_32x32x16_bf16(b0, qr[d0], p0, 0, 0, 0); p1 = __builtin_amdgcn_mfma_f32_32x32x16_bf16(b1, qr[d0], p1, 0, 0, 0); } }
}
template <bool FIRST> __device__ __forceinline__ void partialSM_n(f32x16& p0, f32x16& p1, float& M, f32x16& negm, float& alpha) {
    float pmax = p0[0];
#pragma unroll
    for (int r = 1; r < 16; ++r) pmax = fmaxf(pmax, p0[r]);
#pragma unroll
    for (int r = 0; r < 16; ++r) pmax = fmaxf(pmax, p1[r]);
    { auto rr = __builtin_amdgcn_permlane32_swap(__float_as_uint(pmax), __float_as_uint(pmax), false, false);
      pmax = fmaxf(__uint_as_float(rr[0]), __uint_as_float(rr[1])); }
    if (!FIRST && __builtin_expect(__all(pmax <= THR * 1.4426950408889634f), 1)) { alpha = 1.f; }
    else { const float d = FIRST ? pmax : fmaxf(pmax, 0.f); alpha = __builtin_amdgcn_exp2f(-d); M += d;
#pragma unroll
        for (int r = 0; r < 16; ++r) { p0[r] -= d; p1[r] -= d; }
        const float nm = -M;
#pragma unroll
        for (int r = 0; r < 16; ++r) negm[r] = nm; }
#pragma unroll
    for (int r = 0; r < 16; ++r) p0[r] = __builtin_amdgcn_exp2f(p0[r]);
}
__device__ __forceinline__ int v_st(int k, int c) { const int kk = (k & ~0xC) | ((k & 4) << 1) | ((k & 8) >> 1); return ((kk >> 3) * 4 + (c >> 5)) * 512 + ((kk & 7) * 32 + (c & 31)) * 2; }
__device__ __forceinline__ int v_rd_base(int lane) { return ((lane & 3) << 3) | (((lane >> 2) & 3) << 6) | (((lane >> 4) & 1) << 5) | (((lane >> 5) & 1) << 8); }
constexpr int v_rd_off(int d0, int ks, int half) { return d0 * 512 + ks * 4096 + half * 2048; }
template <int OFF> __device__ __forceinline__ s16x4 tr_read(int vb) {
    s16x4 r; asm volatile("ds_read_b64_tr_b16 %0, %1 offset:%2" : "=&v"(r) : "v"(vb), "i"(OFF) : "memory"); return r;
}
template <int D0, int KS = 4096, int HS = 2048> __device__ __forceinline__ void pv_one(f32x16& od, int vb, bf16x8 pa0, bf16x8 pa1, bf16x8 pa2, bf16x8 pa3) {
    const s16x4 l0 = tr_read<D0 * 512 + 0 * KS>(vb), h0 = tr_read<D0 * 512 + 0 * KS + HS>(vb), l1 = tr_read<D0 * 512 + 1 * KS>(vb), h1 = tr_read<D0 * 512 + 1 * KS + HS>(vb);
    const s16x4 l2 = tr_read<D0 * 512 + 2 * KS>(vb), h2 = tr_read<D0 * 512 + 2 * KS + HS>(vb), l3 = tr_read<D0 * 512 + 3 * KS>(vb), h3 = tr_read<D0 * 512 + 3 * KS + HS>(vb);
    asm volatile("s_waitcnt lgkmcnt(0)" ::: "memory"); SBAR();
#define PK(L, H) (bf16x8){L[0], L[1], L[2], L[3], H[0], H[1], H[2], H[3]}
    od = __builtin_amdgcn_mfma_f32_32x32x16_bf16(pa0, PK(l0, h0), od, 0, 0, 0);
    od = __builtin_amdgcn_mfma_f32_32x32x16_bf16(pa1, PK(l1, h1), od, 0, 0, 0);
    od = __builtin_amdgcn_mfma_f32_32x32x16_bf16(pa2, PK(l2, h2), od, 0, 0, 0);
    od = __builtin_amdgcn_mfma_f32_32x32x16_bf16(pa3, PK(l3, h3), od, 0, 0, 0);
#undef PK
}
template <int NB> __device__ __forceinline__ void pv_all(f32x16* o, int vb, bf16x8 pa0, bf16x8 pa1, bf16x8 pa2, bf16x8 pa3) {
    pv_one<0>(o[0], vb, pa0, pa1, pa2, pa3); pv_one<1>(o[1], vb, pa0, pa1, pa2, pa3);
    if constexpr (NB == 4) { pv_one<2>(o[2], vb, pa0, pa1, pa2, pa3); pv_one<3>(o[3], vb, pa0, pa1, pa2, pa3); }
}
__device__ __forceinline__ void bandmask(f32x16& p0, f32x16& p1, int kt0, int qw0, int r32, int hi) {
    if ((kt0 + 63 - qw0 <= 128) && (qw0 + 31 - kt0 <= 128)) return;
    const int qi = qw0 + r32;
#pragma unroll
    for (int r = 0; r < 16; ++r) { const int d = kt0 + crow(r, hi) - qi;
        if (d > 128 || d < -128) p0[r] = -INFINITY;
        if (d + 32 > 128 || d + 32 < -128) p1[r] = -INFINITY; }
}

template <int NB, bool WIN>
__device__ __forceinline__ void body(const bf16* __restrict__ Qb, const bf16* __restrict__ Kh, const bf16* __restrict__ Vh, int NT,
                                     int kpos0, int qpos0, float sink_l2, f32x16 (&o)[NB], char* lds, int tid) {
    constexpr int DV = 32 * NB;
    asm volatile("" : "+v"(tid));
    const int wid = tid >> 6, lane = tid & 63, r32 = lane & 31, hi = lane >> 5;
    char* V_lds = lds + OFF_V; char* K_lds = lds + OFF_K;
    float* ws = (float*)(lds + OFF_WS) + wid * 64; float* li_l = ws; float* al_l = ws + 32;
    float m_reg = -1e30f, l_reg = 0; bf16x8 qr[4];
#pragma unroll
    for (int d = 0; d < NB; ++d) o[d] = f32x16{};
    const bf16* Qw = Qb + (long)(wid * QBLK + r32) * 64 + hi * 8;
#pragma unroll
    for (int d0 = 0; d0 < 4; ++d0) qr[d0] = *reinterpret_cast<const bf16x8*>(Qw + d0 * 16);
    const int qw0 = qpos0 + wid * QBLK;
    const int ksr = tid >> 3, ksc = (tid & 7) * 8;
    const int kst = KSWZ(ksr, ksc * 2);
    const int vsr = (NB == 4) ? (tid >> 4) : (tid >> 3), vsc = (NB == 4) ? (tid & 15) * 8 : (tid & 7) * 8;
    const int vst0 = v_st(vsr, vsc), vst1 = v_st(32 + vsr, vsc);
    const int vb0 = (int)(uintptr_t)V_lds + v_rd_base(lane);
    struct { bf16x8 vs0, vs1, ks0; } sr_[1];
    unsigned vo0 = (unsigned)(vsr * DV + vsc) * 2u, ko0 = (unsigned)(ksr * 64 + ksc) * 2u;
    asm volatile("" : "+v"(vo0), "+v"(ko0));
#define SLOAD(i, k0) do { const char* vt_ = (const char*)Vh + (size_t)(k0) * (DV * 2); const char* kt_ = (const char*)Kh + (size_t)(k0) * 128; \
    sr_[i].vs0 = *reinterpret_cast<const bf16x8*>(vt_ + vo0); \
    if constexpr (NB == 4) sr_[i].vs1 = *reinterpret_cast<const bf16x8*>(vt_ + 32 * DV * 2 + vo0); \
    sr_[i].ks0 = *reinterpret_cast<const bf16x8*>(kt_ + ko0); } while (0)
#define SWRITE(b, i) do { *(bf16x8*)(V_lds + (b) * SHM_V + vst0) = sr_[i].vs0; \
    if constexpr (NB == 4) *(bf16x8*)(V_lds + (b) * SHM_V + vst1) = sr_[i].vs1; \
    *(bf16x8*)(K_lds + (b) * SHM_K + kst) = sr_[i].ks0; } while (0)
#define SWAIT() do { if constexpr (NB == 4) asm volatile("s_waitcnt vmcnt(3)" ::: "memory"); else asm volatile("s_waitcnt vmcnt(2)" ::: "memory"); } while (0)
#define RESC(a) do { if (__any((a) < 1.f)) { if (hi == 0) al_l[r32] = (a); asm volatile("s_waitcnt lgkmcnt(0)" ::: "memory"); \
    _Pragma("unroll") for (int d = 0; d < NB; ++d) _Pragma("unroll") for (int r = 0; r < 16; ++r) o[d][r] *= al_l[crow(r, hi)]; } } while (0)
#define MASK(P0, P1, t) do { if constexpr (WIN) bandmask(P0, P1, kpos0 + (t) * KVBLK, qw0, r32, hi); } while (0)
    static_assert(!WIN, "the dense body works on pre-scaled Q in the log2 domain; the windowed path is win_unit");
    f32x16 pA0, pA1, pB0, pB1; float alA, alB; bf16x8 pa0, pa1, pa2, pa3;
    f32x16 negm = f32x16{}; m_reg = 0.f;
    constexpr int SE = 0;
    __syncthreads();
    SLOAD(SE, 0); asm volatile("s_waitcnt vmcnt(0)" ::: "memory"); SWRITE(0, SE); __syncthreads();
    qkt_n(pA0, pA1, K_lds, qr, negm, r32, hi); partialSM_n<true>(pA0, pA1, m_reg, negm, alA);
    SLOAD(SE, KVBLK); asm volatile("s_waitcnt vmcnt(0)" ::: "memory"); SWRITE(1, SE); if (2 < NT) SLOAD(SE, 2 * KVBLK);
    int bp = 0, bc = 1, bn = 2;
#define ROT3() do { const int t_ = bp; bp = bc; bc = bn; bn = t_; } while (0)
    for (int j = 1; j + 1 < NT; j += 2) {
        __syncthreads();
        SWRITE(bn, SE);
        SBAR(); qkt_n(pB0, pB1, K_lds + bc * SHM_K, qr, negm, r32, hi);
        finishSM(pA0, pA1, alA, l_reg, pa0, pa1, pa2, pa3); SBAR();
        SLOAD(SE, (j + 2) * KVBLK); SBAR();
        pv_all<NB>(o, vb0 + bp * SHM_V, pa0, pa1, pa2, pa3); partialSM_n<false>(pB0, pB1, m_reg, negm, alB);
        RESC(alB);
        ROT3();
        __syncthreads();
        SWRITE(bn, SE);
        SBAR(); qkt_n(pA0, pA1, K_lds + bc * SHM_K, qr, negm, r32, hi);
        finishSM(pB0, pB1, alB, l_reg, pa0, pa1, pa2, pa3); SBAR();
        if (j + 3 < NT) SLOAD(SE, (j + 3) * KVBLK); SBAR();
        pv_all<NB>(o, vb0 + bp * SHM_V, pa0, pa1, pa2, pa3); partialSM_n<false>(pA0, pA1, m_reg, negm, alA);
        RESC(alA);
        ROT3();
    }
    __syncthreads();
    SBAR(); qkt_n(pB0, pB1, K_lds + bc * SHM_K, qr, negm, r32, hi);
    finishSM(pA0, pA1, alA, l_reg, pa0, pa1, pa2, pa3); SBAR();
    pv_all<NB>(o, vb0 + bp * SHM_V, pa0, pa1, pa2, pa3); partialSM_n<false>(pB0, pB1, m_reg, negm, alB);
    RESC(alB);
    finishSM(pB0, pB1, alB, l_reg, pa0, pa1, pa2, pa3); SBAR();
    pv_all<NB>(o, vb0 + bc * SHM_V, pa0, pa1, pa2, pa3);
#undef ROT3
    if (hi == 0) li_l[r32] = l_reg; asm volatile("s_waitcnt lgkmcnt(0)" ::: "memory");
#pragma unroll
    for (int r = 0; r < 16; ++r) { const float rl = __builtin_amdgcn_rcpf(li_l[crow(r, hi)]);
#pragma unroll
        for (int d = 0; d < NB; ++d) o[d][r] *= rl; }
#undef SLOAD
#undef SWRITE
#undef SWAIT
#undef RESC
#undef MASK
}

constexpr int K8_TILE = 4096, V8_TILE = 8192, BUF8 = K8_TILE + V8_TILE, STG8 = 2 * BUF8, OFF8_WS = 3 * STG8;
constexpr float SH8 = 6.f, LIM8 = 8.f;
__device__ __forceinline__ int sw8(int r, int c) { return r * 64 + ((c ^ ((r >> 2) & 3)) << 4); }
typedef int i32x4a __attribute__((ext_vector_type(4))); typedef int i32x8a __attribute__((ext_vector_type(8)));
__device__ __forceinline__ i32x8a frag8(const char* tile, int row, int hi) {
    const i32x4a x = *reinterpret_cast<const i32x4a*>(tile + sw8(row, 2 * hi)), y = *reinterpret_cast<const i32x4a*>(tile + sw8(row, 2 * hi + 1));
    return (i32x8a){x[0], x[1], x[2], x[3], y[0], y[1], y[2], y[3]};
}
template <bool FIRST> __device__ __forceinline__ void partialSM8(f32x16& p0, f32x16& p1, float& R, f32x16& negm, float& alpha) {
    float pmax = p0[0];
#pragma unroll
    for (int r = 1; r < 16; ++r) pmax = fmaxf(pmax, p0[r]);
#pragma unroll
    for (int r = 0; r < 16; ++r) pmax = fmaxf(pmax, p1[r]);
    { auto rr = __builtin_amdgcn_permlane32_swap(__float_as_uint(pmax), __float_as_uint(pmax), false, false);
      pmax = fmaxf(__uint_as_float(rr[0]), __uint_as_float(rr[1])); }
    if (!FIRST && __builtin_expect(__all(pmax <= LIM8), 1)) { alpha = 1.f; }
    else { const float d = FIRST ? (pmax - SH8) : fmaxf(pmax - SH8, 0.f); alpha = __builtin_amdgcn_exp2f(-d); R += d;
#pragma unroll
        for (int r = 0; r < 16; ++r) { p0[r] -= d; p1[r] -= d; }
        const float nm = -R;
#pragma unroll
        for (int r = 0; r < 16; ++r) negm[r] = nm; }
#pragma unroll
    for (int r = 0; r < 16; ++r) p0[r] = __builtin_amdgcn_exp2f(p0[r]);
}
__device__ __forceinline__ void finishSM8(f32x16& p0, f32x16& p1, i32x8a& pa) {
#pragma unroll
    for (int r = 0; r < 16; ++r) p1[r] = __builtin_amdgcn_exp2f(p1[r]);
#pragma unroll
    for (int i = 0; i < 4; ++i) {
        int w = __builtin_amdgcn_cvt_pk_fp8_f32(p0[4 * i], p0[4 * i + 1], pa[i], false); pa[i] = __builtin_amdgcn_cvt_pk_fp8_f32(p0[4 * i + 2], p0[4 * i + 3], w, true);
        w = __builtin_amdgcn_cvt_pk_fp8_f32(p1[4 * i], p1[4 * i + 1], pa[4 + i], false); pa[4 + i] = __builtin_amdgcn_cvt_pk_fp8_f32(p1[4 * i + 2], p1[4 * i + 3], w, true); }
}
__device__ __forceinline__ float max16(const f32x16& p) {
    float m = fmaxf(p[0], p[1]);
#pragma unroll
    for (int r = 2; r < 16; r += 2) m = fmaxf(fmaxf(m, p[r]), p[r + 1]);
    return m;
}
__device__ __forceinline__ void qkt8(f32x16& p0, f32x16& p1, const char* Kt, const i32x8a& qr, const f32x16& negm, int r32, int hi) {
    const i32x8a k0 = frag8(Kt, r32, hi), k1 = frag8(Kt, 32 + r32, hi);
    const int one = 0x7F7F7F7F, eighth = 0x7C7C7C7C;
    asm volatile("v_mfma_scale_f32_32x32x64_f8f6f4 %0, %1, %2, %3, %4, %5 op_sel_hi:[0,0,0]" : "=&v"(p0) : "v"(k0), "v"(qr), "v"(negm), "v"(one), "v"(eighth));
    asm volatile("v_mfma_scale_f32_32x32x64_f8f6f4 %0, %1, %2, %3, %4, %5 op_sel_hi:[0,0,0]" : "=&v"(p1) : "v"(k1), "v"(qr), "v"(negm), "v"(one), "v"(eighth));
    asm volatile("s_nop 15\n\ts_nop 15\n\ts_nop 7" : "+v"(p0), "+v"(p1));
}
__device__ __forceinline__ void pv8(f32x16 (&o)[4], f32x16& ol, const char* Vt, const i32x8a& pa, int r32, int hi) {
    const int one = 0x7F7F7F7F;
    const int e1 = 0x38383838; const i32x8a ones = (i32x8a){e1, e1, e1, e1, e1, e1, e1, e1};
    asm volatile("s_nop 4" ::: "memory");
    asm volatile("v_mfma_scale_f32_32x32x64_f8f6f4 %0, %1, %2, %0, %3, %3 op_sel_hi:[0,0,0]" : "+v"(ol) : "v"(pa), "v"(ones), "v"(one));
#pragma unroll
    for (int d0 = 0; d0 < 4; ++d0) { const i32x8a vf = frag8(Vt, d0 * 32 + r32, hi);
        asm volatile("v_mfma_scale_f32_32x32x64_f8f6f4 %0, %1, %2, %0, %3, %3 op_sel_hi:[0,0,0]" : "+v"(o[d0]) : "v"(pa), "v"(vf), "v"(one)); }
}
struct CvtJob { const float* wgu; const float* wdn; unsigned char* wgu8; unsigned char* wdn8; int on, wg, qbase; };
constexpr int OFF8_CV = OFF8_WS + 2048, CVT_ITEMS = 48;
__device__ __forceinline__ void body8(const unsigned char* __restrict__ Q8b, const unsigned char* __restrict__ K8h, const unsigned char* __restrict__ VT8h, int NT,
                                      f32x16 (&o)[4], char* lds, int tid, const CvtJob cj) {
    asm volatile("" : "+v"(tid));
    const int wid = tid >> 6, lane = tid & 63, r32 = lane & 31, hi = lane >> 5;
    float* ws = (float*)(lds + OFF8_WS) + wid * 64; float* al_l = ws + 32;
    float R = 0.f; f32x16 negm = f32x16{}, ol = f32x16{};
#pragma unroll
    for (int d = 0; d < 4; ++d) o[d] = f32x16{};
    i32x8a qr;
    { const i32x4a x = *reinterpret_cast<const i32x4a*>(Q8b + (size_t)(wid * QBLK + r32) * 64 + hi * 32), y = *reinterpret_cast<const i32x4a*>(Q8b + (size_t)(wid * QBLK + r32) * 64 + hi * 32 + 16);
      qr = (i32x8a){x[0], x[1], x[2], x[3], y[0], y[1], y[2], y[3]}; }
    const int wid_s = __builtin_amdgcn_readfirstlane(wid);
    unsigned lsrc = (unsigned)((lane >> 2) * 64 + (((lane & 3) ^ ((lane >> 4) & 3)) << 4)); asm volatile("" : "+v"(lsrc));
#define SDMA8(b_, s_) do { _Pragma("unroll") for (int c_ = 0; c_ < 3; ++c_) { const int q_ = wid_s * 3 + c_, t_ = q_ >= 12 ? 1 : 0, r_ = q_ - 12 * t_; \
        const unsigned char* src_ = (r_ < 4) ? K8h + (size_t)(2 * (s_) + t_) * K8_TILE + r_ * 1024 : VT8h + (size_t)(2 * (s_) + t_) * V8_TILE + (r_ - 4) * 1024; \
        __builtin_amdgcn_global_load_lds((const unsigned*)(src_ + lsrc), (LAS unsigned*)(lds + (b_) * STG8 + q_ * 1024), 16, 0, 0); } } while (0)
#define SDMA_WAIT() asm volatile("s_waitcnt vmcnt(0)" ::: "memory")
#define RESC8(a) do { if (__any((a) < 1.f)) { if (hi == 0) al_l[r32] = (a); asm volatile("s_nop 15\n\ts_nop 15\n\ts_nop 15\n\ts_nop 15\n\ts_waitcnt lgkmcnt(0)" : "+v"(o[0]), "+v"(o[1]), "+v"(o[2]), "+v"(o[3]), "+v"(ol) :: "memory"); \
    _Pragma("unroll") for (int r = 0; r < 16; ++r) { const float a_ = al_l[crow(r, hi)]; ol[r] *= a_; _Pragma("unroll") for (int d = 0; d < 4; ++d) o[d][r] *= a_; } } } while (0)
    f32x16 pA0, pA1, pB0, pB1; float alA, alB; i32x8a pa = (i32x8a){0, 0, 0, 0, 0, 0, 0, 0};
    __syncthreads();
    SDMA8(0, 0); SDMA8(1, 1); SDMA_WAIT(); __syncthreads();
    qkt8(pA0, pA1, lds, qr, negm, r32, hi); partialSM8<true>(pA0, pA1, R, negm, alA);
    const int NS = NT >> 1;
    int b0 = 0, b1 = 1, b2 = 2;
#define ROT3() do { const int t_ = b0; b0 = b1; b1 = b2; b2 = t_; } while (0)
    const int mx_one = 0x7F7F7F7F, mx_eighth = 0x7C7C7C7C, e1_ = 0x38383838; const i32x8a ones = (i32x8a){e1_, e1_, e1_, e1_, e1_, e1_, e1_, e1_};
#define QKT_ASM(P, KF) asm volatile("v_mfma_scale_f32_32x32x64_f8f6f4 %0, %1, %2, %3, %4, %5 op_sel_hi:[0,0,0]" : "=&v"(P) : "v"(KF), "v"(qr), "v"(negm), "v"(mx_one), "v"(mx_eighth))
#define PV_ASM(O, VF) asm volatile("v_mfma_scale_f32_32x32x64_f8f6f4 %0, %1, %2, %0, %3, %3 op_sel_hi:[0,0,0]" : "+v"(O) : "v"(pa), "v"(VF), "v"(mx_one))
#define STEP8(PC0, PC1, PN0, PN1, ALN, KT_, VT_, LOADSTMT) do { const char* kt_ = (KT_); const char* vt_ = (VT_); \
    QKT_ASM(PN0, kf0); QKT_ASM(PN1, kf1); SBAR(); \
    LOADSTMT; \
    const i32x8a v0_ = frag8(vt_, r32, hi), v1_ = frag8(vt_, 32 + r32, hi); SBAR(); \
    finishSM8(PC0, PC1, pa); SBAR(); \
    asm volatile("s_nop 7" : "+v"(PN0), "+v"(PN1), "+v"(pa)); \
    PV_ASM(ol, ones); SBAR(); \
    const float m0_ = max16(PN0); SBAR(); \
    PV_ASM(o[0], v0_); const i32x8a v2_ = frag8(vt_, 64 + r32, hi); SBAR(); \
    const float m1_ = max16(PN1); SBAR(); \
    PV_ASM(o[1], v1_); const i32x8a v3_ = frag8(vt_, 96 + r32, hi); SBAR(); \
    float pm_ = fmaxf(m0_, m1_); \
    { auto rr_ = __builtin_amdgcn_permlane32_swap(__float_as_uint(pm_), __float_as_uint(pm_), false, false); pm_ = fmaxf(__uint_as_float(rr_[0]), __uint_as_float(rr_[1])); } SBAR(); \
    PV_ASM(o[2], v2_); SBAR(); PV_ASM(o[3], v3_); kf0 = frag8(kt_, r32, hi); kf1 = frag8(kt_, 32 + r32, hi); SBAR(); \
    if (__builtin_expect(!__all(pm_ <= LIM8), 0)) { const float d_ = fmaxf(pm_ - SH8, 0.f); ALN = __builtin_amdgcn_exp2f(-d_); R += d_; \
        _Pragma("unroll") for (int r = 0; r < 16; ++r) { PN0[r] -= d_; PN1[r] -= d_; } \
        const float nm_ = -R; _Pragma("unroll") for (int r = 0; r < 16; ++r) negm[r] = nm_; \
        RESC8(ALN); } \
    _Pragma("unroll") for (int r = 0; r < 16; ++r) PN0[r] = __builtin_amdgcn_exp2f(PN0[r]); } while (0)
    i32x8a kf0 = frag8(lds + BUF8, r32, hi), kf1 = frag8(lds + BUF8, 32 + r32, hi);
#define CVT_DECODE(t_) const int g_ = (cj.qbase + (t_)) * 2048 + cj.wg; const int e_ = g_ / 6144, r_ = g_ - e_ * 6144; const bool gu_ = r_ < 4096; const int r2_ = gu_ ? r_ : r_ - 4096; \
        const int k0_ = 128 * (gu_ ? (r2_ >> 9) : (r2_ >> 8)), n0_ = 4 * (gu_ ? (r2_ & 511) : (r2_ & 255)), NN_ = gu_ ? 2048 : 1024
    int pend = 0;
    for (int i = 0; i + 1 < NS; ++i) {
        if (pend == 3) asm volatile("s_waitcnt vmcnt(3)" ::: "memory"); else if (pend == 2) asm volatile("s_waitcnt vmcnt(2)" ::: "memory");
        else if (pend == 1) asm volatile("s_waitcnt vmcnt(1)" ::: "memory"); else SDMA_WAIT();
        __syncthreads();
        if (i + 2 < NS) SDMA8(b2, i + 2);
        asm volatile("" ::: "memory");
        pend = 0;
        if (cj.on) {
            char* ring = lds + OFF8_CV + wid_s * 6144;
            if (i >= 2 && i < CVT_ITEMS + 2) {
                CVT_DECODE(i - 2);
                unsigned char* dst_ = gu_ ? cj.wgu8 + (size_t)e_ * 2048 * DM : cj.wdn8 + (size_t)e_ * DM * DFF; const float wsc_ = gu_ ? W8_GU_SCALE : W8_DN_SCALE;
                const float* sl = (const float*)(ring + ((i - 2) % 3) * 2048);
                if (lane < 32) {
                    const float* sp_ = sl + (lane & 7) * 4 + (lane >> 3);
                    u32x4 o_;
                    o_.x = pk4_fp8(sp_[0 * 32] * wsc_, sp_[1 * 32] * wsc_, sp_[2 * 32] * wsc_, sp_[3 * 32] * wsc_); o_.y = pk4_fp8(sp_[4 * 32] * wsc_, sp_[5 * 32] * wsc_, sp_[6 * 32] * wsc_, sp_[7 * 32] * wsc_);
                    o_.z = pk4_fp8(sp_[8 * 32] * wsc_, sp_[9 * 32] * wsc_, sp_[10 * 32] * wsc_, sp_[11 * 32] * wsc_); o_.w = pk4_fp8(sp_[12 * 32] * wsc_, sp_[13 * 32] * wsc_, sp_[14 * 32] * wsc_, sp_[15 * 32] * wsc_);
                    *(u32x4*)(dst_ + (size_t)(n0_ + (lane >> 3)) * 1024 + k0_ + (lane & 7) * 16) = o_; }
                asm volatile("s_waitcnt lgkmcnt(0)" ::: "memory");
                pend += 1;
            }
            if (i < CVT_ITEMS) {
                CVT_DECODE(i);
                const float* src_ = gu_ ? cj.wgu + (size_t)e_ * DM * 2048 : cj.wdn + (size_t)e_ * DFF * DM;
                char* slot = ring + (i % 3) * 2048;
#pragma unroll
                for (int j = 0; j < 2; ++j) { const int k_ = (lane & 7) * 16 + 8 * j + (lane >> 3);
                    __builtin_amdgcn_global_load_lds((const unsigned*)(src_ + (size_t)(k0_ + k_) * NN_ + n0_), (LAS unsigned*)(slot + j * 1024), 16, 0, 0); }
                pend += 2;
            }
        }
        SBAR();
        STEP8(pA0, pA1, pB0, pB1, alB, lds + b1 * STG8, lds + b0 * STG8 + K8_TILE, (void)0);
        STEP8(pB0, pB1, pA0, pA1, alA, lds + b1 * STG8 + BUF8, lds + b0 * STG8 + BUF8 + K8_TILE, (void)0);
        ROT3();
    }
#undef STEP8
#undef QKT_ASM
#undef PV_ASM
#undef CVT_DECODE
    SBAR(); qkt8(pB0, pB1, lds + b0 * STG8 + BUF8, qr, negm, r32, hi);
    finishSM8(pA0, pA1, pa); SBAR();
    pv8(o, ol, lds + b0 * STG8 + K8_TILE, pa, r32, hi); partialSM8<false>(pB0, pB1, R, negm, alB);
    RESC8(alB);
    finishSM8(pB0, pB1, pa); SBAR();
    pv8(o, ol, lds + b0 * STG8 + BUF8 + K8_TILE, pa, r32, hi);
    asm volatile("s_nop 15\n\ts_nop 15\n\ts_nop 15\n\ts_nop 15" : "+v"(o[0]), "+v"(o[1]), "+v"(o[2]), "+v"(o[3]), "+v"(ol));
#undef ROT3
#undef SDMA8
#undef SDMA_WAIT
#undef RESC8
#pragma unroll
    for (int r = 0; r < 16; ++r) { const float rl = __builtin_amdgcn_rcpf(ol[r]);
#pragma unroll
        for (int d = 0; d < 4; ++d) o[d][r] *= rl; }
}

__device__ __forceinline__ int v_st64(int k, int c) { const int kk = (k & ~0xC) | ((k & 4) << 1) | ((k & 8) >> 1); return ((kk >> 3) * 2 + (c >> 5)) * 512 + ((kk & 7) * 32 + (c & 31)) * 2; }
constexpr int WIN_K = 0, WIN_V = 65536, WIN_WS = 131072;
#define WIN_LOAD(WKK, WVV, Kh_, Vh_, NT_, tid_) do { unsigned go_ = (unsigned)(((tid_) >> 3) * 64 + ((tid_) & 7) * 8) * 2u; asm volatile("" : "+v"(go_)); \
    _Pragma("unroll") for (int t_ = 0; t_ < 8; ++t_) { WKK[t_] = *reinterpret_cast<const bf16x8*>((const char*)(Kh_) + (size_t)t_ * 8192 + go_); \
        WVV[t_] = *reinterpret_cast<const bf16x8*>((const char*)(Vh_) + (size_t)t_ * 8192 + go_); } } while (0)
#define WIN_STAGE(WKK, WVV, NT_, lds_, tid_) do { const int ksr_ = (tid_) >> 3, ksc_ = ((tid_) & 7) * 8; const int kst_ = KSWZ(ksr_, ksc_ * 2), vst_ = att::v_st64(ksr_, ksc_); \
    __syncthreads(); \
    _Pragma("unroll") for (int t_ = 0; t_ < 8; ++t_) { *(bf16x8*)((lds_) + att::WIN_K + t_ * 8192 + kst_) = WKK[t_]; *(bf16x8*)((lds_) + att::WIN_V + t_ * 8192 + vst_) = WVV[t_]; } \
    __syncthreads(); } while (0)
__device__ __forceinline__ void win_compute(const bf16* __restrict__ Qb, int NT, int kpos0, int qpos0, float sink_l2, f32x16 (&o)[2], char* lds, int tid) {
    const int wid = tid >> 6, lane = tid & 63, r32 = lane & 31, hi = lane >> 5;
    float* ws = (float*)(lds + WIN_WS) + wid * 64; float* li_l = ws; float* al_l = ws + 32;
    bf16x8 qr[4];
    const bf16* Qw = Qb + (long)(wid * QBLK + r32) * 64 + hi * 8;
#pragma unroll
    for (int d0 = 0; d0 < 4; ++d0) qr[d0] = *reinterpret_cast<const bf16x8*>(Qw + d0 * 16);
    const int qw0 = qpos0 + wid * QBLK;
    int t_lo = (qw0 - 128 - kpos0) >> 6; if (t_lo < 0) t_lo = 0;
    int t_hi = (qw0 + 31 + 128 - kpos0) >> 6; if (t_hi > NT - 1) t_hi = NT - 1;
    float m_reg = -1e30f, l_reg = 0.f; o[0] = f32x16{}; o[1] = f32x16{};
    const int vb0 = (int)(uintptr_t)(lds + WIN_V) + v_rd_base(lane);
    for (int t = t_lo; t <= t_hi; ++t) {
        f32x16 p0, p1; float mn, al; bf16x8 pa0, pa1, pa2, pa3;
        qkt(p0, p1, lds + WIN_K + t * 8192, qr, r32, hi);
        bandmask(p0, p1, kpos0 + t * KVBLK, qw0, r32, hi);
        partialSM(p0, p1, m_reg, mn, al);
        if (__any(al < 1.f)) { if (hi == 0) al_l[r32] = al; asm volatile("s_waitcnt lgkmcnt(0)" ::: "memory");
#pragma unroll
            for (int d = 0; d < 2; ++d)
#pragma unroll
                for (int r = 0; r < 16; ++r) o[d][r] *= al_l[crow(r, hi)]; }
        finishSM(p0, p1, al, l_reg, pa0, pa1, pa2, pa3);
        const int vb = vb0 + t * 8192;
        pv_one<0, 2048, 1024>(o[0], vb, pa0, pa1, pa2, pa3); pv_one<1, 2048, 1024>(o[1], vb, pa0, pa1, pa2, pa3);
    }
    l_reg += __builtin_amdgcn_exp2f(sink_l2 - m_reg * (SCALE * 1.4426950408889634f));
    if (hi == 0) li_l[r32] = l_reg; asm volatile("s_waitcnt lgkmcnt(0)" ::: "memory");
#pragma unroll
    for (int r = 0; r < 16; ++r) { const float rl = __builtin_amdgcn_rcpf(li_l[crow(r, hi)]);
        o[0][r] *= rl; o[1][r] *= rl; }
}
}

#define XB_TMO      128
#define XB_XCNT(j)  (256  + 64 * (j))
#define XB_XSUB(j)  (1280 + 64 * (j))
#define XB_XGEN(j)  (2304 + 64 * (j))
#define XB_TOP      3328
#define XB_TOPGEN   3392
#define XCD_BAR_WORDS 3456
#define XB_SPIN_CAP (1u << 22)
__device__ __forceinline__ unsigned xb_ld(unsigned* p)              { return __hip_atomic_load(p, __ATOMIC_RELAXED, __HIP_MEMORY_SCOPE_AGENT); }
__device__ __forceinline__ unsigned xb_add(unsigned* p, unsigned v) { return __hip_atomic_fetch_add(p, v, __ATOMIC_RELAXED, __HIP_MEMORY_SCOPE_AGENT); }
__device__ __forceinline__ unsigned xb_xcc_id() { return (unsigned)__builtin_amdgcn_s_getreg((3 << 11) | 20) & 0xFu; }
#define XB_SPIN(cond, bar) do { unsigned _sp = 0; while (cond) { __builtin_amdgcn_s_sleep(1); \
    if ((++_sp & 255u) == 0u) { if (xb_ld(&(bar)[XB_TMO])) break; if (_sp > XB_SPIN_CAP) { atomicAdd(&(bar)[XB_TMO], 1u); break; } } } } while (0)
struct XcdBarrier { unsigned* bar; unsigned x; volatile LAS unsigned* st; };
__device__ __forceinline__ XcdBarrier xcd_barrier_post(unsigned* bar, volatile LAS unsigned* st) {
    XcdBarrier b; b.bar = bar; b.x = xb_xcc_id(); b.st = st;
    if (threadIdx.x == 0) (void)xb_add(&bar[XB_XCNT(b.x)], 1u);
    return b;
}
__device__ __forceinline__ void xcd_barrier_complete(unsigned* bar, unsigned x, unsigned& nloc, unsigned& nx) {
    const unsigned G = gridDim.x * gridDim.y * gridDim.z;
    unsigned sum, cnt, mine, sp = 0u;
    for (;;) {
        sum = 0u; cnt = 0u; mine = 0u;
#pragma unroll
        for (unsigned j = 0; j < 16; ++j) { const unsigned c = xb_ld(&bar[XB_XCNT(j)]); sum += c; cnt += (c > 0u) ? 1u : 0u; mine = (j == x) ? c : mine; }
        if (sum == G) break;
        __builtin_amdgcn_s_sleep(1);
        if ((++sp & 255u) == 0u) { if (xb_ld(&bar[XB_TMO])) break; if (sp > XB_SPIN_CAP) { atomicAdd(&bar[XB_TMO], 1u); break; } }
    }
    nloc = mine > 0u ? mine : 1u; nx = cnt > 0u ? cnt : 1u;
}
__device__ __forceinline__ void xcd_barrier(unsigned* bar_in, volatile LAS unsigned* st) {
    asm volatile("s_waitcnt vmcnt(0)" ::: "memory");
    __syncthreads();
    if (threadIdx.x == 0) {
        GAS unsigned* barg_ = (GAS unsigned*)bar_in; asm volatile("" : "+s"(barg_)); unsigned* bar = (unsigned*)barg_;
        const unsigned bx_ = xb_xcc_id();
        __builtin_amdgcn_s_waitcnt(0);
        unsigned nloc = st[0], nx = st[1];
        if (nloc == 0u) { xcd_barrier_complete(bar, bx_, nloc, nx); st[0] = nloc; st[1] = nx; }
        const unsigned old = xb_add(&bar[XB_XSUB(bx_)], 1u);
        const unsigned gen = old / nloc;
        if (old + 1u == (gen + 1u) * nloc) {
            __builtin_amdgcn_fence(__ATOMIC_RELEASE, "agent");
            asm volatile("s_waitcnt vmcnt(0)" ::: "memory");
            const unsigned og = xb_add(&bar[XB_TOP], 1u);
            const unsigned tg = og / nx;
            if (og + 1u == (tg + 1u) * nx) xb_add(&bar[XB_TOPGEN], 1u);
            else XB_SPIN(xb_ld(&bar[XB_TOPGEN]) == tg, bar);
            __builtin_amdgcn_fence(__ATOMIC_ACQUIRE, "agent");
            xb_add(&bar[XB_XGEN(bx_)], 1u);
            asm volatile("s_waitcnt vmcnt(0)" ::: "memory");
        } else {
            XB_SPIN(xb_ld(&bar[XB_XGEN(bx_)]) == gen, bar);
            __builtin_amdgcn_fence(__ATOMIC_ACQUIRE, "agent");
            asm volatile("s_waitcnt vmcnt(0)" ::: "memory");
        }
    }
    __syncthreads();
}

struct Args {
    const float* in[28]; float* out; unsigned char* ws;
    float lam_init[4];
    int lay_lo, lay_hi, ph_lo, ph_hi;
    int single, pad;
};
enum { I_X = 0, I_WIN, I_LAMBDA, I_SUBLN, I_WPA, I_CONVW, I_CONVB, I_MLWQ, I_MLWK, I_MLWV, I_MLWG, I_MLBG, I_MLNORM, I_MLSKIP, I_WPB, I_SINKS, I_WPC, I_WOUT,
       I_LN1G, I_LN1B, I_RW, I_RB, I_WGU, I_BGU, I_WDN, I_BDN, I_LN2G, I_LN2B };

__device__ __forceinline__ void transpose_item(const float* W, int K, int N, bf16* WT, int k0, int n0, int c0, LAS float* scr, int lane) {
#pragma unroll 8
    for (int i = 0; i < 32; ++i) { const int kk = 2 * i + (lane >> 5); scr[kk * 33 + (lane & 31)] = W[(size_t)(k0 + kk) * N + c0 + (lane & 31)]; }
    LDS_WAIT(); asm volatile("" ::: "memory");
    const int c = lane & 7;
#pragma unroll
    for (int j = 0; j < 4; ++j) { const int n = (lane >> 3) + 8 * j; const LAS float* s = scr + (8 * c) * 33 + n;
        u32x4 o; o.x = cvtpk(s[0 * 33], s[1 * 33]); o.y = cvtpk(s[2 * 33], s[3 * 33]); o.z = cvtpk(s[4 * 33], s[5 * 33]); o.w = cvtpk(s[6 * 33], s[7 * 33]);
        *(u32x4*)(WT + (size_t)(n0 + n) * K + k0 + 8 * c) = o; }
    LDS_WAIT(); asm volatile("" ::: "memory");
}
__device__ __forceinline__ int inproj_src_col32(int n0) {
    const int tile = n0 >> 8, nt = n0 & 255;
    if (tile <= 3 || tile == 10 || tile == 11) { const int half = nt >> 7, hd = (nt & 127) >> 5; return tile * 256 + hd * 64 + half * 32; }
    if (tile == 12) { const int half = nt >> 7, q = nt & 127; if (q < 64) return WA_K_COL + (q >> 5) * 64 + half * 32; return WA_V_COL + half * 64 + (q - 64); }
    return n0;
}
__device__ __forceinline__ void sincos_acc(float ang, float& sn, float& cs) {
    const double x = (double)ang;
    const double kq = rint(x * 0.63661977236758134308);
    const double r = fma(-kq, 1.57079632679489661923, x);
    const float rf = (float)r, z = rf * rf;
    const float sp = rf + rf * z * (-1.6666654611e-1f + z * (8.3321608736e-3f + z * (-1.9515295891e-4f)));
    const float cp = 1.0f - 0.5f * z + z * z * (4.166664568298827e-2f + z * (-1.388731625493765e-3f + z * 2.443315711809948e-5f));
    const int q = ((int)kq) & 3;
    sn = (q == 0) ? sp : (q == 1) ? cp : (q == 2) ? -sp : -cp;
    cs = (q == 0) ? cp : (q == 1) ? -sp : (q == 2) ? -cp : sp;
}

constexpr int LDT = 136;
constexpr int TILE_B = 128 * LDT * 2;
__device__ __forceinline__ void wave_mm(f32x4 (&acc)[8], const LAS bf16* A, const LAS bf16* Bt, int lane) {
    const int fr = lane & 15, fq = lane >> 4;
#pragma unroll
    for (int j = 0; j < 8; ++j) acc[j] = (f32x4){0.f, 0.f, 0.f, 0.f};
#pragma unroll
    for (int k0 = 0; k0 < 128; k0 += 32) {
        const bf16x8 a = *(const LAS bf16x8*)(A + fr * LDT + k0 + fq * 8);
#pragma unroll
        for (int j = 0; j < 8; ++j) { const bf16x8 b = *(const LAS bf16x8*)(Bt + (j * 16 + fr) * LDT + k0 + fq * 8);
            acc[j] = __builtin_amdgcn_mfma_f32_16x16x32_bf16(a, b, acc[j], 0, 0, 0); }
    }
}
__device__ __forceinline__ void stage_rows(LAS bf16* dst, const bf16* src, int gs, int tid) {
#pragma unroll
    for (int i = 0; i < 4; ++i) { const int q = tid + 512 * i, r = q >> 4, c = (q & 15) * 8;
        *(LAS u32x4*)(dst + r * LDT + c) = *(const u32x4*)(src + (size_t)r * gs + c); }
}
template <bool SCALED> __device__ __forceinline__ void stage_tr(LAS bf16* dst, const bf16* src, int gs, const LAS float* rscale, int tid) {
#pragma unroll
    for (int i = 0; i < 4; ++i) { const int q = tid + 512 * i, r = q & 127, c = (q >> 7) * 8;
        const u32x4 w = *(const u32x4*)(src + (size_t)r * gs + c);
        const unsigned ww[4] = {w.x, w.y, w.z, w.w};
        const float sc = SCALED ? rscale[r] : 1.f;
#pragma unroll
        for (int j = 0; j < 4; ++j) {
            if (SCALED) { dst[(c + 2 * j) * LDT + r] = tobf1(bflo(ww[j]) * sc); dst[(c + 2 * j + 1) * LDT + r] = tobf1(bfhi(ww[j]) * sc); }
            else { dst[(c + 2 * j) * LDT + r] = (bf16)(ww[j] & 0xffffu); dst[(c + 2 * j + 1) * LDT + r] = (bf16)(ww[j] >> 16); } }
    }
}
__device__ __forceinline__ float logsigmoidf_(float x) { return fminf(x, 0.f) - log1pf(__expf(-fabsf(x))); }
template <bool WITH_MAX> __device__ __forceinline__ void scan_dir(const LAS float* ls, const LAS float* ig, LAS float* bcum, LAS float* pmx, int dir, int lane) {
    const int n0 = dir ? 127 - 2 * lane : 2 * lane, n1 = dir ? 126 - 2 * lane : 2 * lane + 1;
    const float x0 = ls[n0], x1 = ls[n1], s = x0 + x1; float inc = s;
#pragma unroll
    for (int off = 1; off < 64; off <<= 1) { const float t = shup(inc, off, lane); if (lane >= off) inc += t; }
    const float ex = inc - s, b0 = ex + x0, b1 = b0 + x1;
    bcum[n0] = b0; bcum[n1] = b1;
    if (WITH_MAX) {
        const float d0 = ig[n0] - b0, d1 = ig[n1] - b1; float minc = fmaxf(d0, d1);
#pragma unroll
        for (int off = 1; off < 64; off <<= 1) { const float t = shup(minc, off, lane); if (lane >= off) minc = fmaxf(minc, t); }
        float mex = shup(minc, 1, lane); if (lane == 0) mex = -INFINITY;
        pmx[n0] = fmaxf(mex, d0); pmx[n1] = fmaxf(fmaxf(mex, d0), d1);
    }
}

enum { PH_INPROJ = 1, PH_MLQKV, PH_MLGATES, PH_MLLOC, PH_MLSCAN, PH_MLOUT, PH_DIFF, PH_WIN, PH_MERGE, PH_OUT, PH_LN1, PH_SORT, PH_GU, PH_DOWN, PH_LN2, PH_END };

__global__ void __launch_bounds__(NTHR, 2) mega(Args args) {
    extern __shared__ __attribute__((aligned(16))) unsigned char lds_raw[];
    LAS unsigned char* lds = (LAS unsigned char*)lds_raw;
    volatile LAS unsigned* CTLW = (volatile LAS unsigned*)(lds + PH_LDS);
    const int tid0 = threadIdx.x;
    const int wave_s = __builtin_amdgcn_readfirstlane(tid0 >> 6);
    const int G = gridDim.x, bx = blockIdx.x;
#define PH_LOCALS unsigned lz_ = 0u; asm volatile("" : "+v"(lz_)); int tid = wave_s * 64 + (int)__builtin_amdgcn_mbcnt_hi(~0u, __builtin_amdgcn_mbcnt_lo(~0u, lz_)); asm volatile("" : "+v"(tid)); GAS unsigned char* wsg_ = (GAS unsigned char*)args.ws; asm volatile("" : "+s"(wsg_)); unsigned char* ws = (unsigned char*)wsg_; const int lane = tid & 63; const int wave = __builtin_amdgcn_readfirstlane(tid >> 6); \
    const int gw = vcu * NWAVES + wave, NGW = G * NWAVES, gt = vcu * NTHR + tid, NGT = G * NTHR; (void)lane; (void)gw; (void)NGW; (void)gt; (void)NGT;
    const int vcu = (bx % 8) * (G / 8) + bx / 8;
    for (int u = tid0; u < 64; u += NTHR) CTLW[u] = 0u;
    __syncthreads();
    if (args.single) (void)xcd_barrier_post((unsigned*)(args.ws + OFF_CTL) + 4096, CTLW + 8);
#define SEAM() do { if (args.single) xcd_barrier((unsigned*)(args.ws + OFF_CTL) + 4096, CTLW + 8); } while (0)

#define WIN_T ((bf16*)((bf16*)(ws + OFF_WIN)))
#define WP_T ((bf16*)((bf16*)(ws + OFF_WP)))
#define WOUT_T ((bf16*)((bf16*)(ws + OFF_WOUT)))
#define WGU_T ((bf16*)((bf16*)(ws + OFF_WGU)))
#define WDN_T ((bf16*)((bf16*)(ws + OFF_WDN)))
#define WML_T ((bf16*)((bf16*)(ws + OFF_WML)))
#define ROPE ((f32x2*)((f32x2*)(ws + OFF_ROPE)))
#define XB ((bf16*)((bf16*)(ws + OFF_XB)))
#define XF ((float*)((float*)(ws + OFF_XF)))
#define ZB ((bf16*)(ws + OFF_ZB))
#define X1 ((float*)(ws + OFF_X1))
#define QA ((bf16*)((bf16*)(ws + OFF_QA)))
#define KA ((bf16*)((bf16*)(ws + OFF_KA)))
#define VA ((bf16*)((bf16*)(ws + OFF_VA)))
#define MLX ((bf16*)((bf16*)(ws + OFF_MLX)))
#define MLO ((bf16*)((bf16*)(ws + OFF_MLO)))
#define XC ((bf16*)((bf16*)(ws + OFF_XC)))
#define WQb ((bf16*)((bf16*)(ws + OFF_WQ)))
#define WKb ((bf16*)((bf16*)(ws + OFF_WK)))
#define WVb ((bf16*)((bf16*)(ws + OFF_WV)))
#define GT ((bf16*)((bf16*)(ws + OFF_GT)))
#define YA ((bf16*)((bf16*)(ws + OFF_Y3)))
#define YB ((bf16*)(YA + (size_t)TOK * 512))
#define YC ((bf16*)(YB + (size_t)TOK * 512))
#define MF ((float*)((float*)(ws + OFF_MF)))
#define MB ((bf16*)((bf16*)(ws + OFF_MB)))
#define MQ ((bf16*)((bf16*)(ws + OFF_MQ)))
#define MK ((bf16*)(MQ + (size_t)TOK * 512))
#define MV ((bf16*)(MK + (size_t)TOK * 512))
#define G4 ((float*)((float*)(ws + OFF_G4)))
#define GATE4(k_) ((GP[((((size_t)0 * 4 + (k_)) * BATCH + b) * 4 + h) * SEQ + s0 + gt_] + GP[((((size_t)1 * 4 + (k_)) * BATCH + b) * 4 + h) * SEQ + s0 + gt_]) + (GP[((((size_t)2 * 4 + (k_)) * BATCH + b) * 4 + h) * SEQ + s0 + gt_] + GP[((((size_t)3 * 4 + (k_)) * BATCH + b) * 4 + h) * SEQ + s0 + gt_]))
#define GP ((float*)(ws + OFF_WGU + 320 * MiB))
#define CLOC ((bf16*)(ws + OFF_CLOC))
#define CPT ((bf16*)((bf16*)(ws + OFF_CPT)))
#define NLOC ((float*)((float*)(ws + OFF_NLOC)))
#define NPREV ((float*)((float*)(ws + OFF_NPREV)))
#define MLOC ((float*)((float*)(ws + OFF_MLOC)))
#define GCH ((float*)((float*)(ws + OFF_GCH)))
#define MPREV ((float*)((float*)(ws + OFF_MPREV)))
#define STASH ((float*)((float*)(ws + OFF_STASH)))
#define BLKCNT ((int*)((int*)(ws + OFF_BLKCNT)))
#define TILEE ((int*)((int*)(ws + OFF_TILEE)))
#define ROWW ((float*)((float*)(ws + OFF_ROWW)))
#define TOKE ((int*)((int*)(ws + OFF_TOKE)))
#define TOKW ((float*)((float*)(ws + OFF_TOKW)))
#define TOKLP ((int*)((int*)(ws + OFF_TOKLP)))
#define TOKROW ((int*)((int*)(ws + OFF_TOKROW)))
#define XG ((bf16*)((bf16*)(ws + OFF_XG)))
#define ROWTOK ((int*)(ws + OFF_ROWTOK))
#define XB8 ((unsigned char*)(ws + OFF_XB8))
#define WGU8 ((unsigned char*)(ws + OFF_WGU))
#define WIN8 ((unsigned char*)(ws + OFF_WGU + 256 * MiB))
#define XB8I ((unsigned char*)(ws + OFF_WGU + 288 * MiB))
#define WDN8 ((unsigned char*)(ws + OFF_WDN))
#define ACT8 ((unsigned char*)(ws + OFF_ACT))
#define ACT ((bf16*)((bf16*)(ws + OFF_ACT)))
#define YS ((bf16*)((bf16*)(ws + OFF_YS)))
    for (int rep_ = 0, nrep_ = (((PHASE_MASK & 1ull) && args.lay_lo < 0) ? (int)(1 + (REPEAT_MASK & 1ull)) : 0); rep_ < nrep_; ++rep_) {
        PH_LOCALS
        LAS float* scr = (LAS float*)(lds + wave * 16896);
        constexpr int I_IN = 8 * 200, I_P = 4 * 32, I_O = 8 * 32, I_GU = 8 * 64, I_DN = 8 * 32, I_ML = 1 * 4;
        constexpr int N0 = DEPTH * I_IN, N1 = N0 + 3 * DEPTH * I_P, N2 = N1 + DEPTH * I_O, N3 = N2, N4 = N3,     N5 = N4 + 3 * 16 * I_ML;
#define TR_DECODE(it_, SRC, NN, DST, KK, K0, N0_, C0, WSC) do { const int it__ = (it_); WSC = 0.f; \
            if (it__ < N0) { const int l_ = it__ / I_IN, r_ = it__ % I_IN, kb = r_ / 200, nb = r_ % 200; \
                SRC = args.in[I_WIN] + (size_t)l_ * DM * DIN; NN = DIN; DST = WIN_T + (size_t)l_ * DIN * DM; KK = DM; K0 = 128 * kb; N0_ = 32 * nb; C0 = inproj_src_col32(32 * nb); \
                { DST = (bf16*)(WIN8 + (size_t)l_ * 6400 * DM); WSC = W8_IN_SCALE; } } \
            else if (it__ < N1) { const int q = it__ - N0, br = q / (DEPTH * I_P), r2 = q % (DEPTH * I_P), l_ = r2 / I_P, r_ = r2 % I_P, kb = r_ / 32, nb = r_ % 32; \
                SRC = (br == 0 ? args.in[I_WPA] : br == 1 ? args.in[I_WPB] : args.in[I_WPC]) + (size_t)l_ * 512 * DM; NN = DM; DST = WP_T + ((size_t)l_ * 3 + br) * DM * 512; KK = 512; K0 = 128 * kb; N0_ = 32 * nb; C0 = 32 * nb; } \
            else if (it__ < N2) { const int q = it__ - N1, l_ = q / I_O, r_ = q % I_O, kb = r_ / 32, nb = r_ % 32; \
                SRC = args.in[I_WOUT] + (size_t)l_ * DM * DM; NN = DM; DST = WOUT_T + (size_t)l_ * DM * DM; KK = DM; K0 = 128 * kb; N0_ = 32 * nb; C0 = 32 * nb; } \
            else if (it__ < N4) { const int q0_ = it__ - N2; constexpr int PER_L = NEXP * (I_GU + I_DN); const int ql = q0_ % PER_L, l_ = 0;     \
                if (ql < NEXP * I_GU) { const int mt = l_ * NEXP + ql / I_GU, r_ = ql % I_GU, kb = r_ / 64, nb = r_ % 64; \
                    SRC = args.in[I_WGU] + (size_t)mt * DM * 2048; NN = 2048; DST = (bf16*)(WGU8 + (size_t)mt * 2048 * DM); KK = DM; K0 = 128 * kb; N0_ = 32 * nb; C0 = 32 * nb; WSC = W8_GU_SCALE; } \
                else { const int q = ql - NEXP * I_GU, mt = l_ * NEXP + q / I_DN, r_ = q % I_DN, kb = r_ / 32, nb = r_ % 32; \
                    SRC = args.in[I_WDN] + (size_t)mt * DFF * DM; NN = DM; DST = (bf16*)(WDN8 + (size_t)mt * DM * DFF); KK = DFF; K0 = 128 * kb; N0_ = 32 * nb; C0 = 32 * nb; WSC = W8_DN_SCALE; } } \
            else { const int q = it__ - N4, which = q / (16 * I_ML), r2 = q % (16 * I_ML), lh = r2 / I_ML, r_ = r2 % I_ML, kb = r_ / 4, nb = r_ % 4; \
                SRC = (which == 0 ? args.in[I_MLWQ] : which == 1 ? args.in[I_MLWK] : args.in[I_MLWV]) + (size_t)lh * 128 * 128; NN = 128; \
                DST = WML_T + (((size_t)(lh >> 2) * 3 + which) * 4 + (lh & 3)) * 128 * 128; KK = 128; K0 = 128 * kb; N0_ = 32 * nb; C0 = 32 * nb; } } while (0)
        {
#define TR_LOAD(dstv, SRC, NN_, K0, C0) do { const float* sp_ = (SRC) + (size_t)((K0) + (lane >> 3)) * (NN_) + (C0) + (lane & 7) * 4; \
                _Pragma("unroll") for (int i = 0; i < 16; ++i) dstv[i] = *(const f32x4*)(sp_ + (size_t)(8 * i) * (NN_)); } while (0)
#define TR_PROC(v, dst, KK, k0, n0, wsc) do { \
                _Pragma("unroll") for (int i = 0; i < 16; ++i) _Pragma("unroll") for (int e = 0; e < 4; ++e) scr[(8 * i + (lane >> 3)) * 33 + (lane & 7) * 4 + e] = v[i][e]; \
                LDS_WAIT(); asm volatile("" ::: "memory"); \
                if (wsc == 0.f) { const int c = lane & 15;                         \
                  _Pragma("unroll") for (int j = 0; j < 8; ++j) { const int n = (lane >> 4) + 4 * j; const LAS float* sp = scr + (8 * c) * 33 + n; \
                      u32x4 o; o.x = cvtpk(sp[0 * 33], sp[1 * 33]); o.y = cvtpk(sp[2 * 33], sp[3 * 33]); o.z = cvtpk(sp[4 * 33], sp[5 * 33]); o.w = cvtpk(sp[6 * 33], sp[7 * 33]); \
                      *(u32x4*)(dst + (size_t)(n0 + n) * KK + k0 + 8 * c) = o; } } \
                else {                                                             \
                  _Pragma("unroll") for (int j = 0; j < 4; ++j) { const int q = lane + 64 * j, n = q >> 3, part = q & 7; const LAS float* sp = scr + (part * 16) * 33 + n; \
                      u32x4 o; \
                      o.x = pk4_fp8(sp[0 * 33] * wsc, sp[1 * 33] * wsc, sp[2 * 33] * wsc, sp[3 * 33] * wsc); o.y = pk4_fp8(sp[4 * 33] * wsc, sp[5 * 33] * wsc, sp[6 * 33] * wsc, sp[7 * 33] * wsc); \
                      o.z = pk4_fp8(sp[8 * 33] * wsc, sp[9 * 33] * wsc, sp[10 * 33] * wsc, sp[11 * 33] * wsc); o.w = pk4_fp8(sp[12 * 33] * wsc, sp[13 * 33] * wsc, sp[14 * 33] * wsc, sp[15 * 33] * wsc); \
                      *(u32x4*)((unsigned char*)dst + (size_t)(n0 + n) * KK + k0 + part * 16) = o; } } \
                LDS_WAIT(); asm volatile("" ::: "memory"); } while (0)
#define TR_STATE(S) const float* src##S = nullptr; bf16* dst##S = nullptr; int NN##S = 0, KK##S = 0, k0##S = 0, n0##S = 0, c0##S = 0; float wsc##S = 0.f; f32x4 v##S[16]
#define TR_FETCH(S, it_) do { if ((it_) < N5) { TR_DECODE((it_), src##S, NN##S, dst##S, KK##S, k0##S, n0##S, c0##S, wsc##S); TR_LOAD(v##S, src##S, NN##S, k0##S, c0##S); } } while (0)
            TR_STATE(A); TR_STATE(B);
            TR_FETCH(A, gw); TR_FETCH(B, gw + NGW);
#pragma unroll 1
            for (int it = gw; it < N5; it += 2 * NGW) {
                TR_PROC(vA, dstA, KKA, k0A, n0A, wscA); TR_FETCH(A, it + 2 * NGW);
                if (it + NGW < N5) { TR_PROC(vB, dstB, KKB, k0B, n0B, wscB); TR_FETCH(B, it + 3 * NGW); }
            }
#undef TR_PROC
#undef TR_STATE
#undef TR_FETCH
#undef TR_LOAD
        }
#undef TR_DECODE
        for (size_t i = gt; i < (size_t)TOK * DM / 8; i += NGT) {
            const f32x4 a = *(const f32x4*)(args.in[I_X] + i * 8), b = *(const f32x4*)(args.in[I_X] + i * 8 + 4);
            *(u32x4*)(XB + i * 8) = pg8::pack8(a, b);
            *(u32x2*)(XB8I + i * 8) = (u32x2){pk4_fp8(a[0], a[1], a[2], a[3]), pk4_fp8(b[0], b[1], b[2], b[3])};
        }
        for (int p = gw; p < DEPTH * NEXP; p += NGW) {
            const int l = p >> 5, e = p & 31;
            const float* rw = args.in[I_RW] + (size_t)l * DM * NEXP; const float* g1 = args.in[I_LN1G] + (size_t)l * DM; const float* b1 = args.in[I_LN1B] + (size_t)l * DM;
            bf16* wh = (bf16*)(ws + OFF_RWGH) + (size_t)p * DM; bf16* wl = (bf16*)(ws + OFF_RWGL) + (size_t)p * DM;
            float cg = 0.f, cb = 0.f;
            for (int k = lane; k < DM; k += 64) { const float w = rw[(size_t)k * NEXP + e], wg = g1[k] * w; const bf16 h = tobf1(wg);
                wh[k] = h; wl[k] = tobf1(wg - bf1(h)); cg += wg; cb += b1[k] * w; }
            cg = wave_sum(cg, lane); cb = wave_sum(cb, lane);
            if (lane == 0) { float* cgcb = (float*)(ws + OFF_CGCB) + (size_t)l * 64; cgcb[e] = cg; cgcb[32 + e] = cb + args.in[I_RB][(size_t)l * NEXP + e]; }
        }
        for (int i = gt; i < DEPTH * 16 * 1536; i += NGT) { const int l = i / (16 * 1536), r = i % (16 * 1536), g = r / 1536, k = r % 1536;
            ((bf16*)(ws + OFF_WGT))[i] = tobf1(args.in[I_MLWG][((size_t)l * 1536 + k) * 16 + g]); }
        for (int i = gt; i < SEQ * 32; i += NGT) {
            const int s = i >> 5, j = i & 31;
            const float inv = exp2f(-(float)(2 * j) * (13.287712379549449f / 64.0f));
            const float ang = (float)s * inv; float sn, cs; sincos_acc(ang, sn, cs);
            ROPE[i] = (f32x2){cs, sn};
        }
        SEAM();
    }

    for (int l = (args.lay_lo < 0 ? 0 : args.lay_lo); l < args.lay_hi; ++l) {
        const int plo = args.ph_lo, phi = args.ph_hi;
#define IN(k) (((PHASE_MASK >> (k)) & 1ull) && plo <= (k) && (k) < phi)
#define PHASE(k) for (int rep_ = 0, nrep_ = (IN(k) ? (int)(1 + ((REPEAT_MASK >> (k)) & 1ull)) : 0); rep_ < nrep_; ++rep_)
        PHASE(PH_INPROJ) {
            PH_LOCALS
            {   pg8::Gemm g{(const bf16*)XB8I, (const bf16*)(WIN8 + (size_t)l * 6400 * DM), DM / 2, DM / 2, DM / 2, 0, nullptr};
                pg8::InprojOrder S{2, bx};
                pg8::EpiInProj E{QA, KA, VA, MLX, MLO, WQb, WKb, WVb, GT, ROPE, 1.0f / W8_IN_SCALE};
                pg8::gemm_phase<pg8::EpiInProj, true, false, true, pg8::InprojOrder>(lds, g, S, E, tid); }
            SEAM();
        }
        PHASE(PH_MLQKV) {
            PH_LOCALS
            LAS bf16* BA1 = (LAS bf16*)lds; LAS bf16* BA2 = (LAS bf16*)(lds + TILE_B); LAS bf16* BW0 = (LAS bf16*)(lds + 2 * TILE_B); LAS bf16* BW1 = (LAS bf16*)(lds + 3 * TILE_B);
            const float* cw = args.in[I_CONVW] + (size_t)l * 5 * 512; const float* cb = args.in[I_CONVB] + (size_t)l * 512;
            for (int u = vcu; u < 512; u += G) {
                const int tt = u >> 2, h = u & 3; const size_t t0 = (size_t)tt * 128;
                const int b = (int)(t0 >> 13), s0 = (int)(t0 & (SEQ - 1));
                const int c8 = (tid & 15) * 8, ch = h * 128 + c8;
                __syncthreads();
                {   f32x4 cwv[5][2]; f32x4 cbv[2];
#pragma unroll
                    for (int k = 0; k < 5; ++k) { cwv[k][0] = *(const f32x4*)(cw + k * 512 + ch); cwv[k][1] = *(const f32x4*)(cw + k * 512 + ch + 4); }
                    cbv[0] = *(const f32x4*)(cb + ch); cbv[1] = *(const f32x4*)(cb + ch + 4);
                    u32x4 xra[4][5];
#pragma unroll
                    for (int i = 0; i < 4; ++i) { const int r = (tid >> 4) + 32 * i, s = s0 + r;
#pragma unroll
                        for (int k = 0; k < 5; ++k) { const int ss = s + k - 2; xra[i][k] = (ss >= 0 && ss < SEQ) ? *(const u32x4*)(MLX + (t0 + r + k - 2) * 512 + ch) : (u32x4){0u, 0u, 0u, 0u}; } }
                    const bf16* wbase = WML_T + (((size_t)l * 3) * 4 + h) * 128 * 128;
                    u32x4 w0r[4], w1r[4], w2r[4];
#pragma unroll
                    for (int i = 0; i < 4; ++i) { const int r = (tid >> 4) + 32 * i; w0r[i] = *(const u32x4*)(wbase + (size_t)r * 128 + c8);
                        w1r[i] = *(const u32x4*)(wbase + (size_t)4 * 128 * 128 + (size_t)r * 128 + c8); w2r[i] = *(const u32x4*)(wbase + (size_t)8 * 128 * 128 + (size_t)r * 128 + c8); }
#pragma unroll
                    for (int i = 0; i < 4; ++i) {
                        const int r = (tid >> 4) + 32 * i;
                        u32x4 xr[5];
#pragma unroll
                        for (int k = 0; k < 5; ++k) xr[k] = xra[i][k];
                        float a[8] = {cbv[0][0], cbv[0][1], cbv[0][2], cbv[0][3], cbv[1][0], cbv[1][1], cbv[1][2], cbv[1][3]};
#pragma unroll
                        for (int k = 0; k < 5; ++k) { const u32x4 w = xr[k];
                            a[0] += bflo(w.x) * cwv[k][0][0]; a[1] += bfhi(w.x) * cwv[k][0][1]; a[2] += bflo(w.y) * cwv[k][0][2]; a[3] += bfhi(w.y) * cwv[k][0][3];
                            a[4] += bflo(w.z) * cwv[k][1][0]; a[5] += bfhi(w.z) * cwv[k][1][1]; a[6] += bflo(w.w) * cwv[k][1][2]; a[7] += bfhi(w.w) * cwv[k][1][3]; }
#pragma unroll
                        for (int j = 0; j < 8; ++j) a[j] = a[j] * sigmoidf_(a[j]);
                        u32x4 o; o.x = cvtpk(a[0], a[1]); o.y = cvtpk(a[2], a[3]); o.z = cvtpk(a[4], a[5]); o.w = cvtpk(a[6], a[7]);
                        *(LAS u32x4*)(BA1 + r * LDT + c8) = o; *(LAS u32x4*)(BA2 + r * LDT + c8) = xr[2];
                        *(LAS u32x4*)(BW0 + r * LDT + c8) = w0r[i]; *(LAS u32x4*)(BW1 + r * LDT + c8) = w1r[i];
                        *(u32x4*)(XC + (t0 + r) * 512 + ch) = o;
                    }
                    __syncthreads();
                    const bf16* wgt = (const bf16*)(ws + OFF_WGT) + (size_t)l * 16 * 1536;
                    LAS bf16* OTs = (LAS bf16*)(lds + 4 * TILE_B) + wave * 512;
                    f32x4 accg = (f32x4){0.f, 0.f, 0.f, 0.f};
#pragma unroll
                    for (int which = 0; which < 3; ++which) {
                        if (which == 2) { __syncthreads();
#pragma unroll
                            for (int i = 0; i < 4; ++i) { const int r = (tid >> 4) + 32 * i; *(LAS u32x4*)(BW0 + r * LDT + c8) = w2r[i]; }
                            __syncthreads(); }
                        const int fr = lane & 15, fq = lane >> 4;
                        bf16x8 wg[4];
#pragma unroll
                        for (int c = 0; c < 4; ++c) wg[c] = *(const bf16x8*)(wgt + (size_t)fr * 1536 + (which * 4 + h) * 128 + c * 32 + 8 * fq);
                        f32x4 acc[8];
                        wave_mm(acc, (which == 2 ? BA2 : BA1) + wave * 16 * LDT, which == 1 ? BW1 : BW0, lane);
                        bf16* dst = (which == 0 ? MQ : which == 1 ? MK : MV) + ((size_t)(b * 4 + h) * SEQ + s0) * 128;
#pragma unroll
                        for (int j = 0; j < 8; ++j)
#pragma unroll
                            for (int r = 0; r < 4; ++r) dst[(size_t)(wave * 16 + 4 * fq + r) * 128 + j * 16 + fr] = tobf1(acc[j][r]);
#pragma unroll
                        for (int c = 0; c < 4; ++c) {
#pragma unroll
                            for (int jj = 0; jj < 2; ++jj)
#pragma unroll
                                for (int r = 0; r < 4; ++r) OTs[(4 * fq + r) * 32 + jj * 16 + fr] = tobf1(acc[2 * c + jj][r]);
                            LDS_WAIT(); asm volatile("" ::: "memory");
                            const bf16x8 av = *(const LAS bf16x8*)(OTs + fr * 32 + fq * 8);
                            accg = __builtin_amdgcn_mfma_f32_16x16x32_bf16(av, wg[c], accg, 0, 0, 0);
                            LDS_WAIT(); asm volatile("" ::: "memory");
                        }
                    }
                    {   int fr = lane & 15; asm volatile("" : "+v"(fr));
                        const int fq = lane >> 4, ty = fr >> 2, hh = fr & 3; const float bias = (h == 0) ? args.in[I_MLBG][(size_t)l * 16 + fr] : 0.f;
#pragma unroll
                        for (int r = 0; r < 4; ++r) GP[((((size_t)h * 4 + ty) * BATCH + b) * 4 + hh) * SEQ + s0 + wave * 16 + 4 * fq + r] = accg[r] + bias; }
                }
            }
            SEAM();
        }
        PHASE(PH_MLLOC) {
            PH_LOCALS
            LAS bf16* BA = (LAS bf16*)lds; LAS bf16* BBf = (LAS bf16*)(lds + TILE_B); LAS bf16* BBb = (LAS bf16*)(lds + 2 * TILE_B);
            LAS float* sm = (LAS float*)(lds + 3 * TILE_B);
            LAS float* sLSf = sm, *sLSb = sm + 128, *sIGf = sm + 256, *sIGb = sm + 384, *sBf = sm + 512, *sBb = sm + 640, *sEf = sm + 768, *sEb = sm + 896, *sNP = sm + 1024;
            for (int u = vcu; u < 512; u += G) {
                asm volatile("" : "+v"(tid));
                const int lane = tid & 63, wave = __builtin_amdgcn_readfirstlane(tid >> 6);
                const int b = u >> 8, h = (u >> 6) & 3, c = u & 63; const int s0 = c * 128;
                const int seqf = (0 * 2 + b) * 4 + h, seqb = (1 * 2 + b) * 4 + h;
                const size_t rb = ((size_t)(b * 4 + h) * SEQ + s0) * 128;
                u32x4 kr[4], vr[4];
#pragma unroll
                for (int i = 0; i < 4; ++i) { const int r = tid & 127, c8 = ((tid >> 7) + 4 * i) * 8; kr[i] = *(const u32x4*)(MK + rb + (size_t)r * 128 + c8); vr[i] = *(const u32x4*)(MV + rb + (size_t)r * 128 + c8); }
                const int gt_ = tid & 127;
                const float g0_ = GATE4(0), g1_ = GATE4(1);
                const float g2_ = GATE4(2), g3_ = GATE4(3);
                __syncthreads();
                if (tid < 128) { sIGf[tid] = g0_; sLSf[tid] = logsigmoidf_(g1_); sIGb[tid] = g2_; sLSb[tid] = logsigmoidf_(g3_); }
                __syncthreads();
                if (wave == 0) scan_dir<false>(sLSf, sIGf, sBf, nullptr, 0, lane);
                if (wave == 1) scan_dir<false>(sLSb, sIGb, sBb, nullptr, 1, lane);
                __syncthreads();
                const float gtf = sBf[127], gtb = sBb[0];
                const float wf0 = gtf - sBf[lane] + sIGf[lane], wf1 = gtf - sBf[lane + 64] + sIGf[lane + 64];
                const float wb0 = gtb - sBb[lane] + sIGb[lane], wb1 = gtb - sBb[lane + 64] + sIGb[lane + 64];
                const float mlf = wave_max(fmaxf(wf0, wf1), lane), mlb = wave_max(fmaxf(wb0, wb1), lane);
                if (wave == 0) { sEf[lane] = __expf(wf0 - mlf) * 0.08838834764831845f; sEf[lane + 64] = __expf(wf1 - mlf) * 0.08838834764831845f; }
                if (wave == 1) { sEb[lane] = __expf(wb0 - mlb) * 0.08838834764831845f; sEb[lane + 64] = __expf(wb1 - mlb) * 0.08838834764831845f; }
                __syncthreads();
#pragma unroll
                for (int i = 0; i < 4; ++i) { const int r = tid & 127, c8 = ((tid >> 7) + 4 * i) * 8; const float ef = sEf[r], eb = sEb[r];
                    const unsigned kw[4] = {kr[i].x, kr[i].y, kr[i].z, kr[i].w}, vw[4] = {vr[i].x, vr[i].y, vr[i].z, vr[i].w};
#pragma unroll
                    for (int j = 0; j < 4; ++j) {
                        BA[(c8 + 2 * j) * LDT + r] = (bf16)(vw[j] & 0xffffu); BA[(c8 + 2 * j + 1) * LDT + r] = (bf16)(vw[j] >> 16);
                        const float k0 = bflo(kw[j]), k1 = bfhi(kw[j]);
                        BBf[(c8 + 2 * j) * LDT + r] = tobf1(k0 * ef); BBf[(c8 + 2 * j + 1) * LDT + r] = tobf1(k1 * ef);
                        BBb[(c8 + 2 * j) * LDT + r] = tobf1(k0 * eb); BBb[(c8 + 2 * j + 1) * LDT + r] = tobf1(k1 * eb); } }
                __syncthreads();
                const int fr = lane & 15, fq = lane >> 4;
#pragma unroll
                for (int dir = 0; dir < 2; ++dir) {
                    f32x4 acc[8];
                    wave_mm(acc, BA + wave * 16 * LDT, dir ? BBb : BBf, lane);
                    bf16* dst = CLOC + ((size_t)(dir ? seqb : seqf) * 64 + c) * 16384;
#pragma unroll
                    for (int j = 0; j < 8; ++j)
#pragma unroll
                        for (int r = 0; r < 4; ++r) dst[(wave * 16 + 4 * fq + r) * 128 + j * 16 + fr] = tobf1(acc[j][r]);
                    const int kd = tid & 127, part = tid >> 7; float sacc = 0.f;
#pragma unroll
                    for (int q = 0; q < 4; ++q) { const u32x4 w = *(const LAS u32x4*)((dir ? BBb : BBf) + kd * LDT + part * 32 + q * 8);
                        sacc += (bflo(w.x) + bfhi(w.x)) + (bflo(w.y) + bfhi(w.y)) + (bflo(w.z) + bfhi(w.z)) + (bflo(w.w) + bfhi(w.w)); }
                    sNP[dir * 512 + part * 128 + kd] = sacc;
                }
                __syncthreads();
                if (tid < 256) { const int dir = tid >> 7, kd = tid & 127; const LAS float* p = sNP + dir * 512;
                    NLOC[((size_t)(dir ? seqb : seqf) * 64 + c) * 128 + kd] = (p[kd] + p[128 + kd]) + (p[256 + kd] + p[384 + kd]); }
                if (tid == 0) { MLOC[seqf * 64 + c] = mlf; GCH[seqf * 64 + c] = gtf; MLOC[seqb * 64 + c] = mlb; GCH[seqb * 64 + c] = gtb; }
            }
            SEAM();
        }
        PHASE(PH_MLSCAN) {
            PH_LOCALS
            LAS float* sG = (LAS float*)lds; LAS float* sM = sG + 64; LAS float* sA = sG + 128; LAS float* sBl = sG + 192; LAS float* sMp = sG + 256;
            const int seq = vcu >> 4, dir = seq >> 3;
            __syncthreads();
            if (tid < 64) { sG[tid] = GCH[seq * 64 + tid]; sM[tid] = MLOC[seq * 64 + tid]; }
            __syncthreads();
            if (tid == 0) { float m = 0.f;
                for (int cc = 0; cc < 64; ++cc) { const int c = dir ? 63 - cc : cc; const float gc = sG[c], ml = sM[c];
                    const float mn = fmaxf(gc + m, ml); sA[cc] = __expf(gc + m - mn); sBl[cc] = __expf(ml - mn); sMp[cc] = m; m = mn; } }
            __syncthreads();
            {
                const int e2 = ((vcu & 15) * NTHR + tid) * 2;
                f32x2 C = {0.f, 0.f};
                for (int half = 0; half < 2; ++half) {
                    unsigned cl[32];
#pragma unroll
                    for (int i = 0; i < 32; ++i) { const int cc = half * 32 + i, c = dir ? 63 - cc : cc; cl[i] = *(const unsigned*)(CLOC + ((size_t)seq * 64 + c) * 16384 + e2); }
#pragma unroll
                    for (int i = 0; i < 32; ++i) { const int cc = half * 32 + i, c = dir ? 63 - cc : cc;
                        *(unsigned*)(CPT + ((size_t)seq * 64 + c) * 16384 + e2) = cvtpk(C[0], C[1]);
                        C = C * sA[cc] + (f32x2){bflo(cl[i]), bfhi(cl[i])} * sBl[cc]; }
                }
            }
            if ((vcu & 15) == 0) {
                if (tid < 64) { const int c = dir ? 63 - tid : tid; MPREV[seq * 64 + c] = sMp[tid]; }
                if (tid < 128) { float n = 0.f;
                    for (int half = 0; half < 2; ++half) { float nl[32];
#pragma unroll
                        for (int i = 0; i < 32; ++i) { const int cc = half * 32 + i, c = dir ? 63 - cc : cc; nl[i] = NLOC[((size_t)seq * 64 + c) * 128 + tid]; }
#pragma unroll
                        for (int i = 0; i < 32; ++i) { const int cc = half * 32 + i, c = dir ? 63 - cc : cc;
                            NPREV[((size_t)seq * 64 + c) * 128 + tid] = n; n = n * sA[cc] + nl[i] * sBl[cc]; } } }
            }
            SEAM();
        }
        PHASE(PH_MLOUT) {
            PH_LOCALS
            LAS bf16* BQ = (LAS bf16*)lds; LAS bf16* BK = (LAS bf16*)(lds + TILE_B); LAS bf16* BV = (LAS bf16*)(lds + 2 * TILE_B); LAS bf16* BC = (LAS bf16*)(lds + 3 * TILE_B);
            LAS float* sm = (LAS float*)(lds + 4 * TILE_B);
            LAS float* sLSf = sm, *sLSb = sm + 128, *sIf = sm + 256, *sIb = sm + 384, *sBf = sm + 512, *sBb = sm + 640, *sPf = sm + 768, *sPb = sm + 896;
            LAS float* sNf = sm + 1024, *sNb = sm + 1152, *sQNf = sm + 1280, *sQNb = sm + 1408;
            const float* normw = args.in[I_MLNORM] + (size_t)l * 512; const float* skipw = args.in[I_MLSKIP] + (size_t)l * 512;
            for (int u = vcu; u < 512; u += G) {
                asm volatile("" : "+v"(tid));
                const int lane = tid & 63, wave = __builtin_amdgcn_readfirstlane(tid >> 6);
                const int b = u >> 8, h = (u >> 6) & 3, c = u & 63; const int s0 = c * 128;
                const int seqf = (0 * 2 + b) * 4 + h, seqb = (1 * 2 + b) * 4 + h;
                const size_t rb = ((size_t)(b * 4 + h) * SEQ + s0) * 128;
                const int gt_ = tid & 127;
                const float g0_ = GATE4(0), g1_ = GATE4(1);
                const float g2_ = GATE4(2), g3_ = GATE4(3);
                const float np0_ = NPREV[((size_t)seqf * 64 + c) * 128 + gt_], np1_ = NPREV[((size_t)seqb * 64 + c) * 128 + gt_];
                __syncthreads();
                stage_rows(BQ, MQ + rb, 128, tid); stage_rows(BK, MK + rb, 128, tid); stage_tr<false>(BV, MV + rb, 128, nullptr, tid);
                stage_rows(BC, CPT + ((size_t)seqf * 64 + c) * 16384, 128, tid);
                if (tid < 128) { sIf[tid] = g0_; sLSf[tid] = logsigmoidf_(g1_); sIb[tid] = g2_; sLSb[tid] = logsigmoidf_(g3_); sNf[tid] = np0_; sNb[tid] = np1_; }
                __syncthreads();
                if (wave == 0) scan_dir<true>(sLSf, sIf, sBf, sPf, 0, lane);
                if (wave == 1) scan_dir<true>(sLSb, sIb, sBb, sPb, 1, lane);
                {
                    const int t = tid >> 2, part = tid & 3; float af = 0.f, ab = 0.f;
                    for (int k = 0; k < 32; ++k) { const float q = bf1(BQ[t * LDT + part * 32 + k]); af += q * sNf[part * 32 + k]; ab += q * sNb[part * 32 + k]; }
                    af += shx(af, 1, lane); af += shx(af, 2, lane); ab += shx(ab, 1, lane); ab += shx(ab, 2, lane);
                    if (part == 0) { sQNf[t] = af; sQNb[t] = ab; }
                }
                __syncthreads();
                const float mpf = MPREV[seqf * 64 + c], mpb = MPREV[seqb * 64 + c];
                const int fr = lane & 15, fq = lane >> 4;
                u32x4 cbr[4];
#pragma unroll
                for (int i = 0; i < 4; ++i) { const int q = tid + 512 * i; cbr[i] = *(const u32x4*)(CPT + ((size_t)seqb * 64 + c) * 16384 + (size_t)(q >> 4) * 128 + (q & 15) * 8); }
                f32x4 accS[8];
                wave_mm(accS, BQ + wave * 16 * LDT, BK, lane);
                float rowBf[4], rowBb[4], mtf[4], mtb[4], inf_[4], inb_[4], rsf[4], rsb[4];
#pragma unroll
                for (int r = 0; r < 4; ++r) { const int t = wave * 16 + 4 * fq + r;
                    rowBf[r] = sBf[t]; rowBb[r] = sBb[t];
                    mtf[r] = rowBf[r] + fmaxf(mpf, sPf[t]); mtb[r] = rowBb[r] + fmaxf(mpb, sPb[t]);
                    inf_[r] = __expf(rowBf[r] + mpf - mtf[r]); inb_[r] = __expf(rowBb[r] + mpb - mtb[r]);
                    rsf[r] = 0.f; rsb[r] = 0.f; }
#pragma unroll
                for (int j = 0; j < 8; ++j) { const int s = j * 16 + fr; const float cf = sIf[s] - sBf[s], cb = sIb[s] - sBb[s];
#pragma unroll
                    for (int r = 0; r < 4; ++r) { const int t = wave * 16 + 4 * fq + r; const float sv = accS[j][r];
                        rsf[r] += (s <= t) ? __expf(rowBf[r] + cf - mtf[r]) * sv : 0.f;
                        rsb[r] += (s >= t) ? __expf(rowBb[r] + cb - mtb[r]) * sv : 0.f; } }
                float scf[4], scb[4], cif[4], cib[4];
#pragma unroll
                for (int r = 0; r < 4; ++r) { const int t = wave * 16 + 4 * fq + r;
                    float a = rsf[r] * 0.08838834764831845f, bq = rsb[r] * 0.08838834764831845f;
                    a += shx(a, 1, lane); a += shx(a, 2, lane); a += shx(a, 4, lane); a += shx(a, 8, lane);
                    bq += shx(bq, 1, lane); bq += shx(bq, 2, lane); bq += shx(bq, 4, lane); bq += shx(bq, 8, lane);
                    const float denf = inf_[r] * sQNf[t] + a, denb = inb_[r] * sQNb[t] + bq;
                    scf[r] = 1.0f / fmaxf(fabsf(denf), __expf(-mtf[r])); scb[r] = 1.0f / fmaxf(fabsf(denb), __expf(-mtb[r]));
                    cif[r] = scf[r] * inf_[r]; cib[r] = scb[r] * inb_[r];
                    scf[r] *= 0.08838834764831845f; scb[r] *= 0.08838834764831845f; }
                __syncthreads();
#pragma unroll
                for (int j = 0; j < 8; ++j) { const int s = j * 16 + fr; const float cf = sIf[s] - sBf[s], cb = sIb[s] - sBb[s];
#pragma unroll
                    for (int r = 0; r < 4; ++r) { const int t = wave * 16 + 4 * fq + r; const float sv = accS[j][r];
                        const float a = (s <= t) ? __expf(rowBf[r] + cf - mtf[r]) * scf[r] : 0.f;
                        const float bq = (s >= t) ? __expf(rowBb[r] + cb - mtb[r]) * scb[r] : 0.f;
                        BK[t * LDT + s] = tobf1((a + bq) * sv); } }
                __syncthreads();
                f32x4 hacc[8];
                wave_mm(hacc, BK + wave * 16 * LDT, BV, lane);
                f32x4 xacc[8];
                wave_mm(xacc, BQ + wave * 16 * LDT, BC, lane);
#pragma unroll
                for (int j = 0; j < 8; ++j)
#pragma unroll
                    for (int r = 0; r < 4; ++r) hacc[j][r] += cif[r] * xacc[j][r];
                __syncthreads();
#pragma unroll
                for (int i = 0; i < 4; ++i) { const int q = tid + 512 * i; *(LAS u32x4*)(BV + (q >> 4) * LDT + (q & 15) * 8) = cbr[i]; }
                __syncthreads();
                wave_mm(xacc, BQ + wave * 16 * LDT, BV, lane);
#pragma unroll
                for (int j = 0; j < 8; ++j)
#pragma unroll
                    for (int r = 0; r < 4; ++r) hacc[j][r] += cib[r] * xacc[j][r];
#pragma unroll
                for (int r = 0; r < 4; ++r) {
                    float sacc = 0.f;
#pragma unroll
                    for (int j = 0; j < 8; ++j) sacc += hacc[j][r];
                    sacc += shx(sacc, 1, lane); sacc += shx(sacc, 2, lane); sacc += shx(sacc, 4, lane); sacc += shx(sacc, 8, lane);
                    const float mu = sacc * (1.f / 128.f); float q = 0.f;
#pragma unroll
                    for (int j = 0; j < 8; ++j) { const float d = hacc[j][r] - mu; q += d * d; }
                    q += shx(q, 1, lane); q += shx(q, 2, lane); q += shx(q, 4, lane); q += shx(q, 8, lane);
                    const float rstd = 1.0f / sqrtf(q * (1.f / 128.f) + LN_EPS);
#pragma unroll
                    for (int j = 0; j < 8; ++j) hacc[j][r] = (hacc[j][r] - mu) * rstd;
                }
                __syncthreads();
                {   LAS float* HN = (LAS float*)lds;
#pragma unroll
                    for (int j = 0; j < 8; ++j)
#pragma unroll
                        for (int r = 0; r < 4; ++r) HN[(wave * 16 + 4 * fq + r) * 132 + j * 16 + fr] = hacc[j][r];
                    __syncthreads();
                    const int t = tid >> 2, cq = (tid & 3) * 32; const size_t tokrow = (size_t)b * SEQ + s0 + t; const int col0 = h * 128 + cq;
                    u32x4 xcv[4], mov[4];
#pragma unroll
                    for (int i = 0; i < 4; ++i) { xcv[i] = *(const u32x4*)(XC + tokrow * 512 + col0 + i * 8); mov[i] = *(const u32x4*)(MLO + tokrow * 512 + col0 + i * 8); }
#pragma unroll
                    for (int i = 0; i < 4; ++i) {
                        const f32x4 h0 = *(const LAS f32x4*)(HN + t * 132 + cq + i * 8), h1 = *(const LAS f32x4*)(HN + t * 132 + cq + i * 8 + 4);
                        const f32x4 n0 = *(const f32x4*)(normw + col0 + i * 8), n1 = *(const f32x4*)(normw + col0 + i * 8 + 4);
                        const f32x4 k0 = *(const f32x4*)(skipw + col0 + i * 8), k1 = *(const f32x4*)(skipw + col0 + i * 8 + 4);
                        const unsigned xw[4] = {xcv[i].x, xcv[i].y, xcv[i].z, xcv[i].w}, mw[4] = {mov[i].x, mov[i].y, mov[i].z, mov[i].w};
                        float o[8];
#pragma unroll
                        for (int j = 0; j < 4; ++j) {
                            const float ha = (j < 2 ? h0[2 * j] : h1[2 * j - 4]), hb = (j < 2 ? h0[2 * j + 1] : h1[2 * j - 3]);
                            const float na = (j < 2 ? n0[2 * j] : n1[2 * j - 4]), nb = (j < 2 ? n0[2 * j + 1] : n1[2 * j - 3]);
                            const float ka = (j < 2 ? k0[2 * j] : k1[2 * j - 4]), kb = (j < 2 ? k0[2 * j + 1] : k1[2 * j - 3]);
                            o[2 * j] = sigmoidf_(bflo(mw[j])) * (ha * na + ka * bflo(xw[j]));
                            o[2 * j + 1] = sigmoidf_(bfhi(mw[j])) * (hb * nb + kb * bfhi(xw[j])); }
                        u32x4 ow; ow.x = cvtpk(o[0], o[1]); ow.y = cvtpk(o[2], o[3]); ow.z = cvtpk(o[4], o[5]); ow.w = cvtpk(o[6], o[7]);
                        *(u32x4*)(YB + tokrow * 512 + col0 + i * 8) = ow;
                    }
                }
            }
            __syncthreads();
        }
        PHASE(PH_DIFF) {
            PH_LOCALS
            const float* lp = args.in[I_LAMBDA] + (size_t)l * 256;
            const float s1 = wave_sum(lp[lane] * lp[64 + lane], lane), s2 = wave_sum(lp[128 + lane] * lp[192 + lane], lane);
            const float lam_init = args.lam_init[l], lam = __expf(s1) - __expf(s2) + lam_init;
            const float* subln = args.in[I_SUBLN] + (size_t)l * 128;
            for (int u = vcu; u < 256; u += G) {
                const int b = u >> 7, h = (u >> 5) & 3, qb = u & 31;
                f32x16 o[4];
                const unsigned char* q8 = (const unsigned char*)QA; const unsigned char* k8 = (const unsigned char*)KA; const unsigned char* v8 = (const unsigned char*)VA + (size_t)(b * 4 + h) * SEQ * 128;
                att::CvtJob cj; cj.on = 1; const int ln_ = l;
                cj.wgu = args.in[I_WGU] + (size_t)ln_ * NEXP * DM * 2048; cj.wdn = args.in[I_WDN] + (size_t)ln_ * NEXP * DFF * DM;
                cj.wgu8 = WGU8 + (size_t)ln_ * NEXP * 2048 * DM; cj.wdn8 = WDN8 + (size_t)ln_ * NEXP * DM * DFF; cj.wg = bx * 8 + wave; cj.qbase = 0;
                {   const size_t hb = ((size_t)(b * 8 + h * 2 + 0) * SEQ) * 64;
                    att::body8(q8 + hb + (size_t)qb * 256 * 64, k8 + hb, v8, SEQ / 64, o, (char*)lds_raw, tid, cj); }
                {   int t2 = tid; asm volatile("" : "+v"(t2));
                    GAS float* st = (GAS float*)(STASH + (size_t)bx * (16 * 512 * 4) + (size_t)t2 * 4);
#pragma unroll
                for (int d = 0; d < 4; ++d)
#pragma unroll
                    for (int q4 = 0; q4 < 4; ++q4) *(GAS f32x4*)(st + (size_t)(d * 4 + q4) * 2048) = (f32x4){o[d][q4 * 4], o[d][q4 * 4 + 1], o[d][q4 * 4 + 2], o[d][q4 * 4 + 3]}; }
                {   const size_t hb = ((size_t)(b * 8 + h * 2 + 1) * SEQ) * 64; cj.qbase = att::CVT_ITEMS;
                    att::body8(q8 + hb + (size_t)qb * 256 * 64, k8 + hb, v8, SEQ / 64, o, (char*)lds_raw, tid, cj); }
                float ss[16];
#pragma unroll
                for (int r = 0; r < 16; ++r) ss[r] = 0.f;
                int t3 = tid; asm volatile("" : "+v"(t3));
                const int r32 = t3 & 31, hi = (t3 >> 5) & 1;
                GAS float* st = (GAS float*)(STASH + (size_t)bx * (16 * 512 * 4) + (size_t)t3 * 4);
#pragma unroll
                for (int d = 0; d < 4; ++d)
#pragma unroll
                    for (int q4 = 0; q4 < 4; ++q4) { const f32x4 v = *(const GAS f32x4*)(st + (size_t)(d * 4 + q4) * 2048);
#pragma unroll
                        for (int k = 0; k < 4; ++k) { const float x = v[k] - lam * o[d][q4 * 4 + k]; o[d][q4 * 4 + k] = x; ss[q4 * 4 + k] += x * x; } }
#pragma unroll
                for (int r = 0; r < 16; ++r) { float v = ss[r]; v += shx(v, 1, lane); v += shx(v, 2, lane); v += shx(v, 4, lane); v += shx(v, 8, lane); v += shx(v, 16, lane);
                    ss[r] = (1.0f / sqrtf(v * (1.f / 128.f) + LN_EPS)) * (1.f - lam_init); }
                GAS bf16* yo = (GAS bf16*)(YA + ((size_t)b * SEQ + qb * 256 + wave * 32 + 4 * hi) * 512 + h * 128 + r32);
                asm volatile("" : "+v"(yo));
#pragma unroll
                for (int d = 0; d < 4; ++d) { const float gsc = subln[d * 32 + r32];
#pragma unroll
                    for (int r = 0; r < 16; ++r) yo[((r & 3) + 8 * (r >> 2)) * 512 + d * 32] = tobf1(o[d][r] * ss[r] * gsc); }
            }
            __syncthreads();
        }
        PHASE(PH_WIN) {
            PH_LOCALS
            const float* sinks = args.in[I_SINKS] + (size_t)l * 8;
            bf16x8 wkk[8], wvv[8];
            int vcu_l = vcu; asm volatile("" : "+s"(vcu_l));
#define WIN_DECODE(u_, b_, qh_, q0_, klo_, NT_) const int b_ = (u_) >> 8, qh_ = ((u_) >> 5) & 7, q0_ = ((u_) & 31) * 256; \
                const int klo_ = (q0_ - 128 < 0) ? 0 : q0_ - 128; const int NT_ = (((q0_ + 384 > SEQ) ? SEQ : q0_ + 384) - klo_) / 64
            {   WIN_DECODE(vcu_l * 2, b0_, qh0_, q00_, klo0_, NT0_);
                WIN_LOAD(wkk, wvv, WKb + ((size_t)(b0_ * 2 + (qh0_ >> 2)) * SEQ + klo0_) * 64, WVb + ((size_t)(b0_ * 2 + (qh0_ >> 2)) * SEQ + klo0_) * 64, NT0_, tid); }
#pragma unroll
            for (int i = 0; i < 2; ++i) {
                const int u = vcu_l * 2 + i;
                WIN_DECODE(u, b, qh, q0, klo, NT);
                WIN_STAGE(wkk, wvv, NT, (char*)lds_raw, tid);
                if (i == 0) { WIN_DECODE(u + 1, b1_, qh1_, q01_, klo1_, NT1_);
                    WIN_LOAD(wkk, wvv, WKb + ((size_t)(b1_ * 2 + (qh1_ >> 2)) * SEQ + klo1_) * 64, WVb + ((size_t)(b1_ * 2 + (qh1_ >> 2)) * SEQ + klo1_) * 64, NT1_, tid); }
                f32x16 o[2];
                att::win_compute(WQb + ((size_t)(b * 8 + qh) * SEQ + q0) * 64, NT, klo, q0, sinks[qh] * 1.4426950408889634f, o, (char*)lds_raw, tid);
                const int r32 = tid & 31, hi = (tid >> 5) & 1;
                GAS bf16* yo = (GAS bf16*)(YC + ((size_t)b * SEQ + q0 + wave * 32 + 4 * hi) * 512 + qh * 64 + r32);
                asm volatile("" : "+v"(yo));
#pragma unroll
                for (int d = 0; d < 2; ++d)
#pragma unroll
                    for (int r = 0; r < 16; ++r) yo[((r & 3) + 8 * (r >> 2)) * 512 + d * 32] = tobf1(o[d][r]);
            }
#undef WIN_DECODE
            SEAM();
        }
        PHASE(PH_MERGE) {
            PH_LOCALS
            pg8::Gemm g{YA, WP_T + (size_t)l * 3 * DM * 512, 512, 512, 512, (size_t)TOK * 512 * 2, nullptr};
            pg8::StaticOrder S; S.init(TOK / 256, DM / 256, G, bx, nullptr, 3);
            pg8::EpiMerge E{GT, MB};
            pg8::gemm_phase<pg8::EpiMerge, true>(lds, g, S, E, tid);
            SEAM();
        }
        PHASE(PH_OUT) {
            PH_LOCALS
            pg8::Gemm g{MB, WOUT_T + (size_t)l * DM * DM, DM, DM, DM, 0, nullptr};
            pg8::StaticOrder S; S.init(TOK / 256, DM / 256, G, bx, nullptr);
            pg8::EpiOut E{XB, ZB};
            pg8::gemm_phase<pg8::EpiOut, true>(lds, g, S, E, tid);
            SEAM();
        }
        PHASE(PH_LN1) {
            PH_LOCALS
            LAS float* PART = (LAS float*)lds;
            LAS float* RAW = (LAS float*)(lds + 8 * 32 * 33 * 4);
            LAS float* LG = (LAS float*)(lds + 8 * 32 * 33 * 4 + 64 * 33 * 4) + wave * (8 * 33);
            LAS int* LCNT = (LAS int*)(lds + 8 * 32 * 33 * 4 + 64 * 33 * 4 + 8 * 8 * 33 * 4);
            const float* g1 = args.in[I_LN1G] + (size_t)l * DM; const float* b1 = args.in[I_LN1B] + (size_t)l * DM;
            const float* cgcb = (const float*)(ws + OFF_CGCB) + (size_t)l * 64;
            const int tok0 = bx * (TOK / GRID);
            u32x2 zall[8][4];
#pragma unroll
            for (int q = 0; q < 8; ++q)
#pragma unroll
                for (int j = 0; j < 4; ++j) zall[q][j] = *(const u32x2*)(ZB + (size_t)(tok0 + wave * 8 + q) * DM + 4 * lane + 256 * j);
            __syncthreads();
            if (tid < 32) LCNT[tid] = 0;
            {
                const int tg = wave & 1, kq = wave >> 1, r32 = lane & 31, hi = lane >> 5;
                const bf16* zr = ZB + (size_t)(tok0 + tg * 32 + r32) * DM + kq * 256 + hi * 8;
                const bf16* whp = (const bf16*)(ws + OFF_RWGH) + ((size_t)l * NEXP + r32) * DM + kq * 256 + hi * 8;
                const bf16* wlp = (const bf16*)(ws + OFF_RWGL) + ((size_t)l * NEXP + r32) * DM + kq * 256 + hi * 8;
                f32x16 acc = f32x16{};
#pragma unroll 8
                for (int ks = 0; ks < 16; ++ks) {
                    const bf16x8 a_h = *(const bf16x8*)(zr + ks * 16);
                    const bf16x8 bh = *(const bf16x8*)(whp + ks * 16), bl = *(const bf16x8*)(wlp + ks * 16);
                    acc = __builtin_amdgcn_mfma_f32_32x32x16_bf16(a_h, bh, acc, 0, 0, 0);
                    acc = __builtin_amdgcn_mfma_f32_32x32x16_bf16(a_h, bl, acc, 0, 0, 0);
                }
#pragma unroll
                for (int r = 0; r < 16; ++r) PART[(wave * 32 + ((r & 3) + 8 * (r >> 2) + 4 * hi)) * 33 + r32] = acc[r];
            }
            __syncthreads();
            for (int i = tid; i < 64 * 32; i += NTHR) { const int t = i >> 5, e = i & 31, tg = t >> 5, tr = t & 31;
                RAW[t * 33 + e] = (PART[((0 * 2 + tg) * 32 + tr) * 33 + e] + PART[((1 * 2 + tg) * 32 + tr) * 33 + e]) + (PART[((2 * 2 + tg) * 32 + tr) * 33 + e] + PART[((3 * 2 + tg) * 32 + tr) * 33 + e]); }
            __syncthreads();
            f32x4 gv[4], bv[4];
#pragma unroll
            for (int j = 0; j < 4; ++j) { gv[j] = *(const f32x4*)(g1 + 4 * lane + 256 * j); bv[j] = *(const f32x4*)(b1 + 4 * lane + 256 * j); }
            const float cge = cgcb[lane & 31], cbe = cgcb[32 + (lane & 31)];
#pragma unroll
            for (int i0 = 0; i0 < 8; i0 += 2) {
                f32x4 v[2][4];
#pragma unroll
                for (int q = 0; q < 2; ++q)
#pragma unroll
                    for (int j = 0; j < 4; ++j) { const u32x2 w = zall[i0 + q][j]; v[q][j] = (f32x4){bflo(w.x), bfhi(w.x), bflo(w.y), bfhi(w.y)}; }
#pragma unroll
                for (int q = 0; q < 2; ++q) {
                    const int tl = wave * 8 + i0 + q, t = tok0 + tl;
                    float s = 0.f;
#pragma unroll
                    for (int j = 0; j < 4; ++j) s += (v[q][j][0] + v[q][j][1]) + (v[q][j][2] + v[q][j][3]);
                    const float mean = wave_sum(s, lane) * (1.f / DM); float s2 = 0.f;
#pragma unroll
                    for (int j = 0; j < 4; ++j) { v[q][j] = v[q][j] - mean; s2 += (v[q][j][0] * v[q][j][0] + v[q][j][1] * v[q][j][1]) + (v[q][j][2] * v[q][j][2] + v[q][j][3] * v[q][j][3]); }
                    const float rstd = 1.f / sqrtf(wave_sum(s2, lane) * (1.f / DM) + LN_EPS);
#pragma unroll
                    for (int j = 0; j < 4; ++j) { const f32x4 o = v[q][j] * rstd * gv[j] + bv[j];
                        u32x2 w; w.x = cvtpk(o[0], o[1]); w.y = cvtpk(o[2], o[3]);
                        *(u32x2*)(XB + (size_t)t * DM + 4 * lane + 256 * j) = w;
                        *(unsigned*)(XB8 + (size_t)t * DM + 4 * lane + 256 * j) = pk4_fp8(o[0], o[1], o[2], o[3]); }
                    if (lane < 32) LG[(i0 + q) * 33 + lane] = rstd * (RAW[tl * 33 + lane] - mean * cge) + cbe;
                }
            }
            LDS_WAIT(); asm volatile("" ::: "memory");
            if (lane < 8) {
                const int t = tok0 + wave * 8 + lane;
                float v0 = -INFINITY, v1 = -INFINITY, v2 = -INFINITY, v3 = -INFINITY; int e0 = 0, e1 = 0, e2 = 0, e3 = 0;
#pragma unroll 4
                for (int e = 0; e < 32; ++e) { const float x = LG[lane * 33 + e];
                    if (x > v0) { v3 = v2; e3 = e2; v2 = v1; e2 = e1; v1 = v0; e1 = e0; v0 = x; e0 = e; }
                    else if (x > v1) { v3 = v2; e3 = e2; v2 = v1; e2 = e1; v1 = x; e1 = e; }
                    else if (x > v2) { v3 = v2; e3 = e2; v2 = x; e2 = e; }
                    else if (x > v3) { v3 = x; e3 = e; } }
                const float p1 = __expf(v1 - v0), p2 = __expf(v2 - v0), p3 = __expf(v3 - v0), inv = 1.f / (1.f + p1 + p2 + p3);
                const int l0 = atomicAdd((int*)&LCNT[e0], 1), l1 = atomicAdd((int*)&LCNT[e1], 1), l2 = atomicAdd((int*)&LCNT[e2], 1), l3 = atomicAdd((int*)&LCNT[e3], 1);
                *(int4*)(TOKE + t * 4) = make_int4(e0, e1, e2, e3);
                *(float4*)(TOKW + t * 4) = make_float4(inv, p1 * inv, p2 * inv, p3 * inv);
                *(int4*)(TOKLP + t * 4) = make_int4(l0, l1, l2, l3);
            }
            __syncthreads();
            if (tid < 32) BLKCNT[bx * 32 + tid] = LCNT[tid];
            SEAM();
        }
        PHASE(PH_SORT) {
            PH_LOCALS
            LAS int* sTot = (LAS int*)lds; LAS int* sBase = sTot + 32; LAS int* sOff = sTot + 64; LAS int* sRow = sTot + 128;
            LAS int* sPT = sTot + 512; LAS int* sPB = sTot + 1024;
            __syncthreads();
            {   const int e = tid & 31, part = tid >> 5; int tot = 0, base = 0;
#pragma unroll
                for (int i = 0; i < 16; ++i) { const int b2 = part * 16 + i; const int c = BLKCNT[b2 * 32 + e]; tot += c; base += (b2 < bx) ? c : 0; }
                sPT[tid] = tot; sPB[tid] = base; }
            __syncthreads();
            if (tid < 32) { int tot = 0, base = 0;
#pragma unroll
                for (int p = 0; p < 16; ++p) { tot += sPT[p * 32 + tid]; base += sPB[p * 32 + tid]; } sTot[tid] = tot; sBase[tid] = base; }
            __syncthreads();
            if (tid == 0) { int off = 0, nt = 0;
#pragma unroll 1
                for (int e = 0; e < 32; ++e) { sOff[e] = off; const int n = (sTot[e] + 255) >> 8;
                    if (bx == 0) {
#pragma unroll 1
                        for (int i = 0; i < n; ++i) TILEE[nt + i] = e; }
                    nt += n; off += n * 256; }
                if (bx == 0) TILEE[512] = nt; }
            __syncthreads();
            if (tid < 256) { const int t = bx * 64 + (tid >> 2), k = tid & 3; const int e = TOKE[t * 4 + k];
                const int row = sOff[e] + sBase[e] + TOKLP[t * 4 + k]; TOKROW[t * 4 + k] = row; ROWW[row] = TOKW[t * 4 + k]; ROWTOK[row] = t; }
            if (bx < 32 && tid < 256) { const int lo = sOff[bx] + sTot[bx], hi = sOff[bx] + (((sTot[bx] + 255) >> 8) << 8);
                if (lo + tid < hi) ROWTOK[lo + tid] = 0; }
            SEAM();
        }
        PHASE(PH_GU) {
            PH_LOCALS
            const int ntiles = __builtin_amdgcn_readfirstlane(TILEE[512]);
            pg8::Gemm g{(const bf16*)XB8, (const bf16*)(WGU8 + (size_t)l * NEXP * 2048 * DM), DM / 2, DM / 2, DM / 2, 0, ROWTOK};
            pg8::StaticOrder S; S.init(ntiles, 8, G, bx, TILEE);
            pg8::EpiSwiglu E{args.in[I_BGU] + (size_t)l * NEXP * 2048, TILEE, ACT8};
            pg8::gemm_phase<pg8::EpiSwiglu, true, true, true>(lds, g, S, E, tid);
            SEAM();
        }
        PHASE(PH_DOWN) {
            PH_LOCALS
            const int ntiles = __builtin_amdgcn_readfirstlane(TILEE[512]);
            pg8::Gemm g{(const bf16*)ACT8, (const bf16*)(WDN8 + (size_t)l * NEXP * DM * DFF), DFF / 2, DFF / 2, DFF / 2, 0, nullptr};
            pg8::StaticOrder S; S.init(ntiles, 4, G, bx, TILEE, 1, 1);
            pg8::EpiDown E{args.in[I_BDN] + (size_t)l * NEXP * DM, TILEE, ROWW, (unsigned char*)YS};
            pg8::gemm_phase<pg8::EpiDown, true, false, true>(lds, g, S, E, tid);
            SEAM();
        }
        PHASE(PH_LN2) {
            PH_LOCALS
            const float* g2 = args.in[I_LN2G] + (size_t)l * DM; const float* b2 = args.in[I_LN2B] + (size_t)l * DM;
            f32x4 gv[4], bv[4];
#pragma unroll
            for (int j = 0; j < 4; ++j) { gv[j] = *(const f32x4*)(g2 + 4 * lane + 256 * j); bv[j] = *(const f32x4*)(b2 + 4 * lane + 256 * j); }
            const int tw0 = bx * (TOK / GRID) + wave * 8;
            const int myrow = TOKROW[tw0 * 4 + (lane & 31)];
#pragma unroll 1
            for (int i0 = 0; i0 < 8; i0 += 4) {
                u32x2 xb4[4][4]; unsigned ys4[4][4][4];
#pragma unroll
                for (int q = 0; q < 4; ++q) { const int t = tw0 + i0 + q;
#pragma unroll
                    for (int j = 0; j < 4; ++j) xb4[q][j] = *(const u32x2*)(XB + (size_t)t * DM + 4 * lane + 256 * j);
#pragma unroll
                    for (int k = 0; k < 4; ++k) { const int row = __builtin_amdgcn_readlane(myrow, (i0 + q) * 4 + k); const unsigned char* yr = (const unsigned char*)YS + (size_t)row * DM;
#pragma unroll
                        for (int j = 0; j < 4; ++j) ys4[q][k][j] = *(const unsigned*)(yr + 4 * lane + 256 * j); } }
#pragma unroll
                for (int q = 0; q < 4; ++q) {
                    const int t = tw0 + i0 + q;
                    f32x4 v[4];
#pragma unroll
                    for (int j = 0; j < 4; ++j) { const u32x2 w = xb4[q][j]; v[j] = (f32x4){bflo(w.x), bfhi(w.x), bflo(w.y), bfhi(w.y)} * DN_ALPHA;
                        f32x4 ya = (f32x4){0.f, 0.f, 0.f, 0.f};
#pragma unroll
                        for (int k = 0; k < 4; ++k) { const unsigned y = ys4[q][k][j]; const f32x2 lo = __builtin_amdgcn_cvt_pk_f32_fp8((int)y, false), hi2 = __builtin_amdgcn_cvt_pk_f32_fp8((int)y, true);
                            ya[0] += lo[0]; ya[1] += lo[1]; ya[2] += hi2[0]; ya[3] += hi2[1]; }
                        v[j] = v[j] + ya * (1.0f / YS8_SCALE); }
                    float sacc = 0.f;
#pragma unroll
                    for (int j = 0; j < 4; ++j) sacc += (v[j][0] + v[j][1]) + (v[j][2] + v[j][3]);
                    const float mean = wave_sum(sacc, lane) * (1.f / DM); float s2 = 0.f;
#pragma unroll
                    for (int j = 0; j < 4; ++j) { v[j] = v[j] - mean; s2 += (v[j][0] * v[j][0] + v[j][1] * v[j][1]) + (v[j][2] * v[j][2] + v[j][3] * v[j][3]); }
                    const float rstd = 1.f / sqrtf(wave_sum(s2, lane) * (1.f / DM) + LN_EPS);
#pragma unroll
                    for (int j = 0; j < 4; ++j) { const f32x4 o = v[j] * rstd * gv[j] + bv[j];
                        if (l == DEPTH - 1) *(f32x4*)(args.out + (size_t)t * DM + 4 * lane + 256 * j) = o;
                        u32x2 w; w.x = cvtpk(o[0], o[1]); w.y = cvtpk(o[2], o[3]);
                        *(u32x2*)(XB + (size_t)t * DM + 4 * lane + 256 * j) = w;
                        *(unsigned*)(XB8I + (size_t)t * DM + 4 * lane + 256 * j) = pk4_fp8(o[0], o[1], o[2], o[3]); }
                }
            }
            if (l + 1 < args.lay_hi) SEAM();
        }
#undef IN
#undef PHASE
    }
}

extern "C" void kernel_launch(void* const* d_in, const int* in_sizes, int n_in, void* d_out, int out_size, void* d_ws, size_t ws_size, hipStream_t stream) {
    static int ok = 0;
    if (ok == 0) {
        if (n_in != 28 || in_sizes[0] != TOK * DM || out_size != TOK * DM || ws_size < WS_END) {
            fprintf(stderr, "kernel_launch: unexpected shapes: n_in %d in0 %d out %d ws %zu (need %zu)\n", n_in, n_in > 0 ? in_sizes[0] : -1, out_size, ws_size, (size_t)WS_END); ok = -1; return; }
        int dev = 0, cus = 0, per_cu = 0;
        hipGetDevice(&dev); hipDeviceGetAttribute(&cus, hipDeviceAttributeMultiprocessorCount, dev);
        if (hipFuncSetAttribute((const void*)mega, hipFuncAttributeMaxDynamicSharedMemorySize, LDS_BYTES) != hipSuccess) { fprintf(stderr, "kernel_launch: hipFuncSetAttribute failed\n"); ok = -1; return; }
        if (hipOccupancyMaxActiveBlocksPerMultiprocessor(&per_cu, (const void*)mega, NTHR, LDS_BYTES) != hipSuccess || per_cu < 1) fprintf(stderr, "kernel_launch: occupancy query says %d blocks/CU\n", per_cu);
        (void)hipGetLastError();
        if (cus < GRID) { fprintf(stderr, "kernel_launch: device has %d CUs, need %d\n", cus, GRID); ok = -1; return; }
        ok = 1;
    }
    if (ok < 0) return;
    hipMemsetAsync((char*)d_ws + OFF_CTL, 0, CTL_BYTES, stream);
    Args a{};
    for (int i = 0; i < 28; ++i) a.in[i] = (const float*)d_in[i];
    a.out = (float*)d_out; a.ws = (unsigned char*)d_ws;
    for (int l = 0; l < 4; ++l) a.lam_init[l] = (float)(0.8 - 0.6 * exp(-0.3 * (double)l));
#if MK_MULTI
    a.single = 0;
    a.lay_lo = -1; a.lay_hi = 0; a.ph_lo = 0; a.ph_hi = 0;
    hipLaunchKernelGGL(mega, dim3(GRID), dim3(NTHR), LDS_BYTES, stream, a);
    for (int l = 0; l < DEPTH; ++l) for (int p = 1; p < PH_END; ++p) { a.lay_lo = l; a.lay_hi = l + 1; a.ph_lo = p; a.ph_hi = p + 1; hipLaunchKernelGGL(mega, dim3(GRID), dim3(NTHR), LDS_BYTES, stream, a); }
#else
    a.single = 1; a.lay_lo = -1; a.lay_hi = DEPTH; a.ph_lo = 1; a.ph_hi = PH_END;
    hipLaunchKernelGGL(mega, dim3(GRID), dim3(NTHR), LDS_BYTES, stream, a);
#endif
    const hipError_t le = hipPeekAtLastError();
    if (le != hipSuccess) fprintf(stderr, "kernel_launch: launch failed: %s\n", hipGetErrorName(le));
}
```

```cpp
#include <hip/hip_runtime.h>
#include <cstdio>
#include <cstdint>
#include <cmath>

#ifndef MK_MULTI
#define MK_MULTI 0
#endif

#ifndef REPEAT_MASK
#define REPEAT_MASK 0ull
#endif
#ifndef PHASE_MASK
#define PHASE_MASK 0xffffffffull
#endif
#define LAS __attribute__((address_space(3)))
#define GAS __attribute__((address_space(1)))
typedef unsigned short bf16;
typedef short bf16x8 __attribute__((ext_vector_type(8)));
typedef short s16x4 __attribute__((ext_vector_type(4)));
typedef float f32x2 __attribute__((ext_vector_type(2)));
typedef float f32x4 __attribute__((ext_vector_type(4)));
typedef float f32x16 __attribute__((ext_vector_type(16)));
typedef unsigned u32x2 __attribute__((ext_vector_type(2)));
typedef unsigned u32x4 __attribute__((ext_vector_type(4)));

constexpr int BATCH = 2, SEQ = 8192, DM = 1024, TOK = BATCH * SEQ, DEPTH = 4, DIN = 6400;
constexpr int NEXP = 32, DFF = 1024;
constexpr int WA_K_COL = 3072, WA_V_COL = 3200;
constexpr float DN_ALPHA = 1.6817928305074290f;
constexpr float LN_EPS = 1e-5f;
constexpr int NTHR = 512, NWAVES = 8, GRID = 256;
constexpr int MAXROWS = 73728;

constexpr size_t MiB = 1ull << 20;
constexpr size_t OFF_CTL = 0, CTL_BYTES = 1 * MiB;
constexpr size_t OFF_ROPE = 1 * MiB;
constexpr size_t OFF_WML = 3 * MiB;
constexpr size_t OFF_MISC = 5 * MiB;
constexpr size_t OFF_G4 = OFF_MISC;
constexpr size_t OFF_NLOC = OFF_MISC + 1 * MiB;
constexpr size_t OFF_NPREV = OFF_NLOC + 512 * 1024;
constexpr size_t OFF_MLOC = OFF_MISC + 2 * MiB;
constexpr size_t OFF_GCH = OFF_MLOC + 4096;
constexpr size_t OFF_MPREV = OFF_GCH + 4096;
constexpr size_t OFF_BLKCNT = OFF_MLOC + 16384;
constexpr size_t OFF_CGCB = OFF_MLOC + 49152;
constexpr size_t OFF_TILEE = OFF_MLOC + 65536;
constexpr size_t OFF_RWGH = OFF_MISC + 2 * MiB + 512 * 1024;
constexpr size_t OFF_RWGL = OFF_RWGH + 256 * 1024;
constexpr size_t OFF_ROWW = OFF_MLOC + 131072;
constexpr size_t OFF_TOKE = OFF_MISC + 3 * MiB;
constexpr size_t OFF_TOKW = OFF_TOKE + 256 * 1024;
constexpr size_t OFF_TOKLP = OFF_TOKW + 256 * 1024;
constexpr size_t OFF_TOKROW = OFF_TOKLP + 256 * 1024;
constexpr size_t OFF_WIN = 9 * MiB;
constexpr size_t OFF_WP = OFF_WIN + 50 * MiB;
constexpr size_t OFF_WOUT = OFF_WP + 12 * MiB;
constexpr size_t OFF_WGU = OFF_WOUT + 8 * MiB;
constexpr size_t OFF_WDN = OFF_WGU + 512 * MiB;
constexpr size_t OFF_XB = OFF_WDN + 256 * MiB;
constexpr size_t OFF_XF = OFF_XB + 32 * MiB;
constexpr size_t OFF_QA = OFF_XF + 64 * MiB;
constexpr size_t OFF_KA = OFF_QA + 16 * MiB;
constexpr size_t OFF_VA = OFF_KA + 16 * MiB;
constexpr size_t OFF_MLX = OFF_VA + 16 * MiB;
constexpr size_t OFF_MLO = OFF_MLX + 16 * MiB;
constexpr size_t OFF_XC = OFF_MLO + 16 * MiB;
constexpr size_t OFF_WQ = OFF_XC + 16 * MiB;
constexpr size_t OFF_WK = OFF_WQ + 16 * MiB;
constexpr size_t OFF_WV = OFF_WK + 4 * MiB;
constexpr size_t OFF_GT = OFF_WV + 4 * MiB;
constexpr size_t OFF_Y3 = OFF_GT + 96 * MiB;
constexpr size_t OFF_MF = OFF_Y3 + 48 * MiB;
constexpr size_t OFF_MB = OFF_MF + 64 * MiB;
constexpr size_t OFF_MQ = OFF_MB + 32 * MiB;
constexpr size_t OFF_CLOC = OFF_MQ + 48 * MiB;
constexpr size_t OFF_CPT = OFF_CLOC + 64 * MiB;
constexpr size_t OFF_STASH = OFF_CPT + 32 * MiB;
constexpr size_t OFF_XG = OFF_STASH + 32 * MiB;
constexpr size_t OFF_ACT = OFF_XG + 144 * MiB;
constexpr size_t OFF_YS = OFF_ACT + 144 * MiB;
constexpr size_t OFF_ZB = OFF_YS + 144 * MiB;
constexpr size_t OFF_X1 = OFF_ZB + 64 * MiB;
constexpr size_t OFF_WGT = OFF_X1 + 64 * MiB;
constexpr size_t OFF_ROWTOK = OFF_WGT + 1 * MiB;
constexpr size_t OFF_XB8 = OFF_ROWTOK + 1 * MiB;
constexpr size_t WS_END = OFF_XB8 + 16 * MiB;

constexpr int PH_LDS = 147456;
constexpr int LDS_BYTES = PH_LDS + 256;

typedef float f32x2_cv __attribute__((ext_vector_type(2))); typedef __bf16 bf16x2_cv __attribute__((ext_vector_type(2)));
__device__ __forceinline__ unsigned cvtpk(float lo, float hi) { const f32x2_cv v = {lo, hi}; const bf16x2_cv b = __builtin_convertvector(v, bf16x2_cv); return __builtin_bit_cast(unsigned, b); }
__device__ __forceinline__ float bflo(unsigned u) { return __uint_as_float(u << 16); }
__device__ __forceinline__ float bfhi(unsigned u) { return __uint_as_float(u & 0xffff0000u); }
__device__ __forceinline__ float bf1(bf16 h) { return __uint_as_float(((unsigned)h) << 16); }
__device__ __forceinline__ bf16 tobf1(float f) { return (bf16)(cvtpk(f, 0.f) & 0xffffu); }
__device__ __forceinline__ float sigmoidf_(float x) { return __builtin_amdgcn_rcpf(1.0f + __builtin_amdgcn_exp2f(-1.4426950408889634f * x)); }
__device__ __forceinline__ float shx(float v, int mask, int lane) { return __int_as_float(__builtin_amdgcn_ds_bpermute((lane ^ mask) << 2, __float_as_int(v))); }
__device__ __forceinline__ float shup(float v, int off, int lane) { return __int_as_float(__builtin_amdgcn_ds_bpermute((lane - off) << 2, __float_as_int(v))); }
__device__ __forceinline__ float wave_sum(float v, int lane) {
#pragma unroll
    for (int o = 1; o < 64; o <<= 1) v += shx(v, o, lane);
    return v;
}
__device__ __forceinline__ float wave_max(float v, int lane) {
#pragma unroll
    for (int o = 1; o < 64; o <<= 1) v = fmaxf(v, shx(v, o, lane));
    return v;
}
#define LDS_WAIT() asm volatile("s_waitcnt lgkmcnt(0)" ::: "memory")

__device__ __forceinline__ unsigned pk4_fp8(float a, float b, float c, float d) { int w = __builtin_amdgcn_cvt_pk_fp8_f32(a, b, 0, false); w = __builtin_amdgcn_cvt_pk_fp8_f32(c, d, w, true); return (unsigned)w; }
constexpr float W8_GU_SCALE = 32.f, W8_DN_SCALE = 64.f, W8_IN_SCALE = 32.f, YS8_SCALE = 16.f;

namespace pg8 {
constexpr int BM = 256, BK = 64, HALF = 128, HTB = HALF * BK * 2, STAGE_BYTES = 8 * HTB, NXCD = 8, WGM = 8;
__host__ __device__ __forceinline__ int lds_byte(int r, int c) { const int st = (r >> 4) * 2 + (c >> 5), rr = r & 15, cc = c & 31, ob = rr * 64 + cc * 2; return st * 1024 + (ob ^ (((ob >> 9) & 1) << 5)); }
__host__ __device__ __forceinline__ void stage_rc(int b, int& R, int& C) { const int st = b / 1024, sb = b % 1024, swz = sb ^ (((sb >> 9) & 1) << 5); R = (st >> 1) * 16 + swz / 64; C = (st & 1) * 32 + (swz % 64) / 2; }
__host__ __device__ __forceinline__ int perm32(int rho) { const int n = rho >> 4, i = rho & 15; return 8 * (i >> 2) + 4 * n + (i & 3); }

struct Unit { int pm, pn, bt, br, hf; };
struct Gemm { const bf16* A; const bf16* Bt; int lda, ldb, K; size_t abr; const int* rowtok; };

__device__ __forceinline__ void tile_of(int wgid, int nwg, int nM, int nN, int& pm, int& pn) {
    { const int q = nwg / NXCD, r = nwg % NXCD, xcd = wgid % NXCD, off = wgid / NXCD; wgid = (xcd < r ? xcd * (q + 1) : r * (q + 1) + (xcd - r) * q) + off; }
    const int nig = WGM * nN, gid = wgid / nig, fm = gid * WGM, gsz = (nM - fm) < WGM ? (nM - fm) : WGM;
    pm = fm + ((wgid % nig) % gsz); pn = (wgid % nig) / gsz;
}
struct StaticOrder {
    int nM, nN, nwg, G, c, nbr, split; const int* tile_e;
    __device__ void init(int nM_, int nN_, int G_, int c_, const int* te, int nbr_ = 1, int split_ = 0) { nM = nM_; nN = nN_; nwg = nM * nN; G = G_; c = c_; tile_e = te; nbr = nbr_; split = split_; }
    __device__ bool next(int i, Unit& u) const {
        long L = (nbr > 1) ? (long)c : (long)i * G + c; if (nbr > 1 && i >= nbr) return false;
        u.hf = 0;
        const int R = nwg % G, full = nwg - R;
        if (split && R > 0 && 2 * R <= G && L >= full) { const int j = (int)(L - full); if (j >= 2 * R) return false; L = full + (j % R); u.hf = 1 + j / R; }
        else if (L >= nwg) return false;
        u.br = (nbr > 1) ? i : 0;
        tile_of((int)L, nwg, nM, nN, u.pm, u.pn);
        u.bt = tile_e ? (__builtin_amdgcn_readfirstlane(tile_e[u.pm]) * nN + u.pn) : (u.br * nN + u.pn);
        return true;
    }
};

static_assert(WGM == 8 && NXCD == 8, "InprojOrder mode 2 deals the last 64 list positions as half units: with these constants they are exactly the 64 tiles of gate column tile 24");
struct InprojOrder {
    int mode, c;
    __device__ bool next(int i, Unit& u) const {
        int L, nN, pn;
        int hf = 0;
        if (mode == 2) { nN = 25; if (i < 6) L = i * 256 + c; else if (i == 6 && c < 128) { L = 1536 + (c & 63); hf = 1 + (c >> 6); } else return false; }
        else if (mode == 0) { nN = 5; if (i == 0) L = c; else if (i == 1 && c < 64) L = 256 + c; else return false; }
        else { nN = 20; if (i < 4) L = i * 256 + c; else if (i == 4 && c >= 64) L = 1024 + (c - 64); else if (i == 5 && c >= 192) L = 1216 + (c - 192); else return false; }
        u.br = 0; u.hf = hf;
        tile_of(L, 64 * nN, 64, nN, u.pm, pn);
        if (mode == 2) { u.pn = pn; u.bt = pn; }
        else if (mode == 0) { u.pn = pn < 2 ? 6 + pn : 8 + pn; u.bt = u.pn; }
        else { u.pn = pn < 6 ? pn : (pn < 8 ? pn + 2 : pn + 5); u.bt = pn; }
        return true;
    }
};

typedef int i32x4v __attribute__((ext_vector_type(4))); typedef int i32x8v __attribute__((ext_vector_type(8)));
__device__ __forceinline__ i32x8v cat16(const bf16x8 a, const bf16x8 b) { const i32x4v x = __builtin_bit_cast(i32x4v, a), y = __builtin_bit_cast(i32x4v, b); return (i32x8v){x[0], x[1], x[2], x[3], y[0], y[1], y[2], y[3]}; }
template <class Epi, bool ALIGN_EPI, bool GATHER = false, bool FP8 = false, class Order = StaticOrder>
__device__ __forceinline__ void gemm_phase(LAS unsigned char* lds, const Gemm g, const Order& S, const Epi& E, int tid) {
    asm volatile("" : "+v"(tid));
    const int wid = __builtin_amdgcn_readfirstlane(tid >> 6), lane = tid & 63, wr = wid >> 2, wc = wid & 3, fr = lane & 15, fq = lane >> 4;
    const int K = g.K, nt = K / BK;
    unsigned voffA[2], voffB[2]; int RA[2], CA[2];
#pragma unroll
    for (int i = 0; i < 2; ++i) { int R, C; stage_rc(tid * 16 + i * 8192, R, C); const int Rb = Epi::PERM ? ((R & ~31) + perm32(R & 31)) : R;
        RA[i] = R; CA[i] = C; voffA[i] = (unsigned)(R * g.lda + C) * 2u; voffB[i] = (unsigned)(Rb * g.ldb + C) * 2u; }
    unsigned voffAc[2][2], voffAn[2][2];
#define PG8_GOFF(dst, pm_) do { _Pragma("unroll") for (int _h = 0; _h < 2; ++_h) _Pragma("unroll") for (int _i = 0; _i < 2; ++_i) \
        dst[_h][_i] = (unsigned)(g.rowtok[(pm_) * BM + _h * HALF + RA[_i]] * g.lda + CA[_i]) * 2u; } while (0)
#define PG8_STAGE_A(bufoff, ptr_ng, kidx, half, usenext) do { if constexpr (GATHER) { const char* gb_ = (const char*)g.A + (size_t)(kidx) * kstep; \
        _Pragma("unroll") for (int _i = 0; _i < 2; ++_i) { const unsigned vo_ = (usenext) ? voffAn[half][_i] : voffAc[half][_i]; \
            __builtin_amdgcn_global_load_lds((const unsigned*)(gb_ + vo_), (LAS unsigned*)(lds + (bufoff) + ldsw + _i * 8192), 16, 0, 0); } } \
        else { PG8_STAGE(bufoff, (ptr_ng) + ((half) ? hsA : 0), voffA); } } while (0)
    const size_t kstep = (size_t)(BK * 2);
    const size_t hsA = (size_t)HALF * g.lda * 2, hsB = (size_t)HALF * g.ldb * 2;
    const size_t tsA = 2 * hsA, tsB = 2 * hsB;
    const unsigned ldsw = (unsigned)wid * 1024u;
    const int aoff = lds_byte(wr * 64 + fr, fq * 8), boff = lds_byte(wc * 32 + fr, fq * 8);
#define PG8_SA(b, h) (((b) * 2 + (h)) * HTB)
#define PG8_SB(b, h) ((4 + (b) * 2 + (h)) * HTB)
#define PG8_STAGE(bufoff, gbase, voff) do { _Pragma("unroll") for (int _i = 0; _i < 2; ++_i) \
        __builtin_amdgcn_global_load_lds((const unsigned*)((const char*)(gbase) + (voff)[_i]), (LAS unsigned*)(lds + (bufoff) + ldsw + _i * 8192), 16, 0, 0); } while (0)
#define PG8_LDA(dst, b, h) do { if constexpr (FP8) { _Pragma("unroll") for (int m = 0; m < 4; ++m) dst##8[m] = cat16(*(const LAS bf16x8*)(lds + PG8_SA(b, h) + aoff + m * 2048), *(const LAS bf16x8*)(lds + PG8_SA(b, h) + aoff + m * 2048 + 1024)); } \
        else { _Pragma("unroll") for (int m = 0; m < 4; ++m) _Pragma("unroll") for (int k = 0; k < 2; ++k) dst[m][k] = *(const LAS bf16x8*)(lds + PG8_SA(b, h) + aoff + m * 2048 + k * 1024); } } while (0)
#define PG8_LDB(dst, b, h) do { if constexpr (FP8) { _Pragma("unroll") for (int n = 0; n < 2; ++n) dst##8[n] = cat16(*(const LAS bf16x8*)(lds + PG8_SB(b, h) + boff + n * 2048), *(const LAS bf16x8*)(lds + PG8_SB(b, h) + boff + n * 2048 + 1024)); } \
        else { _Pragma("unroll") for (int n = 0; n < 2; ++n) _Pragma("unroll") for (int k = 0; k < 2; ++k) dst[n][k] = *(const LAS bf16x8*)(lds + PG8_SB(b, h) + boff + n * 2048 + k * 1024); } } while (0)
#define PG8_MMA(ai, bj, At, Bt) do { __builtin_amdgcn_s_setprio(1); _Pragma("unroll") for (int m = 0; m < 4; ++m) _Pragma("unroll") for (int n = 0; n < 2; ++n) { \
        if constexpr (FP8) asm volatile("v_mfma_scale_f32_16x16x128_f8f6f4 %0, %1, %2, %0, %3, %3 op_sel_hi:[0,0,0]" : "+v"(acc[ai][bj][m][n]) : "v"(Bt##8[n]), "v"(At##8[m]), "v"(mx_one)); \
        else { _Pragma("unroll") for (int k = 0; k < 2; ++k) acc[ai][bj][m][n] = __builtin_amdgcn_mfma_f32_16x16x32_bf16(Bt[n][k], At[m][k], acc[ai][bj][m][n], 0, 0, 0); } } \
        __builtin_amdgcn_s_setprio(0); } while (0)
#define PG8_WAIT_V(n) asm volatile("s_waitcnt vmcnt(" #n ")" ::: "memory")
#define PG8_WAIT_L(n) asm volatile("s_waitcnt lgkmcnt(" #n ")" ::: "memory")
#define PG8_BAR __builtin_amdgcn_s_barrier()
#define PG8_SCHED __builtin_amdgcn_sched_barrier(0)
    Unit cur, nxt; int ui = 0;
    if (!S.next(0, cur)) return;
    f32x4 acc[2][2][4][2];
#pragma unroll
    for (int a = 0; a < 2; ++a)
#pragma unroll
        for (int b = 0; b < 2; ++b)
#pragma unroll
            for (int m = 0; m < 4; ++m)
#pragma unroll
                for (int n = 0; n < 2; ++n) acc[a][b][m][n] = (f32x4){0.f, 0.f, 0.f, 0.f};
    bf16x8 At[4][2], B0[2][2], B1[2][2];
    i32x8v At8[4], B08[2], B18[2];
    const int mx_one = 0x7F7F7F7F;
    const char* cA = (const char*)g.A + (size_t)cur.br * g.abr + (size_t)cur.pm * tsA; const char* cB = (const char*)g.Bt + (size_t)cur.bt * tsB + (cur.hf == 2 ? hsB : 0);
    size_t hoC = cur.hf ? 0 : hsB;
    if constexpr (GATHER) { PG8_GOFF(voffAc, cur.pm); PG8_GOFF(voffAn, cur.pm); }
    PG8_STAGE(PG8_SB(0, 0), cB, voffB); PG8_STAGE(PG8_SB(0, 1), cB + hoC, voffB); PG8_STAGE_A(PG8_SA(0, 0), cA, 0, 0, false); PG8_STAGE_A(PG8_SA(0, 1), cA, 0, 1, false);
    if (wr == 1) PG8_BAR;
    PG8_WAIT_V(2); PG8_BAR;
    PG8_STAGE(PG8_SB(1, 0), cB + kstep, voffB); PG8_STAGE_A(PG8_SA(1, 0), cA + kstep, 1, 0, false); PG8_STAGE(PG8_SB(1, 1), cB + hoC + kstep, voffB);
    PG8_WAIT_V(6); PG8_BAR;
    for (;;) {
        const bool has_next = S.next(ui + 1, nxt);
        const char* nA = has_next ? (const char*)g.A + (size_t)nxt.br * g.abr + (size_t)nxt.pm * tsA : cA; const char* nB = has_next ? (const char*)g.Bt + (size_t)nxt.bt * tsB + (nxt.hf == 2 ? hsB : 0) : cB;
        const size_t hoN = has_next ? (nxt.hf ? 0 : hsB) : hoC; const bool whole = cur.hf == 0;
        if constexpr (GATHER) { if (has_next) PG8_GOFF(voffAn, nxt.pm); }
#pragma unroll 1
        for (int t = 0; t < nt; t += 2) {
            const bool last = (t == nt - 2);
            const bool un = last && has_next;
            const int k2 = last ? 0 : t + 2;
            const char* a1 = cA + (size_t)(t + 1) * kstep;
            const char* a2 = last ? nA : cA + (size_t)(t + 2) * kstep; const char* b2 = last ? nB : cB + (size_t)(t + 2) * kstep;
            const char* a3 = a2 + kstep; const char* b3 = b2 + kstep; const size_t ho2 = last ? hoN : hoC;
            PG8_LDB(B0, 0, 0); if (whole) PG8_LDB(B1, 0, 1); PG8_SCHED; PG8_LDA(At, 0, 0); PG8_STAGE_A(PG8_SA(1, 1), a1, t + 1, 1, false);
            PG8_WAIT_V(8); PG8_WAIT_L(0); PG8_BAR; PG8_MMA(0, 0, At, B0); if (whole) PG8_MMA(0, 1, At, B1); PG8_BAR; PG8_SCHED;
            PG8_LDA(At, 0, 1); PG8_STAGE(PG8_SB(0, 0), b2, voffB); PG8_STAGE(PG8_SB(0, 1), b2 + ho2, voffB); PG8_STAGE_A(PG8_SA(0, 0), a2, k2, 0, un);
            PG8_WAIT_V(8); PG8_WAIT_L(0); PG8_BAR; PG8_MMA(1, 0, At, B0); if (whole) PG8_MMA(1, 1, At, B1); PG8_BAR; PG8_SCHED;
            PG8_LDB(B0, 1, 0); if (whole) PG8_LDB(B1, 1, 1); PG8_SCHED; PG8_LDA(At, 1, 0); PG8_STAGE_A(PG8_SA(0, 1), a2, k2, 1, un);
            PG8_WAIT_V(8); PG8_WAIT_L(0); PG8_BAR; PG8_MMA(0, 0, At, B0); if (whole) PG8_MMA(0, 1, At, B1); PG8_BAR; PG8_SCHED;
            PG8_LDA(At, 1, 1); PG8_STAGE(PG8_SB(1, 0), b3, voffB); PG8_STAGE(PG8_SB(1, 1), b3 + ho2, voffB); PG8_STAGE_A(PG8_SA(1, 0), a3, k2 + 1, 0, un);
            PG8_WAIT_V(8); PG8_WAIT_L(0); PG8_BAR; PG8_MMA(1, 0, At, B0); if (whole) PG8_MMA(1, 1, At, B1); PG8_BAR; PG8_SCHED;
        }
        if constexpr (ALIGN_EPI) { if (wr == 0) PG8_BAR; }
        if constexpr (FP8) asm volatile("s_nop 15\n\ts_nop 15\n\ts_nop 15\n\ts_nop 15" ::: "memory");
        E(acc, cur, wr, wc, fr, fq);
        if (!has_next) break;
        if (!(Epi::CARRY && cur.br < 2)) {
#pragma unroll
        for (int a = 0; a < 2; ++a)
#pragma unroll
            for (int b = 0; b < 2; ++b)
#pragma unroll
                for (int m = 0; m < 4; ++m)
#pragma unroll
                    for (int n = 0; n < 2; ++n) acc[a][b][m][n] = (f32x4){0.f, 0.f, 0.f, 0.f};
        }
        cur = nxt; cA = nA; cB = nB; hoC = hoN; ++ui;
        if constexpr (GATHER) { _Pragma("unroll") for (int _h = 0; _h < 2; ++_h) _Pragma("unroll") for (int _i = 0; _i < 2; ++_i) voffAc[_h][_i] = voffAn[_h][_i]; }
        if constexpr (ALIGN_EPI) { if (wr == 1) PG8_BAR; }
    }
    PG8_WAIT_V(0);
    if constexpr (!ALIGN_EPI) { if (wr == 0) PG8_BAR; }
    PG8_BAR;
#undef PG8_SA
#undef PG8_SB
#undef PG8_STAGE
#undef PG8_STAGE_A
#undef PG8_GOFF
#undef PG8_LDA
#undef PG8_LDB
#undef PG8_MMA
#undef PG8_WAIT_V
#undef PG8_WAIT_L
#undef PG8_BAR
#undef PG8_SCHED
}

__device__ __forceinline__ u32x4 pack8(const f32x4 v0, const f32x4 v1) { u32x4 w; w.x = cvtpk(v0[0], v0[1]); w.y = cvtpk(v0[2], v0[3]); w.z = cvtpk(v1[0], v1[1]); w.w = cvtpk(v1[2], v1[3]); return w; }

struct EpiInProj {
    static constexpr bool PERM = true, CARRY = false;
    bf16 *QA, *KA, *VA, *MLX, *MLO, *WQ, *WK, *WV, *GT; const f32x2* rope; float ds;
    __device__ __forceinline__ void operator()(const f32x4 (&acc)[2][2][4][2], const Unit& u, int wr, int wc, int fr, int fq) const {
        const int pn = u.pn, row0 = u.pm * BM + wr * 64 + fr, c0 = wc * 32 + 8 * fq;
        bf16* base; int W, extraB, radd0, radd1, cadd0, cadd1, mode;
        float qs = 1.f; int f8 = 0;
        if (pn < 2)       { base = QA; W = 64; extraB = 7 * SEQ; radd0 = radd1 = (4 * pn + wc) * SEQ; cadd0 = 8 * fq; cadd1 = 32 + 8 * fq; mode = 1; f8 = 1; qs = 1.4426950408889634f; }
        else if (pn < 4)  { base = KA; W = 64; extraB = 7 * SEQ; radd0 = radd1 = (4 * (pn - 2) + wc) * SEQ; cadd0 = 8 * fq; cadd1 = 32 + 8 * fq; mode = 1; f8 = 1; }
        else if (pn < 6)  { base = VA; W = 128; extraB = 3 * SEQ; radd0 = ((pn - 4) * 2) * SEQ; radd1 = ((pn - 4) * 2 + 1) * SEQ; cadd0 = cadd1 = c0; mode = 0; f8 = 2; }
        else if (pn < 8)  { base = MLX; W = 512; extraB = 0; radd0 = radd1 = 0; cadd0 = (pn - 6) * 256 + c0; cadd1 = cadd0 + 128; mode = 0; }
        else if (pn < 10) { base = MLO; W = 512; extraB = 0; radd0 = radd1 = 0; cadd0 = (pn - 8) * 256 + c0; cadd1 = cadd0 + 128; mode = 0; }
        else if (pn < 12) { base = WQ; W = 64; extraB = 7 * SEQ; radd0 = radd1 = (4 * (pn - 10) + wc) * SEQ; cadd0 = 8 * fq; cadd1 = 32 + 8 * fq; mode = 1; }
        else if (pn == 12) {
            if (wc < 2)   { base = WK; W = 64; extraB = SEQ; radd0 = radd1 = wc * SEQ; cadd0 = 8 * fq; cadd1 = 32 + 8 * fq; mode = 1; }
            else          { base = WV; W = 64; extraB = SEQ; radd0 = 0; radd1 = SEQ; cadd0 = cadd1 = (wc - 2) * 32 + 8 * fq; mode = 0; }
        }
        else              { base = GT; W = 3072; extraB = 0; radd0 = radd1 = 0; cadd0 = (pn - 13) * 256 + c0; cadd1 = cadd0 + 128; mode = 2; }
#pragma unroll
        for (int ai = 0; ai < 2; ++ai)
#pragma unroll
            for (int m = 0; m < 4; ++m) {
                const int row = row0 + ai * HALF + m * 16, b = row >> 13, s = row & (SEQ - 1);
                f32x4 l0 = acc[ai][0][m][0] * ds, l1 = acc[ai][0][m][1] * ds, h0 = acc[ai][1][m][0] * ds, h1 = acc[ai][1][m][1] * ds;
                if (mode == 1) {
                    const f32x4* rp = (const f32x4*)(rope + (size_t)s * 32 + 8 * fq);
                    const f32x4 r0 = rp[0], r1 = rp[1], r2 = rp[2], r3 = rp[3];
                    f32x4 nl0, nl1, nh0, nh1;
                    nl0[0] = l0[0] * r0[0] - h0[0] * r0[1]; nh0[0] = h0[0] * r0[0] + l0[0] * r0[1];
                    nl0[1] = l0[1] * r0[2] - h0[1] * r0[3]; nh0[1] = h0[1] * r0[2] + l0[1] * r0[3];
                    nl0[2] = l0[2] * r1[0] - h0[2] * r1[1]; nh0[2] = h0[2] * r1[0] + l0[2] * r1[1];
                    nl0[3] = l0[3] * r1[2] - h0[3] * r1[3]; nh0[3] = h0[3] * r1[2] + l0[3] * r1[3];
                    nl1[0] = l1[0] * r2[0] - h1[0] * r2[1]; nh1[0] = h1[0] * r2[0] + l1[0] * r2[1];
                    nl1[1] = l1[1] * r2[2] - h1[1] * r2[3]; nh1[1] = h1[1] * r2[2] + l1[1] * r2[3];
                    nl1[2] = l1[2] * r3[0] - h1[2] * r3[1]; nh1[2] = h1[2] * r3[0] + l1[2] * r3[1];
                    nl1[3] = l1[3] * r3[2] - h1[3] * r3[3]; nh1[3] = h1[3] * r3[2] + l1[3] * r3[3];
                    l0 = nl0 * qs; l1 = nl1 * qs; h0 = nh0 * qs; h1 = nh1 * qs;
                } else if (mode == 2) {
#pragma unroll
                    for (int j = 0; j < 4; ++j) { l0[j] = sigmoidf_(l0[j]); l1[j] = sigmoidf_(l1[j]); h0[j] = sigmoidf_(h0[j]); h1[j] = sigmoidf_(h1[j]); }
                }
                const size_t rb = (size_t)row + (size_t)b * extraB;
                if (f8 == 1) {
                    unsigned char* b8 = (unsigned char*)base;
                    *(u32x2*)(b8 + (rb + radd0) * 64 + cadd0) = (u32x2){pk4_fp8(l0[0], l0[1], l0[2], l0[3]), pk4_fp8(l1[0], l1[1], l1[2], l1[3])};
                    *(u32x2*)(b8 + (rb + radd1) * 64 + cadd1) = (u32x2){pk4_fp8(h0[0], h0[1], h0[2], h0[3]), pk4_fp8(h1[0], h1[1], h1[2], h1[3])};
                } else if (f8 == 2) {
                    const int kk = s & 63, pos = ((kk >> 2) & 1) * 32 + (kk >> 5) * 16 + (kk & 3) + 4 * ((kk & 31) >> 3);
                    unsigned char* b8 = (unsigned char*)base + (((size_t)(b * 4 + (pn - 4) * 2) * 128 + (s >> 6)) * 128 + c0) * 64 + pos;
                    const unsigned w0 = pk4_fp8(l0[0], l0[1], l0[2], l0[3]), w1 = pk4_fp8(l1[0], l1[1], l1[2], l1[3]);
                    const unsigned w2 = pk4_fp8(h0[0], h0[1], h0[2], h0[3]), w3 = pk4_fp8(h1[0], h1[1], h1[2], h1[3]);
#pragma unroll
                    for (int j = 0; j < 4; ++j) { b8[j * 64] = (unsigned char)(w0 >> (8 * j)); b8[(4 + j) * 64] = (unsigned char)(w1 >> (8 * j));
                        b8[(size_t)128 * 128 * 64 + j * 64] = (unsigned char)(w2 >> (8 * j)); b8[(size_t)128 * 128 * 64 + (4 + j) * 64] = (unsigned char)(w3 >> (8 * j)); }
                } else {
                if (u.hf != 2) *(u32x4*)(base + (rb + radd0) * W + cadd0) = pack8(l0, l1);
                if (u.hf == 0) *(u32x4*)(base + (rb + radd1) * W + cadd1) = pack8(h0, h1);
                if (u.hf == 2) *(u32x4*)(base + (rb + radd1) * W + cadd1) = pack8(l0, l1);
                }
            }
    }
};


struct EpiMerge {
    static constexpr bool PERM = true, CARRY = true;
    const bf16* GT; bf16* MB;
    __device__ __forceinline__ void operator()(f32x4 (&acc)[2][2][4][2], const Unit& u, int wr, int wc, int fr, int fq) const {
        const int row0 = u.pm * BM + wr * 64 + fr, col0 = u.pn * BM + wc * 32 + 8 * fq, br = u.br, brn = br < 2 ? br + 1 : 2;
#pragma unroll
        for (int ai = 0; ai < 2; ++ai)
#pragma unroll
            for (int mp = 0; mp < 2; ++mp) {
                u32x4 gw[2][2], gn[2][2];
#pragma unroll
                for (int mm = 0; mm < 2; ++mm)
#pragma unroll
                    for (int bj = 0; bj < 2; ++bj) { const size_t row = (size_t)(row0 + ai * HALF + (mp * 2 + mm) * 16); const int col = col0 + bj * HALF;
                        gw[mm][bj] = *(const u32x4*)(GT + row * 3072 + br * 1024 + col); gn[mm][bj] = *(const u32x4*)(GT + row * 3072 + brn * 1024 + col); }
#pragma unroll
                for (int mm = 0; mm < 2; ++mm)
#pragma unroll
                    for (int bj = 0; bj < 2; ++bj) { const size_t row = (size_t)(row0 + ai * HALF + (mp * 2 + mm) * 16); const int col = col0 + bj * HALF; const int m = mp * 2 + mm;
                        const u32x4 g = gw[mm][bj], d = gn[mm][bj];
                        float f[8] = {bflo(g.x), bfhi(g.x), bflo(g.y), bfhi(g.y), bflo(g.z), bfhi(g.z), bflo(g.w), bfhi(g.w)};
#pragma unroll
                        for (int j = 0; j < 8; ++j) f[j] = fmaxf(f[j], 1e-30f);
                        if (br < 2) { const float dd[8] = {bflo(d.x), bfhi(d.x), bflo(d.y), bfhi(d.y), bflo(d.z), bfhi(d.z), bflo(d.w), bfhi(d.w)};
#pragma unroll
                            for (int j = 0; j < 8; ++j) f[j] *= __builtin_amdgcn_rcpf(fmaxf(dd[j], 1e-30f)); }
                        f32x4 v0 = acc[ai][bj][m][0], v1 = acc[ai][bj][m][1];
                        v0[0] *= f[0]; v0[1] *= f[1]; v0[2] *= f[2]; v0[3] *= f[3]; v1[0] *= f[4]; v1[1] *= f[5]; v1[2] *= f[6]; v1[3] *= f[7];
                        if (br < 2) { acc[ai][bj][m][0] = v0; acc[ai][bj][m][1] = v1; }
                        else *(u32x4*)(MB + row * 1024 + col) = pack8(v0, v1); }
            }
    }
};

struct EpiOut {
    static constexpr bool PERM = true, CARRY = false;
    const bf16* resid; bf16* Z;
    __device__ __forceinline__ void operator()(const f32x4 (&acc)[2][2][4][2], const Unit& u, int wr, int wc, int fr, int fq) const {
        const int row0 = u.pm * BM + wr * 64 + fr, col0 = u.pn * BM + wc * 32 + 8 * fq;
#pragma unroll
        for (int ai = 0; ai < 2; ++ai) {
            u32x4 rr[4][2];
#pragma unroll
            for (int m = 0; m < 4; ++m)
#pragma unroll
                for (int bj = 0; bj < 2; ++bj) rr[m][bj] = *(const u32x4*)(resid + (size_t)(row0 + ai * HALF + m * 16) * 1024 + col0 + bj * HALF);
#pragma unroll
            for (int m = 0; m < 4; ++m)
#pragma unroll
                for (int bj = 0; bj < 2; ++bj) { const u32x4 g = rr[m][bj];
                    f32x4 v0 = acc[ai][bj][m][0], v1 = acc[ai][bj][m][1];
                    v0[0] += DN_ALPHA * bflo(g.x); v0[1] += DN_ALPHA * bfhi(g.x); v0[2] += DN_ALPHA * bflo(g.y); v0[3] += DN_ALPHA * bfhi(g.y);
                    v1[0] += DN_ALPHA * bflo(g.z); v1[1] += DN_ALPHA * bfhi(g.z); v1[2] += DN_ALPHA * bflo(g.w); v1[3] += DN_ALPHA * bfhi(g.w);
                    *(u32x4*)(Z + (size_t)(row0 + ai * HALF + m * 16) * 1024 + col0 + bj * HALF) = pack8(v0, v1); }
        }
    }
};

struct EpiSwiglu {
    static constexpr bool PERM = true, CARRY = false;
    const float* bgu  ; const int* tile_e; unsigned char* ACT8_;
    __device__ __forceinline__ void operator()(const f32x4 (&acc)[2][2][4][2], const Unit& u, int wr, int wc, int fr, int fq) const {
        const int e = __builtin_amdgcn_readfirstlane(tile_e[u.pm]);
        const int row0 = u.pm * BM + wr * 64 + fr, cl0 = u.pn * BM + wc * 32 + 8 * fq;
        constexpr float ds = 1.0f / W8_GU_SCALE;
        f32x4 bv[2][2];
#pragma unroll
        for (int bj = 0; bj < 2; ++bj) { bv[bj][0] = *(const f32x4*)(bgu + (size_t)e * 2048 + cl0 + bj * HALF); bv[bj][1] = *(const f32x4*)(bgu + (size_t)e * 2048 + cl0 + bj * HALF + 4); }
#pragma unroll
        for (int ai = 0; ai < 2; ++ai)
#pragma unroll
            for (int m = 0; m < 4; ++m) {
                const size_t row = (size_t)(row0 + ai * HALF + m * 16);
#pragma unroll
                for (int bj = 0; bj < 2; ++bj) {
                    const f32x4 v0 = acc[ai][bj][m][0] * ds + bv[bj][0], v1 = acc[ai][bj][m][1] * ds + bv[bj][1];
                    float a[4];
                    { float g = fminf(v0[0], 7.f), up = fminf(fmaxf(v0[1], -7.f), 7.f); a[0] = g * sigmoidf_(1.702f * g) * (up + 1.f); }
                    { float g = fminf(v0[2], 7.f), up = fminf(fmaxf(v0[3], -7.f), 7.f); a[1] = g * sigmoidf_(1.702f * g) * (up + 1.f); }
                    { float g = fminf(v1[0], 7.f), up = fminf(fmaxf(v1[1], -7.f), 7.f); a[2] = g * sigmoidf_(1.702f * g) * (up + 1.f); }
                    { float g = fminf(v1[2], 7.f), up = fminf(fmaxf(v1[3], -7.f), 7.f); a[3] = g * sigmoidf_(1.702f * g) * (up + 1.f); }
                    *(unsigned*)(ACT8_ + row * 1024 + ((cl0 + bj * HALF) >> 1)) = pk4_fp8(a[0], a[1], a[2], a[3]);
                }
            }
    }
};

struct EpiDown {
    static constexpr bool PERM = true, CARRY = false;
    const float* bdn  ; const int* tile_e; const float* roww; unsigned char* YS;
    __device__ __forceinline__ void operator()(const f32x4 (&acc)[2][2][4][2], const Unit& u, int wr, int wc, int fr, int fq) const {
        const int e = __builtin_amdgcn_readfirstlane(tile_e[u.pm]);
        const int row0 = u.pm * BM + wr * 64 + fr, cl0 = u.pn * BM + wc * 32 + 8 * fq + (u.hf == 2 ? HALF : 0), nbj = u.hf ? 1 : 2;
        constexpr float ds = 1.0f / W8_DN_SCALE;
        f32x4 bv[2][2];
#pragma unroll
        for (int bj = 0; bj < 2; ++bj) { bv[bj][0] = *(const f32x4*)(bdn + (size_t)e * 1024 + cl0 + bj * HALF); bv[bj][1] = *(const f32x4*)(bdn + (size_t)e * 1024 + cl0 + bj * HALF + 4); }
        float rwv[2][4];
#pragma unroll
        for (int ai = 0; ai < 2; ++ai)
#pragma unroll
            for (int m = 0; m < 4; ++m) rwv[ai][m] = roww[row0 + ai * HALF + m * 16] * YS8_SCALE;
#pragma unroll
        for (int ai = 0; ai < 2; ++ai)
#pragma unroll
            for (int m = 0; m < 4; ++m) {
                const size_t row = (size_t)(row0 + ai * HALF + m * 16);
                const float rw = rwv[ai][m];
#pragma unroll
                for (int bj = 0; bj < 2; ++bj) if (bj < nbj) {
                    const f32x4 v0 = (acc[ai][bj][m][0] * ds + bv[bj][0]) * rw, v1 = (acc[ai][bj][m][1] * ds + bv[bj][1]) * rw;
                    *(u32x2*)(YS + row * 1024 + cl0 + bj * HALF) = (u32x2){pk4_fp8(v0[0], v0[1], v0[2], v0[3]), pk4_fp8(v1[0], v1[1], v1[2], v1[3])};
                }
            }
    }
};
}

namespace att {
constexpr int QBLK = 32, KVBLK = 64;
constexpr int SHM_V = 16384, SHM_K = 8192;
constexpr int NBUF = 3, OFF_V = 0, OFF_K = NBUF * SHM_V, OFF_WS = NBUF * SHM_V + NBUF * SHM_K;
constexpr float SCALE = 0.125f, THR = 8.f;
#define KSWZ(row, colB) ((row) * 128 + ((colB) ^ (((row) & 7) << 4)))
#define SBAR() __builtin_amdgcn_sched_barrier(0)
__device__ __forceinline__ int crow(int r, int hi) { return (r & 3) + 8 * (r >> 2) + 4 * hi; }

__device__ __forceinline__ void partialSM(f32x16& p0, f32x16& p1, float& m_reg, float& mn, float& alpha) {
    constexpr float C = SCALE * 1.4426950408889634f;
    float pmax = p0[0];
#pragma unroll
    for (int r = 1; r < 16; ++r) pmax = fmaxf(pmax, p0[r]);
#pragma unroll
    for (int r = 0; r < 16; ++r) pmax = fmaxf(pmax, p1[r]);
    { auto rr = __builtin_amdgcn_permlane32_swap(__float_as_uint(pmax), __float_as_uint(pmax), false, false);
      pmax = fmaxf(__uint_as_float(rr[0]), __uint_as_float(rr[1])); }
    if (__builtin_expect(__all(pmax - m_reg <= THR / SCALE), 1)) { mn = m_reg; alpha = 1.f; }
    else { mn = fmaxf(m_reg, pmax); alpha = __builtin_amdgcn_exp2f((m_reg - mn) * C); m_reg = mn; }
    const float mnC = -mn * C;
#pragma unroll
    for (int r = 0; r < 16; ++r) p0[r] = fmaf(p0[r], C, mnC);
#pragma unroll
    for (int r = 0; r < 16; ++r) p1[r] = fmaf(p1[r], C, mnC);
#pragma unroll
    for (int r = 0; r < 16; ++r) p0[r] = __builtin_amdgcn_exp2f(p0[r]);
}
__device__ __forceinline__ void finishSM(f32x16& p0, f32x16& p1, float alpha, float& l_reg, bf16x8& pa0, bf16x8& pa1, bf16x8& pa2, bf16x8& pa3) {
#pragma unroll
    for (int r = 0; r < 16; ++r) p1[r] = __builtin_amdgcn_exp2f(p1[r]);
    float ps = 0;
#pragma unroll
    for (int r = 0; r < 16; ++r) ps += p0[r];
#pragma unroll
    for (int r = 0; r < 16; ++r) ps += p1[r];
    { auto rr = __builtin_amdgcn_permlane32_swap(__float_as_uint(ps), __float_as_uint(ps), false, false);
      ps = __uint_as_float(rr[0]) + __uint_as_float(rr[1]); }
    l_reg = l_reg * alpha + ps;
#define PK4(P, BASE, OUT) do { unsigned a0 = cvtpk(P[BASE + 0], P[BASE + 1]), a1 = cvtpk(P[BASE + 2], P[BASE + 3]);   \
    unsigned b0 = cvtpk(P[BASE + 4], P[BASE + 5]), b1 = cvtpk(P[BASE + 6], P[BASE + 7]);                              \
    auto r0 = __builtin_amdgcn_permlane32_swap(a0, b0, false, false); auto r1 = __builtin_amdgcn_permlane32_swap(a1, b1, false, false); \
    u32x4 w = {r0[0], r1[0], r0[1], r1[1]}; OUT = *reinterpret_cast<bf16x8*>(&w); } while (0)
    PK4(p0, 0, pa0); PK4(p0, 8, pa1); PK4(p1, 0, pa2); PK4(p1, 8, pa3);
#undef PK4
}
__device__ __forceinline__ void qkt(f32x16& p0, f32x16& p1, const char* Ks, const bf16x8* qr, int r32, int hi) {
    p0 = f32x16{}; p1 = f32x16{};
#pragma unroll
    for (int d0 = 0; d0 < 4; ++d0) { const int cb = (d0 * 16 + hi * 8) * 2;
        const bf16x8 b0 = *reinterpret_cast<const bf16x8*>(Ks + KSWZ(r32, cb));
        const bf16x8 b1 = *reinterpret_cast<const bf16x8*>(Ks + KSWZ(32 + r32, cb));
        p0 = __builtin_amdgcn_mfma_f32_32x32x16_bf16(b0, qr[d0], p0, 0, 0, 0);
        p1 = __builtin_amdgcn_mfma_f32_32x32x16_bf16(b1, qr[d0], p1, 0, 0, 0); }
}
__device__ __forceinline__ void qkt_n(f32x16& p0, f32x16& p1, const char* Ks, const bf16x8* qr, const f32x16& negm, int r32, int hi) {
#pragma unroll
    for (int d0 = 0; d0 < 4; ++d0) { const int cb = (d0 * 16 + hi * 8) * 2;
        const bf16x8 b0 = *reinterpret_cast<const bf16x8*>(Ks + KSWZ(r32, cb));
        const bf16x8 b1 = *reinterpret_cast<const bf16x8*>(Ks + KSWZ(32 + r32, cb));
        if (d0 == 0) { p0 = __builtin_amdgcn_mfma_f32_32x32x16_bf16(b0, qr[0], negm, 0, 0, 0); p1 = __builtin_amdgcn_mfma_f32_32x32x16_bf16(b1, qr[0], negm, 0, 0, 0); }
        else { p0 = __builtin_amdgcn_mfma_f32_32x32x16_bf16(b0, qr[d0], p0, 0, 0, 0); p1 = __builtin_amdgcn_mfma_f32_32x32x16_bf16(b1, qr[d0], p1, 0, 0, 0); } }
}
template <bool FIRST> __device__ __forceinline__ void partialSM_n(f32x16& p0, f32x16& p1, float& M, f32x16& negm, float& alpha) {
    float pmax = p0[0];
#pragma unroll
    for (int r = 1; r < 16; ++r) pmax = fmaxf(pmax, p0[r]);
#pragma unroll
    for (int r = 0; r < 16; ++r) pmax = fmaxf(pmax, p1[r]);
    { auto rr = __builtin_amdgcn_permlane32_swap(__float_as_uint(pmax), __float_as_uint(pmax), false, false);
      pmax = fmaxf(__uint_as_float(rr[0]), __uint_as_float(rr[1])); }
    if (!FIRST && __builtin_expect(__all(pmax <= THR * 1.4426950408889634f), 1)) { alpha = 1.f; }
    else { const float d = FIRST ? pmax : fmaxf(pmax, 0.f); alpha = __builtin_amdgcn_exp2f(-d); M += d;
#pragma unroll
        for (int r = 0; r < 16; ++r) { p0[r] -= d; p1[r] -= d; }
        const float nm = -M;
#pragma unroll
        for (int r = 0; r < 16; ++r) negm[r] = nm; }
#pragma unroll
    for (int r = 0; r < 16; ++r) p0[r] = __builtin_amdgcn_exp2f(p0[r]);
}
__device__ __forceinline__ int v_st(int k, int c) { const int kk = (k & ~0xC) | ((k & 4) << 1) | ((k & 8) >> 1); return ((kk >> 3) * 4 + (c >> 5)) * 512 + ((kk & 7) * 32 + (c & 31)) * 2; }
__device__ __forceinline__ int v_rd_base(int lane) { return ((lane & 3) << 3) | (((lane >> 2) & 3) << 6) | (((lane >> 4) & 1) << 5) | (((lane >> 5) & 1) << 8); }
constexpr int v_rd_off(int d0, int ks, int half) { return d0 * 512 + ks * 4096 + half * 2048; }
template <int OFF> __device__ __forceinline__ s16x4 tr_read(int vb) {
    s16x4 r; asm volatile("ds_read_b64_tr_b16 %0, %1 offset:%2" : "=&v"(r) : "v"(vb), "i"(OFF) : "memory"); return r;
}
template <int D0, int KS = 4096, int HS = 2048> __device__ __forceinline__ void pv_one(f32x16& od, int vb, bf16x8 pa0, bf16x8 pa1, bf16x8 pa2, bf16x8 pa3) {
    const s16x4 l0 = tr_read<D0 * 512 + 0 * KS>(vb), h0 = tr_read<D0 * 512 + 0 * KS + HS>(vb), l1 = tr_read<D0 * 512 + 1 * KS>(vb), h1 = tr_read<D0 * 512 + 1 * KS + HS>(vb);
    const s16x4 l2 = tr_read<D0 * 512 + 2 * KS>(vb), h2 = tr_read<D0 * 512 + 2 * KS + HS>(vb), l3 = tr_read<D0 * 512 + 3 * KS>(vb), h3 = tr_read<D0 * 512 + 3 * KS + HS>(vb);
    asm volatile("s_waitcnt lgkmcnt(0)" ::: "memory"); SBAR();
#define PK(L, H) (bf16x8){L[0], L[1], L[2], L[3], H[0], H[1], H[2], H[3]}
    od = __builtin_amdgcn_mfma_f32_32x32x16_bf16(pa0, PK(l0, h0), od, 0, 0, 0);
    od = __builtin_amdgcn_mfma_f32_32x32x16_bf16(pa1, PK(l1, h1), od, 0, 0, 0);
    od = __builtin_amdgcn_mfma_f32_32x32x16_bf16(pa2, PK(l2, h2), od, 0, 0, 0);
    od = __builtin_amdgcn_mfma_f32_32x32x16_bf16(pa3, PK(l3, h3), od, 0, 0, 0);
#undef PK
}
template <int NB> __device__ __forceinline__ void pv_all(f32x16* o, int vb, bf16x8 pa0, bf16x8 pa1, bf16x8 pa2, bf16x8 pa3) {
    pv_one<0>(o[0], vb, pa0, pa1, pa2, pa3); pv_one<1>(o[1], vb, pa0, pa1, pa2, pa3);
    if constexpr (NB == 4) { pv_one<2>(o[2], vb, pa0, pa1, pa2, pa3); pv_one<3>(o[3], vb, pa0, pa1, pa2, pa3); }
}
__device__ __forceinline__ void bandmask(f32x16& p0, f32x16& p1, int kt0, int qw0, int r32, int hi) {
    if ((kt0 + 63 - qw0 <= 128) && (qw0 + 31 - kt0 <= 128)) return;
    const int qi = qw0 + r32;
#pragma unroll
    for (int r = 0; r < 16; ++r) { const int d = kt0 + crow(r, hi) - qi;
        if (d > 128 || d < -128) p0[r] = -INFINITY;
        if (d + 32 > 128 || d + 32 < -128) p1[r] = -INFINITY; }
}

template <int NB, bool WIN>
__device__ __forceinline__ void body(const bf16* __restrict__ Qb, const bf16* __restrict__ Kh, const bf16* __restrict__ Vh, int NT,
                                     int kpos0, int qpos0, float sink_l2, f32x16 (&o)[NB], char* lds, int tid) {
    constexpr int DV = 32 * NB;
    asm volatile("" : "+v"(tid));
    const int wid = tid >> 6, lane = tid & 63, r32 = lane & 31, hi = lane >> 5;
    char* V_lds = lds + OFF_V; char* K_lds = lds + OFF_K;
    float* ws = (float*)(lds + OFF_WS) + wid * 64; float* li_l = ws; float* al_l = ws + 32;
    float m_reg = -1e30f, l_reg = 0; bf16x8 qr[4];
#pragma unroll
    for (int d = 0; d < NB; ++d) o[d] = f32x16{};
    const bf16* Qw = Qb + (long)(wid * QBLK + r32) * 64 + hi * 8;
#pragma unroll
    for (int d0 = 0; d0 < 4; ++d0) qr[d0] = *reinterpret_cast<const bf16x8*>(Qw + d0 * 16);
    const int qw0 = qpos0 + wid * QBLK;
    const int ksr = tid >> 3, ksc = (tid & 7) * 8;
    const int kst = KSWZ(ksr, ksc * 2);
    const int vsr = (NB == 4) ? (tid >> 4) : (tid >> 3), vsc = (NB == 4) ? (tid & 15) * 8 : (tid & 7) * 8;
    const int vst0 = v_st(vsr, vsc), vst1 = v_st(32 + vsr, vsc);
    const int vb0 = (int)(uintptr_t)V_lds + v_rd_base(lane);
    struct { bf16x8 vs0, vs1, ks0; } sr_[1];
    unsigned vo0 = (unsigned)(vsr * DV + vsc) * 2u, ko0 = (unsigned)(ksr * 64 + ksc) * 2u;
    asm volatile("" : "+v"(vo0), "+v"(ko0));
#define SLOAD(i, k0) do { const char* vt_ = (const char*)Vh + (size_t)(k0) * (DV * 2); const char* kt_ = (const char*)Kh + (size_t)(k0) * 128; \
    sr_[i].vs0 = *reinterpret_cast<const bf16x8*>(vt_ + vo0); \
    if constexpr (NB == 4) sr_[i].vs1 = *reinterpret_cast<const bf16x8*>(vt_ + 32 * DV * 2 + vo0); \
    sr_[i].ks0 = *reinterpret_cast<const bf16x8*>(kt_ + ko0); } while (0)
#define SWRITE(b, i) do { *(bf16x8*)(V_lds + (b) * SHM_V + vst0) = sr_[i].vs0; \
    if constexpr (NB == 4) *(bf16x8*)(V_lds + (b) * SHM_V + vst1) = sr_[i].vs1; \
    *(bf16x8*)(K_lds + (b) * SHM_K + kst) = sr_[i].ks0; } while (0)
#define SWAIT() do { if constexpr (NB == 4) asm volatile("s_waitcnt vmcnt(3)" ::: "memory"); else asm volatile("s_waitcnt vmcnt(2)" ::: "memory"); } while (0)
#define RESC(a) do { if (__any((a) < 1.f)) { if (hi == 0) al_l[r32] = (a); asm volatile("s_waitcnt lgkmcnt(0)" ::: "memory"); \
    _Pragma("unroll") for (int d = 0; d < NB; ++d) _Pragma("unroll") for (int r = 0; r < 16; ++r) o[d][r] *= al_l[crow(r, hi)]; } } while (0)
#define MASK(P0, P1, t) do { if constexpr (WIN) bandmask(P0, P1, kpos0 + (t) * KVBLK, qw0, r32, hi); } while (0)
    static_assert(!WIN, "the dense body works on pre-scaled Q in the log2 domain; the windowed path is win_unit");
    f32x16 pA0, pA1, pB0, pB1; float alA, alB; bf16x8 pa0, pa1, pa2, pa3;
    f32x16 negm = f32x16{}; m_reg = 0.f;
    constexpr int SE = 0;
    __syncthreads();
    SLOAD(SE, 0); asm volatile("s_waitcnt vmcnt(0)" ::: "memory"); SWRITE(0, SE); __syncthreads();
    qkt_n(pA0, pA1, K_lds, qr, negm, r32, hi); partialSM_n<true>(pA0, pA1, m_reg, negm, alA);
    SLOAD(SE, KVBLK); asm volatile("s_waitcnt vmcnt(0)" ::: "memory"); SWRITE(1, SE); if (2 < NT) SLOAD(SE, 2 * KVBLK);
    int bp = 0, bc = 1, bn = 2;
#define ROT3() do { const int t_ = bp; bp = bc; bc = bn; bn = t_; } while (0)
    for (int j = 1; j + 1 < NT; j += 2) {
        __syncthreads();
        SWRITE(bn, SE);
        SBAR(); qkt_n(pB0, pB1, K_lds + bc * SHM_K, qr, negm, r32, hi);
        finishSM(pA0, pA1, alA, l_reg, pa0, pa1, pa2, pa3); SBAR();
        SLOAD(SE, (j + 2) * KVBLK); SBAR();
        pv_all<NB>(o, vb0 + bp * SHM_V, pa0, pa1, pa2, pa3); partialSM_n<false>(pB0, pB1, m_reg, negm, alB);
        RESC(alB);
        ROT3();
        __syncthreads();
        SWRITE(bn, SE);
        SBAR(); qkt_n(pA0, pA1, K_lds + bc * SHM_K, qr, negm, r32, hi);
        finishSM(pB0, pB1, alB, l_reg, pa0, pa1, pa2, pa3); SBAR();
        if (j + 3 < NT) SLOAD(SE, (j + 3) * KVBLK); SBAR();
        pv_all<NB>(o, vb0 + bp * SHM_V, pa0, pa1, pa2, pa3); partialSM_n<false>(pA0, pA1, m_reg, negm, alA);
        RESC(alA);
        ROT3();
    }
    __syncthreads();
    SBAR(); qkt_n(pB0, pB1, K_lds + bc * SHM_K, qr, negm, r32, hi);
    finishSM(pA0, pA1, alA, l_reg, pa0, pa1, pa2, pa3); SBAR();
    pv_all<NB>(o, vb0 + bp * SHM_V, pa0, pa1, pa2, pa3); partialSM_n<false>(pB0, pB1, m_reg, negm, alB);
    RESC(alB);
    finishSM(pB0, pB1, alB, l_reg, pa0, pa1, pa2, pa3); SBAR();
    pv_all<NB>(o, vb0 + bc * SHM_V, pa0, pa1, pa2, pa3);
#undef ROT3
    if (hi == 0) li_l[r32] = l_reg; asm volatile("s_waitcnt lgkmcnt(0)" ::: "memory");
#pragma unroll
    for (int r = 0; r < 16; ++r) { const float rl = __builtin_amdgcn_rcpf(li_l[crow(r, hi)]);
#pragma unroll
        for (int d = 0; d < NB; ++d) o[d][r] *= rl; }
#undef SLOAD
#undef SWRITE
#undef SWAIT
#undef RESC
#undef MASK
}

constexpr int K8_TILE = 4096, V8_TILE = 8192, BUF8 = K8_TILE + V8_TILE, STG8 = 2 * BUF8, OFF8_WS = 3 * STG8;
constexpr float SH8 = 6.f, LIM8 = 8.f;
__device__ __forceinline__ int sw8(int r, int c) { return r * 64 + ((c ^ ((r >> 2) & 3)) << 4); }
typedef int i32x4a __attribute__((ext_vector_type(4))); typedef int i32x8a __attribute__((ext_vector_type(8)));
__device__ __forceinline__ i32x8a frag8(const char* tile, int row, int hi) {
    const i32x4a x = *reinterpret_cast<const i32x4a*>(tile + sw8(row, 2 * hi)), y = *reinterpret_cast<const i32x4a*>(tile + sw8(row, 2 * hi + 1));
    return (i32x8a){x[0], x[1], x[2], x[3], y[0], y[1], y[2], y[3]};
}
template <bool FIRST> __device__ __forceinline__ void partialSM8(f32x16& p0, f32x16& p1, float& R, f32x16& negm, float& alpha) {
    float pmax = p0[0];
#pragma unroll
    for (int r = 1; r < 16; ++r) pmax = fmaxf(pmax, p0[r]);
#pragma unroll
    for (int r = 0; r < 16; ++r) pmax = fmaxf(pmax, p1[r]);
    { auto rr = __builtin_amdgcn_permlane32_swap(__float_as_uint(pmax), __float_as_uint(pmax), false, false);
      pmax = fmaxf(__uint_as_float(rr[0]), __uint_as_float(rr[1])); }
    if (!FIRST && __builtin_expect(__all(pmax <= LIM8), 1)) { alpha = 1.f; }
    else { const float d = FIRST ? (pmax - SH8) : fmaxf(pmax - SH8, 0.f); alpha = __builtin_amdgcn_exp2f(-d); R += d;
#pragma unroll
        for (int r = 0; r < 16; ++r) { p0[r] -= d; p1[r] -= d; }
        const float nm = -R;
#pragma unroll
        for (int r = 0; r < 16; ++r) negm[r] = nm; }
#pragma unroll
    for (int r = 0; r < 16; ++r) p0[r] = __builtin_amdgcn_exp2f(p0[r]);
}
__device__ __forceinline__ void finishSM8(f32x16& p0, f32x16& p1, i32x8a& pa) {
#pragma unroll
    for (int r = 0; r < 16; ++r) p1[r] = __builtin_amdgcn_exp2f(p1[r]);
#pragma unroll
    for (int i = 0; i < 4; ++i) {
        int w = __builtin_amdgcn_cvt_pk_fp8_f32(p0[4 * i], p0[4 * i + 1], pa[i], false); pa[i] = __builtin_amdgcn_cvt_pk_fp8_f32(p0[4 * i + 2], p0[4 * i + 3], w, true);
        w = __builtin_amdgcn_cvt_pk_fp8_f32(p1[4 * i], p1[4 * i + 1], pa[4 + i], false); pa[4 + i] = __builtin_amdgcn_cvt_pk_fp8_f32(p1[4 * i + 2], p1[4 * i + 3], w, true); }
}
__device__ __forceinline__ float max16(const f32x16& p) {
    float m = fmaxf(p[0], p[1]);
#pragma unroll
    for (int r = 2; r < 16; r += 2) m = fmaxf(fmaxf(m, p[r]), p[r + 1]);
    return m;
}
__device__ __forceinline__ void qkt8(f32x16& p0, f32x16& p1, const char* Kt, const i32x8a& qr, const f32x16& negm, int r32, int hi) {
    const i32x8a k0 = frag8(Kt, r32, hi), k1 = frag8(Kt, 32 + r32, hi);
    const int one = 0x7F7F7F7F, eighth = 0x7C7C7C7C;
    asm volatile("v_mfma_scale_f32_32x32x64_f8f6f4 %0, %1, %2, %3, %4, %5 op_sel_hi:[0,0,0]" : "=&v"(p0) : "v"(k0), "v"(qr), "v"(negm), "v"(one), "v"(eighth));
    asm volatile("v_mfma_scale_f32_32x32x64_f8f6f4 %0, %1, %2, %3, %4, %5 op_sel_hi:[0,0,0]" : "=&v"(p1) : "v"(k1), "v"(qr), "v"(negm), "v"(one), "v"(eighth));
    asm volatile("s_nop 15\n\ts_nop 15\n\ts_nop 7" : "+v"(p0), "+v"(p1));
}
__device__ __forceinline__ void pv8(f32x16 (&o)[4], f32x16& ol, const char* Vt, const i32x8a& pa, int r32, int hi) {
    const int one = 0x7F7F7F7F;
    const int e1 = 0x38383838; const i32x8a ones = (i32x8a){e1, e1, e1, e1, e1, e1, e1, e1};
    asm volatile("s_nop 4" ::: "memory");
    asm volatile("v_mfma_scale_f32_32x32x64_f8f6f4 %0, %1, %2, %0, %3, %3 op_sel_hi:[0,0,0]" : "+v"(ol) : "v"(pa), "v"(ones), "v"(one));
#pragma unroll
    for (int d0 = 0; d0 < 4; ++d0) { const i32x8a vf = frag8(Vt, d0 * 32 + r32, hi);
        asm volatile("v_mfma_scale_f32_32x32x64_f8f6f4 %0, %1, %2, %0, %3, %3 op_sel_hi:[0,0,0]" : "+v"(o[d0]) : "v"(pa), "v"(vf), "v"(one)); }
}
struct CvtJob { const float* wgu; const float* wdn; unsigned char* wgu8; unsigned char* wdn8; int on, wg, qbase; };
constexpr int OFF8_CV = OFF8_WS + 2048, CVT_ITEMS = 24;
__device__ __forceinline__ void body8(const unsigned char* __restrict__ Q8b, const unsigned char* __restrict__ K8h, const unsigned char* __restrict__ VT8h, int NT,
                                      f32x16 (&o)[4], char* lds, int tid, const CvtJob cj) {
    asm volatile("" : "+v"(tid));
    const int wid = tid >> 6, lane = tid & 63, r32 = lane & 31, hi = lane >> 5;
    float* ws = (float*)(lds + OFF8_WS) + wid * 64; float* al_l = ws + 32;
    float R = 0.f; f32x16 negm = f32x16{}, ol = f32x16{};
#pragma unroll
    for (int d = 0; d < 4; ++d) o[d] = f32x16{};
    i32x8a qr;
    { const i32x4a x = *reinterpret_cast<const i32x4a*>(Q8b + (size_t)(wid * QBLK + r32) * 64 + hi * 32), y = *reinterpret_cast<const i32x4a*>(Q8b + (size_t)(wid * QBLK + r32) * 64 + hi * 32 + 16);
      qr = (i32x8a){x[0], x[1], x[2], x[3], y[0], y[1], y[2], y[3]}; }
    const int wid_s = __builtin_amdgcn_readfirstlane(wid);
    unsigned lsrc = (unsigned)((lane >> 2) * 64 + (((lane & 3) ^ ((lane >> 4) & 3)) << 4)); asm volatile("" : "+v"(lsrc));
#define SDMA8(b_, s_) do { _Pragma("unroll") for (int c_ = 0; c_ < 3; ++c_) { const int q_ = wid_s * 3 + c_, t_ = q_ >= 12 ? 1 : 0, r_ = q_ - 12 * t_; \
        const unsigned char* src_ = (r_ < 4) ? K8h + (size_t)(2 * (s_) + t_) * K8_TILE + r_ * 1024 : VT8h + (size_t)(2 * (s_) + t_) * V8_TILE + (r_ - 4) * 1024; \
        __builtin_amdgcn_global_load_lds((const unsigned*)(src_ + lsrc), (LAS unsigned*)(lds + (b_) * STG8 + q_ * 1024), 16, 0, 0); } } while (0)
#define SDMA_WAIT() asm volatile("s_waitcnt vmcnt(0)" ::: "memory")
#define RESC8(a) do { if (__any((a) < 1.f)) { if (hi == 0) al_l[r32] = (a); asm volatile("s_nop 15\n\ts_nop 15\n\ts_nop 15\n\ts_nop 15\n\ts_waitcnt lgkmcnt(0)" : "+v"(o[0]), "+v"(o[1]), "+v"(o[2]), "+v"(o[3]), "+v"(ol) :: "memory"); \
    _Pragma("unroll") for (int r = 0; r < 16; ++r) { const float a_ = al_l[crow(r, hi)]; ol[r] *= a_; _Pragma("unroll") for (int d = 0; d < 4; ++d) o[d][r] *= a_; } } } while (0)
    f32x16 pA0, pA1, pB0, pB1; float alA, alB; i32x8a pa = (i32x8a){0, 0, 0, 0, 0, 0, 0, 0};
    __syncthreads();
    SDMA8(0, 0); SDMA8(1, 1); SDMA_WAIT(); __syncthreads();
    qkt8(pA0, pA1, lds, qr, negm, r32, hi); partialSM8<true>(pA0, pA1, R, negm, alA);
    const int NS = NT >> 1;
    int b0 = 0, b1 = 1, b2 = 2;
#define ROT3() do { const int t_ = b0; b0 = b1; b1 = b2; b2 = t_; } while (0)
    const int mx_one = 0x7F7F7F7F, mx_eighth = 0x7C7C7C7C, e1_ = 0x38383838; const i32x8a ones = (i32x8a){e1_, e1_, e1_, e1_, e1_, e1_, e1_, e1_};
#define QKT_ASM(P, KF) asm volatile("v_mfma_scale_f32_32x32x64_f8f6f4 %0, %1, %2, %3, %4, %5 op_sel_hi:[0,0,0]" : "=&v"(P) : "v"(KF), "v"(qr), "v"(negm), "v"(mx_one), "v"(mx_eighth))
#define PV_ASM(O, VF) asm volatile("v_mfma_scale_f32_32x32x64_f8f6f4 %0, %1, %2, %0, %3, %3 op_sel_hi:[0,0,0]" : "+v"(O) : "v"(pa), "v"(VF), "v"(mx_one))
#define STEP8(PC0, PC1, PN0, PN1, ALN, KT_, VT_, LOADSTMT) do { const char* kt_ = (KT_); const char* vt_ = (VT_); \
    QKT_ASM(PN0, kf0); QKT_ASM(PN1, kf1); SBAR(); \
    LOADSTMT; \
    const i32x8a v0_ = frag8(vt_, r32, hi), v1_ = frag8(vt_, 32 + r32, hi); SBAR(); \
    finishSM8(PC0, PC1, pa); SBAR(); \
    asm volatile("s_nop 7" : "+v"(PN0), "+v"(PN1), "+v"(pa)); \
    PV_ASM(ol, ones); SBAR(); \
    const float m0_ = max16(PN0); SBAR(); \
    PV_ASM(o[0], v0_); const i32x8a v2_ = frag8(vt_, 64 + r32, hi); SBAR(); \
    const float m1_ = max16(PN1); SBAR(); \
    PV_ASM(o[1], v1_); const i32x8a v3_ = frag8(vt_, 96 + r32, hi); SBAR(); \
    float pm_ = fmaxf(m0_, m1_); \
    { auto rr_ = __builtin_amdgcn_permlane32_swap(__float_as_uint(pm_), __float_as_uint(pm_), false, false); pm_ = fmaxf(__uint_as_float(rr_[0]), __uint_as_float(rr_[1])); } SBAR(); \
    PV_ASM(o[2], v2_); SBAR(); PV_ASM(o[3], v3_); kf0 = frag8(kt_, r32, hi); kf1 = frag8(kt_, 32 + r32, hi); SBAR(); \
    if (__builtin_expect(!__all(pm_ <= LIM8), 0)) { const float d_ = fmaxf(pm_ - SH8, 0.f); ALN = __builtin_amdgcn_exp2f(-d_); R += d_; \
        _Pragma("unroll") for (int r = 0; r < 16; ++r) { PN0[r] -= d_; PN1[r] -= d_; } \
        const float nm_ = -R; _Pragma("unroll") for (int r = 0; r < 16; ++r) negm[r] = nm_; \
        RESC8(ALN); } \
    _Pragma("unroll") for (int r = 0; r < 16; ++r) PN0[r] = __builtin_amdgcn_exp2f(PN0[r]); } while (0)
    i32x8a kf0 = frag8(lds + BUF8, r32, hi), kf1 = frag8(lds + BUF8, 32 + r32, hi);
#define CVT_DECODE(t_) const int g_ = (cj.qbase + (t_)) * 2048 + cj.wg; const int e_ = g_ / 3072, r_ = g_ - e_ * 3072; const bool gu_ = r_ < 2048; const int r2_ = gu_ ? r_ : r_ - 2048; \
        const int k0_ = 128 * (gu_ ? (r2_ >> 8) : (r2_ >> 7)), n0_ = 8 * (gu_ ? (r2_ & 255) : (r2_ & 127)), NN_ = gu_ ? 2048 : 1024
    int pend = 0;
    for (int i = 0; i + 1 < NS; ++i) {
        if (pend == 5) asm volatile("s_waitcnt vmcnt(5)" ::: "memory"); else if (pend == 4) asm volatile("s_waitcnt vmcnt(4)" ::: "memory");
        else if (pend == 1) asm volatile("s_waitcnt vmcnt(1)" ::: "memory"); else SDMA_WAIT();
        __syncthreads();
        if (i + 2 < NS) SDMA8(b2, i + 2);
        asm volatile("" ::: "memory");
        pend = 0;
        const int ie_ = i - (wid_s >> 2), tq_ = ie_ >> 1;
        if (cj.on && ie_ >= 0 && (ie_ & 1) == 0) {
            char* ring = lds + OFF8_CV + wid_s * 8192;
            if (tq_ >= 1 && tq_ <= CVT_ITEMS) {
                CVT_DECODE(tq_ - 1);
                unsigned char* dst_ = gu_ ? cj.wgu8 + (size_t)e_ * 2048 * DM : cj.wdn8 + (size_t)e_ * DM * DFF; const float wsc_ = gu_ ? W8_GU_SCALE : W8_DN_SCALE;
                const float* sl = (const float*)(ring + ((tq_ - 1) & 1) * 4096);
                {
                    const float* sp_ = sl + (lane & 7) * 8 + (lane >> 3);
                    u32x4 o_;
                    o_.x = pk4_fp8(sp_[0 * 64] * wsc_, sp_[1 * 64] * wsc_, sp_[2 * 64] * wsc_, sp_[3 * 64] * wsc_); o_.y = pk4_fp8(sp_[4 * 64] * wsc_, sp_[5 * 64] * wsc_, sp_[6 * 64] * wsc_, sp_[7 * 64] * wsc_);
                    o_.z = pk4_fp8(sp_[8 * 64] * wsc_, sp_[9 * 64] * wsc_, sp_[10 * 64] * wsc_, sp_[11 * 64] * wsc_); o_.w = pk4_fp8(sp_[12 * 64] * wsc_, sp_[13 * 64] * wsc_, sp_[14 * 64] * wsc_, sp_[15 * 64] * wsc_);
                    __builtin_nontemporal_store(o_, (u32x4*)(dst_ + (size_t)(n0_ + (lane >> 3)) * 1024 + k0_ + (lane & 7) * 16)); }
                asm volatile("s_waitcnt lgkmcnt(0)" ::: "memory");
                pend += 1;
            }
            if (tq_ < CVT_ITEMS) {
                CVT_DECODE(tq_);
                const float* src_ = gu_ ? cj.wgu + (size_t)e_ * DM * 2048 : cj.wdn + (size_t)e_ * DFF * DM;
                char* slot = ring + (tq_ & 1) * 4096;
#pragma unroll
                for (int j = 0; j < 4; ++j) { const int rp_ = 32 * j + (lane >> 1), k_ = (rp_ & 7) * 16 + (rp_ >> 3);
                    __builtin_amdgcn_global_load_lds((const unsigned*)(src_ + (size_t)(k0_ + k_) * NN_ + n0_ + 4 * (lane & 1)), (LAS unsigned*)(slot + j * 1024), 16, 0, 0); }
                pend += 4;
            }
        }
        SBAR();
        STEP8(pA0, pA1, pB0, pB1, alB, lds + b1 * STG8, lds + b0 * STG8 + K8_TILE, (void)0);
        STEP8(pB0, pB1, pA0, pA1, alA, lds + b1 * STG8 + BUF8, lds + b0 * STG8 + BUF8 + K8_TILE, (void)0);
        ROT3();
    }
#undef STEP8
#undef QKT_ASM
#undef PV_ASM
#undef CVT_DECODE
    SBAR(); qkt8(pB0, pB1, lds + b0 * STG8 + BUF8, qr, negm, r32, hi);
    finishSM8(pA0, pA1, pa); SBAR();
    pv8(o, ol, lds + b0 * STG8 + K8_TILE, pa, r32, hi); partialSM8<false>(pB0, pB1, R, negm, alB);
    RESC8(alB);
    finishSM8(pB0, pB1, pa); SBAR();
    pv8(o, ol, lds + b0 * STG8 + BUF8 + K8_TILE, pa, r32, hi);
    asm volatile("s_nop 15\n\ts_nop 15\n\ts_nop 15\n\ts_nop 15" : "+v"(o[0]), "+v"(o[1]), "+v"(o[2]), "+v"(o[3]), "+v"(ol));
#undef ROT3
#undef SDMA8
#undef SDMA_WAIT
#undef RESC8
#pragma unroll
    for (int r = 0; r < 16; ++r) { const float rl = __builtin_amdgcn_rcpf(ol[r]);
#pragma unroll
        for (int d = 0; d < 4; ++d) o[d][r] *= rl; }
}

__device__ __forceinline__ int v_st64(int k, int c) { const int kk = (k & ~0xC) | ((k & 4) << 1) | ((k & 8) >> 1); return ((kk >> 3) * 2 + (c >> 5)) * 512 + ((kk & 7) * 32 + (c & 31)) * 2; }
constexpr int WIN_K = 0, WIN_V = 65536, WIN_WS = 131072;
#define WIN_LOAD(WKK, WVV, Kh_, Vh_, NT_, tid_) do { unsigned go_ = (unsigned)(((tid_) >> 3) * 64 + ((tid_) & 7) * 8) * 2u; asm volatile("" : "+v"(go_)); \
    _Pragma("unroll") for (int t_ = 0; t_ < 8; ++t_) { WKK[t_] = *reinterpret_cast<const bf16x8*>((const char*)(Kh_) + (size_t)t_ * 8192 + go_); \
        WVV[t_] = *reinterpret_cast<const bf16x8*>((const char*)(Vh_) + (size_t)t_ * 8192 + go_); } } while (0)
#define WIN_STAGE(WKK, WVV, NT_, lds_, tid_) do { const int ksr_ = (tid_) >> 3, ksc_ = ((tid_) & 7) * 8; const int kst_ = KSWZ(ksr_, ksc_ * 2), vst_ = att::v_st64(ksr_, ksc_); \
    __syncthreads(); \
    _Pragma("unroll") for (int t_ = 0; t_ < 8; ++t_) { *(bf16x8*)((lds_) + att::WIN_K + t_ * 8192 + kst_) = WKK[t_]; *(bf16x8*)((lds_) + att::WIN_V + t_ * 8192 + vst_) = WVV[t_]; } \
    __syncthreads(); } while (0)
__device__ __forceinline__ void win_compute(const bf16* __restrict__ Qb, int NT, int kpos0, int qpos0, float sink_l2, f32x16 (&o)[2], char* lds, int tid) {
    const int wid = tid >> 6, lane = tid & 63, r32 = lane & 31, hi = lane >> 5;
    float* ws = (float*)(lds + WIN_WS) + wid * 64; float* li_l = ws; float* al_l = ws + 32;
    bf16x8 qr[4];
    const bf16* Qw = Qb + (long)(wid * QBLK + r32) * 64 + hi * 8;
#pragma unroll
    for (int d0 = 0; d0 < 4; ++d0) qr[d0] = *reinterpret_cast<const bf16x8*>(Qw + d0 * 16);
    const int qw0 = qpos0 + wid * QBLK;
    int t_lo = (qw0 - 128 - kpos0) >> 6; if (t_lo < 0) t_lo = 0;
    int t_hi = (qw0 + 31 + 128 - kpos0) >> 6; if (t_hi > NT - 1) t_hi = NT - 1;
    float m_reg = -1e30f, l_reg = 0.f; o[0] = f32x16{}; o[1] = f32x16{};
    const int vb0 = (int)(uintptr_t)(lds + WIN_V) + v_rd_base(lane);
    for (int t = t_lo; t <= t_hi; ++t) {
        f32x16 p0, p1; float mn, al; bf16x8 pa0, pa1, pa2, pa3;
        qkt(p0, p1, lds + WIN_K + t * 8192, qr, r32, hi);
        bandmask(p0, p1, kpos0 + t * KVBLK, qw0, r32, hi);
        partialSM(p0, p1, m_reg, mn, al);
        if (__any(al < 1.f)) { if (hi == 0) al_l[r32] = al; asm volatile("s_waitcnt lgkmcnt(0)" ::: "memory");
#pragma unroll
            for (int d = 0; d < 2; ++d)
#pragma unroll
                for (int r = 0; r < 16; ++r) o[d][r] *= al_l[crow(r, hi)]; }
        finishSM(p0, p1, al, l_reg, pa0, pa1, pa2, pa3);
        const int vb = vb0 + t * 8192;
        pv_one<0, 2048, 1024>(o[0], vb, pa0, pa1, pa2, pa3); pv_one<1, 2048, 1024>(o[1], vb, pa0, pa1, pa2, pa3);
    }
    l_reg += __builtin_amdgcn_exp2f(sink_l2 - m_reg * (SCALE * 1.4426950408889634f));
    if (hi == 0) li_l[r32] = l_reg; asm volatile("s_waitcnt lgkmcnt(0)" ::: "memory");
#pragma unroll
    for (int r = 0; r < 16; ++r) { const float rl = __builtin_amdgcn_rcpf(li_l[crow(r, hi)]);
        o[0][r] *= rl; o[1][r] *= rl; }
}
}

#define XB_TMO      128
#define XB_XCNT(j)  (256  + 64 * (j))
#define XB_XSUB(j)  (1280 + 64 * (j))
#define XB_XGEN(j)  (2304 + 64 * (j))
#define XB_TOP      3328
#define XB_TOPGEN   3392
#define XCD_BAR_WORDS 3456
#define XB_SPIN_CAP (1u << 22)
__device__ __forceinline__ unsigned xb_ld(unsigned* p)              { return __hip_atomic_load(p, __ATOMIC_RELAXED, __HIP_MEMORY_SCOPE_AGENT); }
__device__ __forceinline__ unsigned xb_add(unsigned* p, unsigned v) { return __hip_atomic_fetch_add(p, v, __ATOMIC_RELAXED, __HIP_MEMORY_SCOPE_AGENT); }
__device__ __forceinline__ unsigned xb_xcc_id() { return (unsigned)__builtin_amdgcn_s_getreg((3 << 11) | 20) & 0xFu; }
#define XB_SPIN(cond, bar) do { unsigned _sp = 0; while (cond) { __builtin_amdgcn_s_sleep(1); \
    if ((++_sp & 255u) == 0u) { if (xb_ld(&(bar)[XB_TMO])) break; if (_sp > XB_SPIN_CAP) { atomicAdd(&(bar)[XB_TMO], 1u); break; } } } } while (0)
struct XcdBarrier { unsigned* bar; unsigned x; volatile LAS unsigned* st; };
__device__ __forceinline__ XcdBarrier xcd_barrier_post(unsigned* bar, volatile LAS unsigned* st) {
    XcdBarrier b; b.bar = bar; b.x = xb_xcc_id(); b.st = st;
    if (threadIdx.x == 0) (void)xb_add(&bar[XB_XCNT(b.x)], 1u);
    return b;
}
__device__ __forceinline__ void xcd_barrier_complete(unsigned* bar, unsigned x, unsigned& nloc, unsigned& nx) {
    const unsigned G = gridDim.x * gridDim.y * gridDim.z;
    unsigned sum, cnt, mine, sp = 0u;
    for (;;) {
        sum = 0u; cnt = 0u; mine = 0u;
#pragma unroll
        for (unsigned j = 0; j < 16; ++j) { const unsigned c = xb_ld(&bar[XB_XCNT(j)]); sum += c; cnt += (c > 0u) ? 1u : 0u; mine = (j == x) ? c : mine; }
        if (sum == G) break;
        __builtin_amdgcn_s_sleep(1);
        if ((++sp & 255u) == 0u) { if (xb_ld(&bar[XB_TMO])) break; if (sp > XB_SPIN_CAP) { atomicAdd(&bar[XB_TMO], 1u); break; } }
    }
    nloc = mine > 0u ? mine : 1u; nx = cnt > 0u ? cnt : 1u;
}
__device__ __forceinline__ void xcd_barrier(unsigned* bar_in, volatile LAS unsigned* st) {
    asm volatile("s_waitcnt vmcnt(0)" ::: "memory");
    __syncthreads();
    if (threadIdx.x == 0) {
        GAS unsigned* barg_ = (GAS unsigned*)bar_in; asm volatile("" : "+s"(barg_)); unsigned* bar = (unsigned*)barg_;
        const unsigned bx_ = xb_xcc_id();
        __builtin_amdgcn_s_waitcnt(0);
        unsigned nloc = st[0], nx = st[1];
        if (nloc == 0u) { xcd_barrier_complete(bar, bx_, nloc, nx); st[0] = nloc; st[1] = nx; }
        const unsigned old = xb_add(&bar[XB_XSUB(bx_)], 1u);
        const unsigned gen = old / nloc;
        if (old + 1u == (gen + 1u) * nloc) {
            __builtin_amdgcn_fence(__ATOMIC_RELEASE, "agent");
            asm volatile("s_waitcnt vmcnt(0)" ::: "memory");
            const unsigned og = xb_add(&bar[XB_TOP], 1u);
            const unsigned tg = og / nx;
            if (og + 1u == (tg + 1u) * nx) xb_add(&bar[XB_TOPGEN], 1u);
            else XB_SPIN(xb_ld(&bar[XB_TOPGEN]) == tg, bar);
            __builtin_amdgcn_fence(__ATOMIC_ACQUIRE, "agent");
            xb_add(&bar[XB_XGEN(bx_)], 1u);
            asm volatile("s_waitcnt vmcnt(0)" ::: "memory");
        } else {
            XB_SPIN(xb_ld(&bar[XB_XGEN(bx_)]) == gen, bar);
            __builtin_amdgcn_fence(__ATOMIC_ACQUIRE, "agent");
            asm volatile("s_waitcnt vmcnt(0)" ::: "memory");
        }
    }
    __syncthreads();
}

struct Args {
    const float* in[28]; float* out; unsigned char* ws;
    float lam_init[4];
    int lay_lo, lay_hi, ph_lo, ph_hi;
    int single, pad;
};
enum { I_X = 0, I_WIN, I_LAMBDA, I_SUBLN, I_WPA, I_CONVW, I_CONVB, I_MLWQ, I_MLWK, I_MLWV, I_MLWG, I_MLBG, I_MLNORM, I_MLSKIP, I_WPB, I_SINKS, I_WPC, I_WOUT,
       I_LN1G, I_LN1B, I_RW, I_RB, I_WGU, I_BGU, I_WDN, I_BDN, I_LN2G, I_LN2B };

__device__ __forceinline__ void transpose_item(const float* W, int K, int N, bf16* WT, int k0, int n0, int c0, LAS float* scr, int lane) {
#pragma unroll 8
    for (int i = 0; i < 32; ++i) { const int kk = 2 * i + (lane >> 5); scr[kk * 33 + (lane & 31)] = W[(size_t)(k0 + kk) * N + c0 + (lane & 31)]; }
    LDS_WAIT(); asm volatile("" ::: "memory");
    const int c = lane & 7;
#pragma unroll
    for (int j = 0; j < 4; ++j) { const int n = (lane >> 3) + 8 * j; const LAS float* s = scr + (8 * c) * 33 + n;
        u32x4 o; o.x = cvtpk(s[0 * 33], s[1 * 33]); o.y = cvtpk(s[2 * 33], s[3 * 33]); o.z = cvtpk(s[4 * 33], s[5 * 33]); o.w = cvtpk(s[6 * 33], s[7 * 33]);
        *(u32x4*)(WT + (size_t)(n0 + n) * K + k0 + 8 * c) = o; }
    LDS_WAIT(); asm volatile("" ::: "memory");
}
__device__ __forceinline__ int inproj_src_col32(int n0) {
    const int tile = n0 >> 8, nt = n0 & 255;
    if (tile <= 3 || tile == 10 || tile == 11) { const int half = nt >> 7, hd = (nt & 127) >> 5; return tile * 256 + hd * 64 + half * 32; }
    if (tile == 12) { const int half = nt >> 7, q = nt & 127; if (q < 64) return WA_K_COL + (q >> 5) * 64 + half * 32; return WA_V_COL + half * 64 + (q - 64); }
    return n0;
}
__device__ __forceinline__ void sincos_acc(float ang, float& sn, float& cs) {
    const double x = (double)ang;
    const double kq = rint(x * 0.63661977236758134308);
    const double r = fma(-kq, 1.57079632679489661923, x);
    const float rf = (float)r, z = rf * rf;
    const float sp = rf + rf * z * (-1.6666654611e-1f + z * (8.3321608736e-3f + z * (-1.9515295891e-4f)));
    const float cp = 1.0f - 0.5f * z + z * z * (4.166664568298827e-2f + z * (-1.388731625493765e-3f + z * 2.443315711809948e-5f));
    const int q = ((int)kq) & 3;
    sn = (q == 0) ? sp : (q == 1) ? cp : (q == 2) ? -sp : -cp;
    cs = (q == 0) ? cp : (q == 1) ? -sp : (q == 2) ? -cp : sp;
}

constexpr int LDT = 136;
constexpr int TILE_B = 128 * LDT * 2;
__device__ __forceinline__ void wave_mm(f32x4 (&acc)[8], const LAS bf16* A, const LAS bf16* Bt, int lane) {
    const int fr = lane & 15, fq = lane >> 4;
#pragma unroll
    for (int j = 0; j < 8; ++j) acc[j] = (f32x4){0.f, 0.f, 0.f, 0.f};
#pragma unroll
    for (int k0 = 0; k0 < 128; k0 += 32) {
        const bf16x8 a = *(const LAS bf16x8*)(A + fr * LDT + k0 + fq * 8);
#pragma unroll
        for (int j = 0; j < 8; ++j) { const bf16x8 b = *(const LAS bf16x8*)(Bt + (j * 16 + fr) * LDT + k0 + fq * 8);
            acc[j] = __builtin_amdgcn_mfma_f32_16x16x32_bf16(a, b, acc[j], 0, 0, 0); }
    }
}
__device__ __forceinline__ void stage_rows(LAS bf16* dst, const bf16* src, int gs, int tid) {
#pragma unroll
    for (int i = 0; i < 4; ++i) { const int q = tid + 512 * i, r = q >> 4, c = (q & 15) * 8;
        *(LAS u32x4*)(dst + r * LDT + c) = *(const u32x4*)(src + (size_t)r * gs + c); }
}
template <bool SCALED> __device__ __forceinline__ void stage_tr(LAS bf16* dst, const bf16* src, int gs, const LAS float* rscale, int tid) {
#pragma unroll
    for (int i = 0; i < 4; ++i) { const int q = tid + 512 * i, r = q & 127, c = (q >> 7) * 8;
        const u32x4 w = *(const u32x4*)(src + (size_t)r * gs + c);
        const unsigned ww[4] = {w.x, w.y, w.z, w.w};
        const float sc = SCALED ? rscale[r] : 1.f;
#pragma unroll
        for (int j = 0; j < 4; ++j) {
            if (SCALED) { dst[(c + 2 * j) * LDT + r] = tobf1(bflo(ww[j]) * sc); dst[(c + 2 * j + 1) * LDT + r] = tobf1(bfhi(ww[j]) * sc); }
            else { dst[(c + 2 * j) * LDT + r] = (bf16)(ww[j] & 0xffffu); dst[(c + 2 * j + 1) * LDT + r] = (bf16)(ww[j] >> 16); } }
    }
}
__device__ __forceinline__ float logsigmoidf_(float x) { return fminf(x, 0.f) - log1pf(__expf(-fabsf(x))); }
template <bool WITH_MAX> __device__ __forceinline__ void scan_dir(const LAS float* ls, const LAS float* ig, LAS float* bcum, LAS float* pmx, int dir, int lane) {
    const int n0 = dir ? 127 - 2 * lane : 2 * lane, n1 = dir ? 126 - 2 * lane : 2 * lane + 1;
    const float x0 = ls[n0], x1 = ls[n1], s = x0 + x1; float inc = s;
#pragma unroll
    for (int off = 1; off < 64; off <<= 1) { const float t = shup(inc, off, lane); if (lane >= off) inc += t; }
    const float ex = inc - s, b0 = ex + x0, b1 = b0 + x1;
    bcum[n0] = b0; bcum[n1] = b1;
    if (WITH_MAX) {
        const float d0 = ig[n0] - b0, d1 = ig[n1] - b1; float minc = fmaxf(d0, d1);
#pragma unroll
        for (int off = 1; off < 64; off <<= 1) { const float t = shup(minc, off, lane); if (lane >= off) minc = fmaxf(minc, t); }
        float mex = shup(minc, 1, lane); if (lane == 0) mex = -INFINITY;
        pmx[n0] = fmaxf(mex, d0); pmx[n1] = fmaxf(fmaxf(mex, d0), d1);
    }
}

enum { PH_INPROJ = 1, PH_MLQKV, PH_MLGATES, PH_MLLOC, PH_MLSCAN, PH_MLOUT, PH_DIFF, PH_WIN, PH_MERGE, PH_OUT, PH_LN1, PH_SORT, PH_GU, PH_DOWN, PH_LN2, PH_END };

__global__ void __launch_bounds__(NTHR, 2) mega(Args args) {
    extern __shared__ __attribute__((aligned(16))) unsigned char lds_raw[];
    LAS unsigned char* lds = (LAS unsigned char*)lds_raw;
    volatile LAS unsigned* CTLW = (volatile LAS unsigned*)(lds + PH_LDS);
    const int tid0 = threadIdx.x;
    const int wave_s = __builtin_amdgcn_readfirstlane(tid0 >> 6);
    const int G = gridDim.x, bx = blockIdx.x;
#define PH_LOCALS unsigned lz_ = 0u; asm volatile("" : "+v"(lz_)); int tid = wave_s * 64 + (int)__builtin_amdgcn_mbcnt_hi(~0u, __builtin_amdgcn_mbcnt_lo(~0u, lz_)); asm volatile("" : "+v"(tid)); GAS unsigned char* wsg_ = (GAS unsigned char*)args.ws; asm volatile("" : "+s"(wsg_)); unsigned char* ws = (unsigned char*)wsg_; const int lane = tid & 63; const int wave = __builtin_amdgcn_readfirstlane(tid >> 6); \
    const int gw = vcu * NWAVES + wave, NGW = G * NWAVES, gt = vcu * NTHR + tid, NGT = G * NTHR; (void)lane; (void)gw; (void)NGW; (void)gt; (void)NGT;
    const int vcu = (bx % 8) * (G / 8) + bx / 8;
    for (int u = tid0; u < 64; u += NTHR) CTLW[u] = 0u;
    __syncthreads();
    if (args.single) (void)xcd_barrier_post((unsigned*)(args.ws + OFF_CTL) + 4096, CTLW + 8);
#define SEAM() do { if (args.single) xcd_barrier((unsigned*)(args.ws + OFF_CTL) + 4096, CTLW + 8); } while (0)

#define WIN_T ((bf16*)((bf16*)(ws + OFF_WIN)))
#define WP_T ((bf16*)((bf16*)(ws + OFF_WP)))
#define WOUT_T ((bf16*)((bf16*)(ws + OFF_WOUT)))
#define WGU_T ((bf16*)((bf16*)(ws + OFF_WGU)))
#define WDN_T ((bf16*)((bf16*)(ws + OFF_WDN)))
#define WML_T ((bf16*)((bf16*)(ws + OFF_WML)))
#define ROPE ((f32x2*)((f32x2*)(ws + OFF_ROPE)))
#define XB ((bf16*)((bf16*)(ws + OFF_XB)))
#define XF ((float*)((float*)(ws + OFF_XF)))
#define ZB ((bf16*)(ws + OFF_ZB))
#define X1 ((float*)(ws + OFF_X1))
#define QA ((bf16*)((bf16*)(ws + OFF_QA)))
#define KA ((bf16*)((bf16*)(ws + OFF_KA)))
#define VA ((bf16*)((bf16*)(ws + OFF_VA)))
#define MLX ((bf16*)((bf16*)(ws + OFF_MLX)))
#define MLO ((bf16*)((bf16*)(ws + OFF_MLO)))
#define XC ((bf16*)((bf16*)(ws + OFF_XC)))
#define WQb ((bf16*)((bf16*)(ws + OFF_WQ)))
#define WKb ((bf16*)((bf16*)(ws + OFF_WK)))
#define WVb ((bf16*)((bf16*)(ws + OFF_WV)))
#define GT ((bf16*)((bf16*)(ws + OFF_GT)))
#define YA ((bf16*)((bf16*)(ws + OFF_Y3)))
#define YB ((bf16*)(YA + (size_t)TOK * 512))
#define YC ((bf16*)(YB + (size_t)TOK * 512))
#define MF ((float*)((float*)(ws + OFF_MF)))
#define MB ((bf16*)((bf16*)(ws + OFF_MB)))
#define MQ ((bf16*)((bf16*)(ws + OFF_MQ)))
#define MK ((bf16*)(MQ + (size_t)TOK * 512))
#define MV ((bf16*)(MK + (size_t)TOK * 512))
#define G4 ((float*)((float*)(ws + OFF_G4)))
#define GATE4(k_) ((GP[((((size_t)0 * 4 + (k_)) * BATCH + b) * 4 + h) * SEQ + s0 + gt_] + GP[((((size_t)1 * 4 + (k_)) * BATCH + b) * 4 + h) * SEQ + s0 + gt_]) + (GP[((((size_t)2 * 4 + (k_)) * BATCH + b) * 4 + h) * SEQ + s0 + gt_] + GP[((((size_t)3 * 4 + (k_)) * BATCH + b) * 4 + h) * SEQ + s0 + gt_]))
#define GP ((float*)(ws + OFF_WGU + 320 * MiB))
#define CLOC ((bf16*)(ws + OFF_CLOC))
#define CPT ((bf16*)((bf16*)(ws + OFF_CPT)))
#define NLOC ((float*)((float*)(ws + OFF_NLOC)))
#define NPREV ((float*)((float*)(ws + OFF_NPREV)))
#define MLOC ((float*)((float*)(ws + OFF_MLOC)))
#define GCH ((float*)((float*)(ws + OFF_GCH)))
#define MPREV ((float*)((float*)(ws + OFF_MPREV)))
#define STASH ((float*)((float*)(ws + OFF_STASH)))
#define BLKCNT ((int*)((int*)(ws + OFF_BLKCNT)))
#define TILEE ((int*)((int*)(ws + OFF_TILEE)))
#define ROWW ((float*)((float*)(ws + OFF_ROWW)))
#define TOKE ((int*)((int*)(ws + OFF_TOKE)))
#define TOKW ((float*)((float*)(ws + OFF_TOKW)))
#define TOKLP ((int*)((int*)(ws + OFF_TOKLP)))
#define TOKROW ((int*)((int*)(ws + OFF_TOKROW)))
#define XG ((bf16*)((bf16*)(ws + OFF_XG)))
#define ROWTOK ((int*)(ws + OFF_ROWTOK))
#define XB8 ((unsigned char*)(ws + OFF_XB8))
#define WGU8 ((unsigned char*)(ws + OFF_WGU))
#define WIN8 ((unsigned char*)(ws + OFF_WGU + 256 * MiB))
#define XB8I ((unsigned char*)(ws + OFF_WGU + 288 * MiB))
#define WDN8 ((unsigned char*)(ws + OFF_WDN))
#define ACT8 ((unsigned char*)(ws + OFF_ACT))
#define ACT ((bf16*)((bf16*)(ws + OFF_ACT)))
#define YS ((bf16*)((bf16*)(ws + OFF_YS)))
    for (int rep_ = 0, nrep_ = (((PHASE_MASK & 1ull) && args.lay_lo < 0) ? (int)(1 + (REPEAT_MASK & 1ull)) : 0); rep_ < nrep_; ++rep_) {
        PH_LOCALS
        LAS float* scr = (LAS float*)(lds + wave * 16896);
        constexpr int I_IN = 8 * 200, I_P = 4 * 32, I_O = 8 * 32, I_GU = 8 * 64, I_DN = 8 * 32, I_ML = 1 * 4;
        constexpr int N0 = DEPTH * I_IN, N1 = N0 + 3 * DEPTH * I_P, N2 = N1 + DEPTH * I_O, N3 = N2, N4 = N3,     N5 = N4 + 3 * 16 * I_ML;
#define TR_DECODE(it_, SRC, NN, DST, KK, K0, N0_, C0, WSC) do { const int it__ = (it_); WSC = 0.f; \
            if (it__ < N0) { const int l_ = it__ / I_IN, r_ = it__ % I_IN, kb = r_ / 200, nb = r_ % 200; \
                SRC = args.in[I_WIN] + (size_t)l_ * DM * DIN; NN = DIN; DST = WIN_T + (size_t)l_ * DIN * DM; KK = DM; K0 = 128 * kb; N0_ = 32 * nb; C0 = inproj_src_col32(32 * nb); \
                { DST = (bf16*)(WIN8 + (size_t)l_ * 6400 * DM); WSC = W8_IN_SCALE; } } \
            else if (it__ < N1) { const int q = it__ - N0, br = q / (DEPTH * I_P), r2 = q % (DEPTH * I_P), l_ = r2 / I_P, r_ = r2 % I_P, kb = r_ / 32, nb = r_ % 32; \
                SRC = (br == 0 ? args.in[I_WPA] : br == 1 ? args.in[I_WPB] : args.in[I_WPC]) + (size_t)l_ * 512 * DM; NN = DM; DST = WP_T + ((size_t)l_ * 3 + br) * DM * 512; KK = 512; K0 = 128 * kb; N0_ = 32 * nb; C0 = 32 * nb; } \
            else if (it__ < N2) { const int q = it__ - N1, l_ = q / I_O, r_ = q % I_O, kb = r_ / 32, nb = r_ % 32; \
                SRC = args.in[I_WOUT] + (size_t)l_ * DM * DM; NN = DM; DST = WOUT_T + (size_t)l_ * DM * DM; KK = DM; K0 = 128 * kb; N0_ = 32 * nb; C0 = 32 * nb; } \
            else if (it__ < N4) { const int q0_ = it__ - N2; constexpr int PER_L = NEXP * (I_GU + I_DN); const int ql = q0_ % PER_L, l_ = 0;     \
                if (ql < NEXP * I_GU) { const int mt = l_ * NEXP + ql / I_GU, r_ = ql % I_GU, kb = r_ / 64, nb = r_ % 64; \
                    SRC = args.in[I_WGU] + (size_t)mt * DM * 2048; NN = 2048; DST = (bf16*)(WGU8 + (size_t)mt * 2048 * DM); KK = DM; K0 = 128 * kb; N0_ = 32 * nb; C0 = 32 * nb; WSC = W8_GU_SCALE; } \
                else { const int q = ql - NEXP * I_GU, mt = l_ * NEXP + q / I_DN, r_ = q % I_DN, kb = r_ / 32, nb = r_ % 32; \
                    SRC = args.in[I_WDN] + (size_t)mt * DFF * DM; NN = DM; DST = (bf16*)(WDN8 + (size_t)mt * DM * DFF); KK = DFF; K0 = 128 * kb; N0_ = 32 * nb; C0 = 32 * nb; WSC = W8_DN_SCALE; } } \
            else { const int q = it__ - N4, which = q / (16 * I_ML), r2 = q % (16 * I_ML), lh = r2 / I_ML, r_ = r2 % I_ML, kb = r_ / 4, nb = r_ % 4; \
                SRC = (which == 0 ? args.in[I_MLWQ] : which == 1 ? args.in[I_MLWK] : args.in[I_MLWV]) + (size_t)lh * 128 * 128; NN = 128; \
                DST = WML_T + (((size_t)(lh >> 2) * 3 + which) * 4 + (lh & 3)) * 128 * 128; KK = 128; K0 = 128 * kb; N0_ = 32 * nb; C0 = 32 * nb; } } while (0)
        {
#define TR_LOAD(dstv, SRC, NN_, K0, C0) do { const float* sp_ = (SRC) + (size_t)((K0) + (lane >> 3)) * (NN_) + (C0) + (lane & 7) * 4; \
                _Pragma("unroll") for (int i = 0; i < 16; ++i) dstv[i] = *(const f32x4*)(sp_ + (size_t)(8 * i) * (NN_)); } while (0)
#define TR_PROC(v, dst, KK, k0, n0, wsc) do { \
                _Pragma("unroll") for (int i = 0; i < 16; ++i) _Pragma("unroll") for (int e = 0; e < 4; ++e) scr[(8 * i + (lane >> 3)) * 33 + (lane & 7) * 4 + e] = v[i][e]; \
                LDS_WAIT(); asm volatile("" ::: "memory"); \
                if (wsc == 0.f) { const int c = lane & 15;                         \
                  _Pragma("unroll") for (int j = 0; j < 8; ++j) { const int n = (lane >> 4) + 4 * j; const LAS float* sp = scr + (8 * c) * 33 + n; \
                      u32x4 o; o.x = cvtpk(sp[0 * 33], sp[1 * 33]); o.y = cvtpk(sp[2 * 33], sp[3 * 33]); o.z = cvtpk(sp[4 * 33], sp[5 * 33]); o.w = cvtpk(sp[6 * 33], sp[7 * 33]); \
                      *(u32x4*)(dst + (size_t)(n0 + n) * KK + k0 + 8 * c) = o; } } \
                else {                                                             \
                  _Pragma("unroll") for (int j = 0; j < 4; ++j) { const int q = lane + 64 * j, n = q >> 3, part = q & 7; const LAS float* sp = scr + (part * 16) * 33 + n; \
                      u32x4 o; \
                      o.x = pk4_fp8(sp[0 * 33] * wsc, sp[1 * 33] * wsc, sp[2 * 33] * wsc, sp[3 * 33] * wsc); o.y = pk4_fp8(sp[4 * 33] * wsc, sp[5 * 33] * wsc, sp[6 * 33] * wsc, sp[7 * 33] * wsc); \
                      o.z = pk4_fp8(sp[8 * 33] * wsc, sp[9 * 33] * wsc, sp[10 * 33] * wsc, sp[11 * 33] * wsc); o.w = pk4_fp8(sp[12 * 33] * wsc, sp[13 * 33] * wsc, sp[14 * 33] * wsc, sp[15 * 33] * wsc); \
                      *(u32x4*)((unsigned char*)dst + (size_t)(n0 + n) * KK + k0 + part * 16) = o; } } \
                LDS_WAIT(); asm volatile("" ::: "memory"); } while (0)
#define TR_STATE(S) const float* src##S = nullptr; bf16* dst##S = nullptr; int NN##S = 0, KK##S = 0, k0##S = 0, n0##S = 0, c0##S = 0; float wsc##S = 0.f; f32x4 v##S[16]
#define TR_FETCH(S, it_) do { if ((it_) < N5) { TR_DECODE((it_), src##S, NN##S, dst##S, KK##S, k0##S, n0##S, c0##S, wsc##S); TR_LOAD(v##S, src##S, NN##S, k0##S, c0##S); } } while (0)
            TR_STATE(A); TR_STATE(B);
            TR_FETCH(A, gw); TR_FETCH(B, gw + NGW);
#pragma unroll 1
            for (int it = gw; it < N5; it += 2 * NGW) {
                TR_PROC(vA, dstA, KKA, k0A, n0A, wscA); TR_FETCH(A, it + 2 * NGW);
                if (it + NGW < N5) { TR_PROC(vB, dstB, KKB, k0B, n0B, wscB); TR_FETCH(B, it + 3 * NGW); }
            }
#undef TR_PROC
#undef TR_STATE
#undef TR_FETCH
#undef TR_LOAD
        }
#undef TR_DECODE
        for (size_t i = gt; i < (size_t)TOK * DM / 8; i += NGT) {
            const f32x4 a = *(const f32x4*)(args.in[I_X] + i * 8), b = *(const f32x4*)(args.in[I_X] + i * 8 + 4);
            *(u32x4*)(XB + i * 8) = pg8::pack8(a, b);
            *(u32x2*)(XB8I + i * 8) = (u32x2){pk4_fp8(a[0], a[1], a[2], a[3]), pk4_fp8(b[0], b[1], b[2], b[3])};
        }
        for (int p = gw; p < DEPTH * NEXP; p += NGW) {
            const int l = p >> 5, e = p & 31;
            const float* rw = args.in[I_RW] + (size_t)l * DM * NEXP; const float* g1 = args.in[I_LN1G] + (size_t)l * DM; const float* b1 = args.in[I_LN1B] + (size_t)l * DM;
            bf16* wh = (bf16*)(ws + OFF_RWGH) + (size_t)p * DM; bf16* wl = (bf16*)(ws + OFF_RWGL) + (size_t)p * DM;
            float cg = 0.f, cb = 0.f;
            for (int k = lane; k < DM; k += 64) { const float w = rw[(size_t)k * NEXP + e], wg = g1[k] * w; const bf16 h = tobf1(wg);
                wh[k] = h; wl[k] = tobf1(wg - bf1(h)); cg += wg; cb += b1[k] * w; }
            cg = wave_sum(cg, lane); cb = wave_sum(cb, lane);
            if (lane == 0) { float* cgcb = (float*)(ws + OFF_CGCB) + (size_t)l * 64; cgcb[e] = cg; cgcb[32 + e] = cb + args.in[I_RB][(size_t)l * NEXP + e]; }
        }
        for (int i = gt; i < DEPTH * 16 * 1536; i += NGT) { const int l = i / (16 * 1536), r = i % (16 * 1536), g = r / 1536, k = r % 1536;
            ((bf16*)(ws + OFF_WGT))[i] = tobf1(args.in[I_MLWG][((size_t)l * 1536 + k) * 16 + g]); }
        for (int i = gt; i < SEQ * 32; i += NGT) {
            const int s = i >> 5, j = i & 31;
            const float inv = exp2f(-(float)(2 * j) * (13.287712379549449f / 64.0f));
            const float ang = (float)s * inv; float sn, cs; sincos_acc(ang, sn, cs);
            ROPE[i] = (f32x2){cs, sn};
        }
        SEAM();
    }

    for (int l = (args.lay_lo < 0 ? 0 : args.lay_lo); l < args.lay_hi; ++l) {
        const int plo = args.ph_lo, phi = args.ph_hi;
#define IN(k) (((PHASE_MASK >> (k)) & 1ull) && plo <= (k) && (k) < phi)
#define PHASE(k) for (int rep_ = 0, nrep_ = (IN(k) ? (int)(1 + ((REPEAT_MASK >> (k)) & 1ull)) : 0); rep_ < nrep_; ++rep_)
        PHASE(PH_INPROJ) {
            PH_LOCALS
            {   pg8::Gemm g{(const bf16*)XB8I, (const bf16*)(WIN8 + (size_t)l * 6400 * DM), DM / 2, DM / 2, DM / 2, 0, nullptr};
                pg8::InprojOrder S{2, bx};
                pg8::EpiInProj E{QA, KA, VA, MLX, MLO, WQb, WKb, WVb, GT, ROPE, 1.0f / W8_IN_SCALE};
                pg8::gemm_phase<pg8::EpiInProj, true, false, true, pg8::InprojOrder>(lds, g, S, E, tid); }
            SEAM();
        }
        PHASE(PH_MLQKV) {
            PH_LOCALS
            LAS bf16* BA1 = (LAS bf16*)lds; LAS bf16* BA2 = (LAS bf16*)(lds + TILE_B); LAS bf16* BW0 = (LAS bf16*)(lds + 2 * TILE_B); LAS bf16* BW1 = (LAS bf16*)(lds + 3 * TILE_B);
            const float* cw = args.in[I_CONVW] + (size_t)l * 5 * 512; const float* cb = args.in[I_CONVB] + (size_t)l * 512;
            for (int u = vcu; u < 512; u += G) {
                const int tt = u >> 2, h = u & 3; const size_t t0 = (size_t)tt * 128;
                const int b = (int)(t0 >> 13), s0 = (int)(t0 & (SEQ - 1));
                const int c8 = (tid & 15) * 8, ch = h * 128 + c8;
                __syncthreads();
                {   f32x4 cwv[5][2]; f32x4 cbv[2];
#pragma unroll
                    for (int k = 0; k < 5; ++k) { cwv[k][0] = *(const f32x4*)(cw + k * 512 + ch); cwv[k][1] = *(const f32x4*)(cw + k * 512 + ch + 4); }
                    cbv[0] = *(const f32x4*)(cb + ch); cbv[1] = *(const f32x4*)(cb + ch + 4);
                    u32x4 xra[4][5];
#pragma unroll
                    for (int i = 0; i < 4; ++i) { const int r = (tid >> 4) + 32 * i, s = s0 + r;
#pragma unroll
                        for (int k = 0; k < 5; ++k) { const int ss = s + k - 2; xra[i][k] = (ss >= 0 && ss < SEQ) ? *(const u32x4*)(MLX + (t0 + r + k - 2) * 512 + ch) : (u32x4){0u, 0u, 0u, 0u}; } }
                    const bf16* wbase = WML_T + (((size_t)l * 3) * 4 + h) * 128 * 128;
                    u32x4 w0r[4], w1r[4], w2r[4];
#pragma unroll
                    for (int i = 0; i < 4; ++i) { const int r = (tid >> 4) + 32 * i; w0r[i] = *(const u32x4*)(wbase + (size_t)r * 128 + c8);
                        w1r[i] = *(const u32x4*)(wbase + (size_t)4 * 128 * 128 + (size_t)r * 128 + c8); w2r[i] = *(const u32x4*)(wbase + (size_t)8 * 128 * 128 + (size_t)r * 128 + c8); }
#pragma unroll
                    for (int i = 0; i < 4; ++i) {
                        const int r = (tid >> 4) + 32 * i;
                        u32x4 xr[5];
#pragma unroll
                        for (int k = 0; k < 5; ++k) xr[k] = xra[i][k];
                        float a[8] = {cbv[0][0], cbv[0][1], cbv[0][2], cbv[0][3], cbv[1][0], cbv[1][1], cbv[1][2], cbv[1][3]};
#pragma unroll
                        for (int k = 0; k < 5; ++k) { const u32x4 w = xr[k];
                            a[0] += bflo(w.x) * cwv[k][0][0]; a[1] += bfhi(w.x) * cwv[k][0][1]; a[2] += bflo(w.y) * cwv[k][0][2]; a[3] += bfhi(w.y) * cwv[k][0][3];
                            a[4] += bflo(w.z) * cwv[k][1][0]; a[5] += bfhi(w.z) * cwv[k][1][1]; a[6] += bflo(w.w) * cwv[k][1][2]; a[7] += bfhi(w.w) * cwv[k][1][3]; }
#pragma unroll
                        for (int j = 0; j < 8; ++j) a[j] = a[j] * sigmoidf_(a[j]);
                        u32x4 o; o.x = cvtpk(a[0], a[1]); o.y = cvtpk(a[2], a[3]); o.z = cvtpk(a[4], a[5]); o.w = cvtpk(a[6], a[7]);
                        *(LAS u32x4*)(BA1 + r * LDT + c8) = o; *(LAS u32x4*)(BA2 + r * LDT + c8) = xr[2];
                        *(LAS u32x4*)(BW0 + r * LDT + c8) = w0r[i]; *(LAS u32x4*)(BW1 + r * LDT + c8) = w1r[i];
                        *(u32x4*)(XC + (t0 + r) * 512 + ch) = o;
                    }
                    __syncthreads();
                    const bf16* wgt = (const bf16*)(ws + OFF_WGT) + (size_t)l * 16 * 1536;
                    LAS bf16* OTs = (LAS bf16*)(lds + 4 * TILE_B) + wave * 512;
                    f32x4 accg = (f32x4){0.f, 0.f, 0.f, 0.f};
#pragma unroll
                    for (int which = 0; which < 3; ++which) {
                        if (which == 2) { __syncthreads();
#pragma unroll
                            for (int i = 0; i < 4; ++i) { const int r = (tid >> 4) + 32 * i; *(LAS u32x4*)(BW0 + r * LDT + c8) = w2r[i]; }
                            __syncthreads(); }
                        const int fr = lane & 15, fq = lane >> 4;
                        bf16x8 wg[4];
#pragma unroll
                        for (int c = 0; c < 4; ++c) wg[c] = *(const bf16x8*)(wgt + (size_t)fr * 1536 + (which * 4 + h) * 128 + c * 32 + 8 * fq);
                        f32x4 acc[8];
                        wave_mm(acc, (which == 2 ? BA2 : BA1) + wave * 16 * LDT, which == 1 ? BW1 : BW0, lane);
                        bf16* dst = (which == 0 ? MQ : which == 1 ? MK : MV) + ((size_t)(b * 4 + h) * SEQ + s0) * 128;
#pragma unroll
                        for (int j = 0; j < 8; ++j)
#pragma unroll
                            for (int r = 0; r < 4; ++r) dst[(size_t)(wave * 16 + 4 * fq + r) * 128 + j * 16 + fr] = tobf1(acc[j][r]);
#pragma unroll
                        for (int c = 0; c < 4; ++c) {
#pragma unroll
                            for (int jj = 0; jj < 2; ++jj)
#pragma unroll
                                for (int r = 0; r < 4; ++r) OTs[(4 * fq + r) * 32 + jj * 16 + fr] = tobf1(acc[2 * c + jj][r]);
                            LDS_WAIT(); asm volatile("" ::: "memory");
                            const bf16x8 av = *(const LAS bf16x8*)(OTs + fr * 32 + fq * 8);
                            accg = __builtin_amdgcn_mfma_f32_16x16x32_bf16(av, wg[c], accg, 0, 0, 0);
                            LDS_WAIT(); asm volatile("" ::: "memory");
                        }
                    }
                    {   int fr = lane & 15; asm volatile("" : "+v"(fr));
                        const int fq = lane >> 4, ty = fr >> 2, hh = fr & 3; const float bias = (h == 0) ? args.in[I_MLBG][(size_t)l * 16 + fr] : 0.f;
#pragma unroll
                        for (int r = 0; r < 4; ++r) GP[((((size_t)h * 4 + ty) * BATCH + b) * 4 + hh) * SEQ + s0 + wave * 16 + 4 * fq + r] = accg[r] + bias; }
                }
            }
            SEAM();
        }
        PHASE(PH_MLLOC) {
            PH_LOCALS
            LAS bf16* BA = (LAS bf16*)lds; LAS bf16* BBf = (LAS bf16*)(lds + TILE_B); LAS bf16* BBb = (LAS bf16*)(lds + 2 * TILE_B);
            LAS float* sm = (LAS float*)(lds + 3 * TILE_B);
            LAS float* sLSf = sm, *sLSb = sm + 128, *sIGf = sm + 256, *sIGb = sm + 384, *sBf = sm + 512, *sBb = sm + 640, *sEf = sm + 768, *sEb = sm + 896, *sNP = sm + 1024;
            for (int u = vcu; u < 512; u += G) {
                asm volatile("" : "+v"(tid));
                const int lane = tid & 63, wave = __builtin_amdgcn_readfirstlane(tid >> 6);
                const int b = u >> 8, h = (u >> 6) & 3, c = u & 63; const int s0 = c * 128;
                const int seqf = (0 * 2 + b) * 4 + h, seqb = (1 * 2 + b) * 4 + h;
                const size_t rb = ((size_t)(b * 4 + h) * SEQ + s0) * 128;
                u32x4 kr[4], vr[4];
#pragma unroll
                for (int i = 0; i < 4; ++i) { const int r = tid & 127, c8 = ((tid >> 7) + 4 * i) * 8; kr[i] = *(const u32x4*)(MK + rb + (size_t)r * 128 + c8); vr[i] = *(const u32x4*)(MV + rb + (size_t)r * 128 + c8); }
                const int gt_ = tid & 127;
                const float g0_ = GATE4(0), g1_ = GATE4(1);
                const float g2_ = GATE4(2), g3_ = GATE4(3);
                __syncthreads();
                if (tid < 128) { sIGf[tid] = g0_; sLSf[tid] = logsigmoidf_(g1_); sIGb[tid] = g2_; sLSb[tid] = logsigmoidf_(g3_); }
                __syncthreads();
                if (wave == 0) scan_dir<false>(sLSf, sIGf, sBf, nullptr, 0, lane);
                if (wave == 1) scan_dir<false>(sLSb, sIGb, sBb, nullptr, 1, lane);
                __syncthreads();
                const float gtf = sBf[127], gtb = sBb[0];
                const float wf0 = gtf - sBf[lane] + sIGf[lane], wf1 = gtf - sBf[lane + 64] + sIGf[lane + 64];
                const float wb0 = gtb - sBb[lane] + sIGb[lane], wb1 = gtb - sBb[lane + 64] + sIGb[lane + 64];
                const float mlf = wave_max(fmaxf(wf0, wf1), lane), mlb = wave_max(fmaxf(wb0, wb1), lane);
                if (wave == 0) { sEf[lane] = __expf(wf0 - mlf) * 0.08838834764831845f; sEf[lane + 64] = __expf(wf1 - mlf) * 0.08838834764831845f; }
                if (wave == 1) { sEb[lane] = __expf(wb0 - mlb) * 0.08838834764831845f; sEb[lane + 64] = __expf(wb1 - mlb) * 0.08838834764831845f; }
                __syncthreads();
#pragma unroll
                for (int i = 0; i < 4; ++i) { const int r = tid & 127, c8 = ((tid >> 7) + 4 * i) * 8; const float ef = sEf[r], eb = sEb[r];
                    const unsigned kw[4] = {kr[i].x, kr[i].y, kr[i].z, kr[i].w}, vw[4] = {vr[i].x, vr[i].y, vr[i].z, vr[i].w};
#pragma unroll
                    for (int j = 0; j < 4; ++j) {
                        BA[(c8 + 2 * j) * LDT + r] = (bf16)(vw[j] & 0xffffu); BA[(c8 + 2 * j + 1) * LDT + r] = (bf16)(vw[j] >> 16);
                        const float k0 = bflo(kw[j]), k1 = bfhi(kw[j]);
                        BBf[(c8 + 2 * j) * LDT + r] = tobf1(k0 * ef); BBf[(c8 + 2 * j + 1) * LDT + r] = tobf1(k1 * ef);
                        BBb[(c8 + 2 * j) * LDT + r] = tobf1(k0 * eb); BBb[(c8 + 2 * j + 1) * LDT + r] = tobf1(k1 * eb); } }
                __syncthreads();
                const int fr = lane & 15, fq = lane >> 4;
#pragma unroll
                for (int dir = 0; dir < 2; ++dir) {
                    f32x4 acc[8];
                    wave_mm(acc, BA + wave * 16 * LDT, dir ? BBb : BBf, lane);
                    bf16* dst = CLOC + ((size_t)(dir ? seqb : seqf) * 64 + c) * 16384;
#pragma unroll
                    for (int j = 0; j < 8; ++j)
#pragma unroll
                        for (int r = 0; r < 4; ++r) dst[(wave * 16 + 4 * fq + r) * 128 + j * 16 + fr] = tobf1(acc[j][r]);
                    const int kd = tid & 127, part = tid >> 7; float sacc = 0.f;
#pragma unroll
                    for (int q = 0; q < 4; ++q) { const u32x4 w = *(const LAS u32x4*)((dir ? BBb : BBf) + kd * LDT + part * 32 + q * 8);
                        sacc += (bflo(w.x) + bfhi(w.x)) + (bflo(w.y) + bfhi(w.y)) + (bflo(w.z) + bfhi(w.z)) + (bflo(w.w) + bfhi(w.w)); }
                    sNP[dir * 512 + part * 128 + kd] = sacc;
                }
                __syncthreads();
                if (tid < 256) { const int dir = tid >> 7, kd = tid & 127; const LAS float* p = sNP + dir * 512;
                    NLOC[((size_t)(dir ? seqb : seqf) * 64 + c) * 128 + kd] = (p[kd] + p[128 + kd]) + (p[256 + kd] + p[384 + kd]); }
                if (tid == 0) { MLOC[seqf * 64 + c] = mlf; GCH[seqf * 64 + c] = gtf; MLOC[seqb * 64 + c] = mlb; GCH[seqb * 64 + c] = gtb; }
            }
            SEAM();
        }
        PHASE(PH_MLSCAN) {
            PH_LOCALS
            LAS float* sG = (LAS float*)lds; LAS float* sM = sG + 64; LAS float* sA = sG + 128; LAS float* sBl = sG + 192; LAS float* sMp = sG + 256;
            const int seq = vcu >> 4, dir = seq >> 3;
            __syncthreads();
            if (tid < 64) { sG[tid] = GCH[seq * 64 + tid]; sM[tid] = MLOC[seq * 64 + tid]; }
            __syncthreads();
            if (tid == 0) { float m = 0.f;
                for (int cc = 0; cc < 64; ++cc) { const int c = dir ? 63 - cc : cc; const float gc = sG[c], ml = sM[c];
                    const float mn = fmaxf(gc + m, ml); sA[cc] = __expf(gc + m - mn); sBl[cc] = __expf(ml - mn); sMp[cc] = m; m = mn; } }
            __syncthreads();
            {
                const int e2 = ((vcu & 15) * NTHR + tid) * 2;
                f32x2 C = {0.f, 0.f};
                for (int half = 0; half < 2; ++half) {
                    unsigned cl[32];
#pragma unroll
                    for (int i = 0; i < 32; ++i) { const int cc = half * 32 + i, c = dir ? 63 - cc : cc; cl[i] = *(const unsigned*)(CLOC + ((size_t)seq * 64 + c) * 16384 + e2); }
#pragma unroll
                    for (int i = 0; i < 32; ++i) { const int cc = half * 32 + i, c = dir ? 63 - cc : cc;
                        *(unsigned*)(CPT + ((size_t)seq * 64 + c) * 16384 + e2) = cvtpk(C[0], C[1]);
                        C = C * sA[cc] + (f32x2){bflo(cl[i]), bfhi(cl[i])} * sBl[cc]; }
                }
            }
            if ((vcu & 15) == 0) {
                if (tid < 64) { const int c = dir ? 63 - tid : tid; MPREV[seq * 64 + c] = sMp[tid]; }
                if (tid < 128) { float n = 0.f;
                    for (int half = 0; half < 2; ++half) { float nl[32];
#pragma unroll
                        for (int i = 0; i < 32; ++i) { const int cc = half * 32 + i, c = dir ? 63 - cc : cc; nl[i] = NLOC[((size_t)seq * 64 + c) * 128 + tid]; }
#pragma unroll
                        for (int i = 0; i < 32; ++i) { const int cc = half * 32 + i, c = dir ? 63 - cc : cc;
                            NPREV[((size_t)seq * 64 + c) * 128 + tid] = n; n = n * sA[cc] + nl[i] * sBl[cc]; } } }
            }
            SEAM();
        }
        PHASE(PH_MLOUT) {
            PH_LOCALS
            LAS bf16* BQ = (LAS bf16*)lds; LAS bf16* BK = (LAS bf16*)(lds + TILE_B); LAS bf16* BV = (LAS bf16*)(lds + 2 * TILE_B); LAS bf16* BC = (LAS bf16*)(lds + 3 * TILE_B);
            LAS float* sm = (LAS float*)(lds + 4 * TILE_B);
            LAS float* sLSf = sm, *sLSb = sm + 128, *sIf = sm + 256, *sIb = sm + 384, *sBf = sm + 512, *sBb = sm + 640, *sPf = sm + 768, *sPb = sm + 896;
            LAS float* sNf = sm + 1024, *sNb = sm + 1152, *sQNf = sm + 1280, *sQNb = sm + 1408;
            const float* normw = args.in[I_MLNORM] + (size_t)l * 512; const float* skipw = args.in[I_MLSKIP] + (size_t)l * 512;
            for (int u = vcu; u < 512; u += G) {
                asm volatile("" : "+v"(tid));
                const int lane = tid & 63, wave = __builtin_amdgcn_readfirstlane(tid >> 6);
                const int b = u >> 8, h = (u >> 6) & 3, c = u & 63; const int s0 = c * 128;
                const int seqf = (0 * 2 + b) * 4 + h, seqb = (1 * 2 + b) * 4 + h;
                const size_t rb = ((size_t)(b * 4 + h) * SEQ + s0) * 128;
                const int gt_ = tid & 127;
                const float g0_ = GATE4(0), g1_ = GATE4(1);
                const float g2_ = GATE4(2), g3_ = GATE4(3);
                const float np0_ = NPREV[((size_t)seqf * 64 + c) * 128 + gt_], np1_ = NPREV[((size_t)seqb * 64 + c) * 128 + gt_];
                __syncthreads();
                stage_rows(BQ, MQ + rb, 128, tid); stage_rows(BK, MK + rb, 128, tid); stage_tr<false>(BV, MV + rb, 128, nullptr, tid);
                stage_rows(BC, CPT + ((size_t)seqf * 64 + c) * 16384, 128, tid);
                if (tid < 128) { sIf[tid] = g0_; sLSf[tid] = logsigmoidf_(g1_); sIb[tid] = g2_; sLSb[tid] = logsigmoidf_(g3_); sNf[tid] = np0_; sNb[tid] = np1_; }
                __syncthreads();
                if (wave == 0) scan_dir<true>(sLSf, sIf, sBf, sPf, 0, lane);
                if (wave == 1) scan_dir<true>(sLSb, sIb, sBb, sPb, 1, lane);
                {
                    const int t = tid >> 2, part = tid & 3; float af = 0.f, ab = 0.f;
                    for (int k = 0; k < 32; ++k) { const float q = bf1(BQ[t * LDT + part * 32 + k]); af += q * sNf[part * 32 + k]; ab += q * sNb[part * 32 + k]; }
                    af += shx(af, 1, lane); af += shx(af, 2, lane); ab += shx(ab, 1, lane); ab += shx(ab, 2, lane);
                    if (part == 0) { sQNf[t] = af; sQNb[t] = ab; }
                }
                __syncthreads();
                const float mpf = MPREV[seqf * 64 + c], mpb = MPREV[seqb * 64 + c];
                const int fr = lane & 15, fq = lane >> 4;
                u32x4 cbr[4];
#pragma unroll
                for (int i = 0; i < 4; ++i) { const int q = tid + 512 * i; cbr[i] = *(const u32x4*)(CPT + ((size_t)seqb * 64 + c) * 16384 + (size_t)(q >> 4) * 128 + (q & 15) * 8); }
                f32x4 accS[8];
                wave_mm(accS, BQ + wave * 16 * LDT, BK, lane);
                float rowBf[4], rowBb[4], mtf[4], mtb[4], inf_[4], inb_[4], rsf[4], rsb[4];
#pragma unroll
                for (int r = 0; r < 4; ++r) { const int t = wave * 16 + 4 * fq + r;
                    rowBf[r] = sBf[t]; rowBb[r] = sBb[t];
                    mtf[r] = rowBf[r] + fmaxf(mpf, sPf[t]); mtb[r] = rowBb[r] + fmaxf(mpb, sPb[t]);
                    inf_[r] = __expf(rowBf[r] + mpf - mtf[r]); inb_[r] = __expf(rowBb[r] + mpb - mtb[r]);
                    rsf[r] = 0.f; rsb[r] = 0.f; }
#pragma unroll
                for (int j = 0; j < 8; ++j) { const int s = j * 16 + fr; const float cf = sIf[s] - sBf[s], cb = sIb[s] - sBb[s];
#pragma unroll
                    for (int r = 0; r < 4; ++r) { const int t = wave * 16 + 4 * fq + r; const float sv = accS[j][r];
                        rsf[r] += (s <= t) ? __expf(rowBf[r] + cf - mtf[r]) * sv : 0.f;
                        rsb[r] += (s >= t) ? __expf(rowBb[r] + cb - mtb[r]) * sv : 0.f; } }
                float scf[4], scb[4], cif[4], cib[4];
#pragma unroll
                for (int r = 0; r < 4; ++r) { const int t = wave * 16 + 4 * fq + r;
                    float a = rsf[r] * 0.08838834764831845f, bq = rsb[r] * 0.08838834764831845f;
                    a += shx(a, 1, lane); a += shx(a, 2, lane); a += shx(a, 4, lane); a += shx(a, 8, lane);
                    bq += shx(bq, 1, lane); bq += shx(bq, 2, lane); bq += shx(bq, 4, lane); bq += shx(bq, 8, lane);
                    const float denf = inf_[r] * sQNf[t] + a, denb = inb_[r] * sQNb[t] + bq;
                    scf[r] = 1.0f / fmaxf(fabsf(denf), __expf(-mtf[r])); scb[r] = 1.0f / fmaxf(fabsf(denb), __expf(-mtb[r]));
                    cif[r] = scf[r] * inf_[r]; cib[r] = scb[r] * inb_[r];
                    scf[r] *= 0.08838834764831845f; scb[r] *= 0.08838834764831845f; }
                __syncthreads();
#pragma unroll
                for (int j = 0; j < 8; ++j) { const int s = j * 16 + fr; const float cf = sIf[s] - sBf[s], cb = sIb[s] - sBb[s];
#pragma unroll
                    for (int r = 0; r < 4; ++r) { const int t = wave * 16 + 4 * fq + r; const float sv = accS[j][r];
                        const float a = (s <= t) ? __expf(rowBf[r] + cf - mtf[r]) * scf[r] : 0.f;
                        const float bq = (s >= t) ? __expf(rowBb[r] + cb - mtb[r]) * scb[r] : 0.f;
                        BK[t * LDT + s] = tobf1((a + bq) * sv); } }
                __syncthreads();
                f32x4 hacc[8];
                wave_mm(hacc, BK + wave * 16 * LDT, BV, lane);
                f32x4 xacc[8];
                wave_mm(xacc, BQ + wave * 16 * LDT, BC, lane);
#pragma unroll
                for (int j = 0; j < 8; ++j)
#pragma unroll
                    for (int r = 0; r < 4; ++r) hacc[j][r] += cif[r] * xacc[j][r];
                __syncthreads();
#pragma unroll
                for (int i = 0; i < 4; ++i) { const int q = tid + 512 * i; *(LAS u32x4*)(BV + (q >> 4) * LDT + (q & 15) * 8) = cbr[i]; }
                __syncthreads();
                wave_mm(xacc, BQ + wave * 16 * LDT, BV, lane);
#pragma unroll
                for (int j = 0; j < 8; ++j)
#pragma unroll
                    for (int r = 0; r < 4; ++r) hacc[j][r] += cib[r] * xacc[j][r];
#pragma unroll
                for (int r = 0; r < 4; ++r) {
                    float sacc = 0.f;
#pragma unroll
                    for (int j = 0; j < 8; ++j) sacc += hacc[j][r];
                    sacc += shx(sacc, 1, lane); sacc += shx(sacc, 2, lane); sacc += shx(sacc, 4, lane); sacc += shx(sacc, 8, lane);
                    const float mu = sacc * (1.f / 128.f); float q = 0.f;
#pragma unroll
                    for (int j = 0; j < 8; ++j) { const float d = hacc[j][r] - mu; q += d * d; }
                    q += shx(q, 1, lane); q += shx(q, 2, lane); q += shx(q, 4, lane); q += shx(q, 8, lane);
                    const float rstd = 1.0f / sqrtf(q * (1.f / 128.f) + LN_EPS);
#pragma unroll
                    for (int j = 0; j < 8; ++j) hacc[j][r] = (hacc[j][r] - mu) * rstd;
                }
                __syncthreads();
                {   LAS float* HN = (LAS float*)lds;
#pragma unroll
                    for (int j = 0; j < 8; ++j)
#pragma unroll
                        for (int r = 0; r < 4; ++r) HN[(wave * 16 + 4 * fq + r) * 132 + j * 16 + fr] = hacc[j][r];
                    __syncthreads();
                    const int t = tid >> 2, cq = (tid & 3) * 32; const size_t tokrow = (size_t)b * SEQ + s0 + t; const int col0 = h * 128 + cq;
                    u32x4 xcv[4], mov[4];
#pragma unroll
                    for (int i = 0; i < 4; ++i) { xcv[i] = *(const u32x4*)(XC + tokrow * 512 + col0 + i * 8); mov[i] = *(const u32x4*)(MLO + tokrow * 512 + col0 + i * 8); }
#pragma unroll
                    for (int i = 0; i < 4; ++i) {
                        const f32x4 h0 = *(const LAS f32x4*)(HN + t * 132 + cq + i * 8), h1 = *(const LAS f32x4*)(HN + t * 132 + cq + i * 8 + 4);
                        const f32x4 n0 = *(const f32x4*)(normw + col0 + i * 8), n1 = *(const f32x4*)(normw + col0 + i * 8 + 4);
                        const f32x4 k0 = *(const f32x4*)(skipw + col0 + i * 8), k1 = *(const f32x4*)(skipw + col0 + i * 8 + 4);
                        const unsigned xw[4] = {xcv[i].x, xcv[i].y, xcv[i].z, xcv[i].w}, mw[4] = {mov[i].x, mov[i].y, mov[i].z, mov[i].w};
                        float o[8];
#pragma unroll
                        for (int j = 0; j < 4; ++j) {
                            const float ha = (j < 2 ? h0[2 * j] : h1[2 * j - 4]), hb = (j < 2 ? h0[2 * j + 1] : h1[2 * j - 3]);
                            const float na = (j < 2 ? n0[2 * j] : n1[2 * j - 4]), nb = (j < 2 ? n0[2 * j + 1] : n1[2 * j - 3]);
                            const float ka = (j < 2 ? k0[2 * j] : k1[2 * j - 4]), kb = (j < 2 ? k0[2 * j + 1] : k1[2 * j - 3]);
                            o[2 * j] = sigmoidf_(bflo(mw[j])) * (ha * na + ka * bflo(xw[j]));
                            o[2 * j + 1] = sigmoidf_(bfhi(mw[j])) * (hb * nb + kb * bfhi(xw[j])); }
                        u32x4 ow; ow.x = cvtpk(o[0], o[1]); ow.y = cvtpk(o[2], o[3]); ow.z = cvtpk(o[4], o[5]); ow.w = cvtpk(o[6], o[7]);
                        *(u32x4*)(YB + tokrow * 512 + col0 + i * 8) = ow;
                    }
                }
            }
            __syncthreads();
        }
        PHASE(PH_DIFF) {
            PH_LOCALS
            const float* lp = args.in[I_LAMBDA] + (size_t)l * 256;
            const float s1 = wave_sum(lp[lane] * lp[64 + lane], lane), s2 = wave_sum(lp[128 + lane] * lp[192 + lane], lane);
            const float lam_init = args.lam_init[l], lam = __expf(s1) - __expf(s2) + lam_init;
            const float* subln = args.in[I_SUBLN] + (size_t)l * 128;
            for (int u = vcu; u < 256; u += G) {
                const int b = u >> 7, h = (u >> 5) & 3, qb = u & 31;
                f32x16 o[4];
                const unsigned char* q8 = (const unsigned char*)QA; const unsigned char* k8 = (const unsigned char*)KA; const unsigned char* v8 = (const unsigned char*)VA + (size_t)(b * 4 + h) * SEQ * 128;
                att::CvtJob cj; cj.on = 1; const int ln_ = l;
                cj.wgu = args.in[I_WGU] + (size_t)ln_ * NEXP * DM * 2048; cj.wdn = args.in[I_WDN] + (size_t)ln_ * NEXP * DFF * DM;
                cj.wgu8 = WGU8 + (size_t)ln_ * NEXP * 2048 * DM; cj.wdn8 = WDN8 + (size_t)ln_ * NEXP * DM * DFF; cj.wg = bx * 8 + wave; cj.qbase = 0;
                {   const size_t hb = ((size_t)(b * 8 + h * 2 + 0) * SEQ) * 64;
                    att::body8(q8 + hb + (size_t)qb * 256 * 64, k8 + hb, v8, SEQ / 64, o, (char*)lds_raw, tid, cj); }
                {   int t2 = tid; asm volatile("" : "+v"(t2));
                    GAS float* st = (GAS float*)(STASH + (size_t)bx * (16 * 512 * 4) + (size_t)t2 * 4);
#pragma unroll
                for (int d = 0; d < 4; ++d)
#pragma unroll
                    for (int q4 = 0; q4 < 4; ++q4) *(GAS f32x4*)(st + (size_t)(d * 4 + q4) * 2048) = (f32x4){o[d][q4 * 4], o[d][q4 * 4 + 1], o[d][q4 * 4 + 2], o[d][q4 * 4 + 3]}; }
                {   const size_t hb = ((size_t)(b * 8 + h * 2 + 1) * SEQ) * 64; cj.qbase = att::CVT_ITEMS;
                    att::body8(q8 + hb + (size_t)qb * 256 * 64, k8 + hb, v8, SEQ / 64, o, (char*)lds_raw, tid, cj); }
                float ss[16];
#pragma unroll
                for (int r = 0; r < 16; ++r) ss[r] = 0.f;
                int t3 = tid; asm volatile("" : "+v"(t3));
                const int r32 = t3 & 31, hi = (t3 >> 5) & 1;
                GAS float* st = (GAS float*)(STASH + (size_t)bx * (16 * 512 * 4) + (size_t)t3 * 4);
#pragma unroll
                for (int d = 0; d < 4; ++d)
#pragma unroll
                    for (int q4 = 0; q4 < 4; ++q4) { const f32x4 v = *(const GAS f32x4*)(st + (size_t)(d * 4 + q4) * 2048);
#pragma unroll
                        for (int k = 0; k < 4; ++k) { const float x = v[k] - lam * o[d][q4 * 4 + k]; o[d][q4 * 4 + k] = x; ss[q4 * 4 + k] += x * x; } }
#pragma unroll
                for (int r = 0; r < 16; ++r) { float v = ss[r]; v += shx(v, 1, lane); v += shx(v, 2, lane); v += shx(v, 4, lane); v += shx(v, 8, lane); v += shx(v, 16, lane);
                    ss[r] = (1.0f / sqrtf(v * (1.f / 128.f) + LN_EPS)) * (1.f - lam_init); }
                GAS bf16* yo = (GAS bf16*)(YA + ((size_t)b * SEQ + qb * 256 + wave * 32 + 4 * hi) * 512 + h * 128 + r32);
                asm volatile("" : "+v"(yo));
#pragma unroll
                for (int d = 0; d < 4; ++d) { const float gsc = subln[d * 32 + r32];
#pragma unroll
                    for (int r = 0; r < 16; ++r) yo[((r & 3) + 8 * (r >> 2)) * 512 + d * 32] = tobf1(o[d][r] * ss[r] * gsc); }
            }
            __syncthreads();
        }
        PHASE(PH_WIN) {
            PH_LOCALS
            const float* sinks = args.in[I_SINKS] + (size_t)l * 8;
            bf16x8 wkk[8], wvv[8];
            int vcu_l = vcu; asm volatile("" : "+s"(vcu_l));
#define WIN_DECODE(u_, b_, qh_, q0_, klo_, NT_) const int b_ = (u_) >> 8, qh_ = ((u_) >> 5) & 7, q0_ = ((u_) & 31) * 256; \
                const int klo_ = (q0_ - 128 < 0) ? 0 : q0_ - 128; const int NT_ = (((q0_ + 384 > SEQ) ? SEQ : q0_ + 384) - klo_) / 64
            {   WIN_DECODE(vcu_l * 2, b0_, qh0_, q00_, klo0_, NT0_);
                WIN_LOAD(wkk, wvv, WKb + ((size_t)(b0_ * 2 + (qh0_ >> 2)) * SEQ + klo0_) * 64, WVb + ((size_t)(b0_ * 2 + (qh0_ >> 2)) * SEQ + klo0_) * 64, NT0_, tid); }
#pragma unroll
            for (int i = 0; i < 2; ++i) {
                const int u = vcu_l * 2 + i;
                WIN_DECODE(u, b, qh, q0, klo, NT);
                WIN_STAGE(wkk, wvv, NT, (char*)lds_raw, tid);
                if (i == 0) { WIN_DECODE(u + 1, b1_, qh1_, q01_, klo1_, NT1_);
                    WIN_LOAD(wkk, wvv, WKb + ((size_t)(b1_ * 2 + (qh1_ >> 2)) * SEQ + klo1_) * 64, WVb + ((size_t)(b1_ * 2 + (qh1_ >> 2)) * SEQ + klo1_) * 64, NT1_, tid); }
                f32x16 o[2];
                att::win_compute(WQb + ((size_t)(b * 8 + qh) * SEQ + q0) * 64, NT, klo, q0, sinks[qh] * 1.4426950408889634f, o, (char*)lds_raw, tid);
                const int r32 = tid & 31, hi = (tid >> 5) & 1;
                GAS bf16* yo = (GAS bf16*)(YC + ((size_t)b * SEQ + q0 + wave * 32 + 4 * hi) * 512 + qh * 64 + r32);
                asm volatile("" : "+v"(yo));
#pragma unroll
                for (int d = 0; d < 2; ++d)
#pragma unroll
                    for (int r = 0; r < 16; ++r) yo[((r & 3) + 8 * (r >> 2)) * 512 + d * 32] = tobf1(o[d][r]);
            }
#undef WIN_DECODE
            SEAM();
        }
        PHASE(PH_MERGE) {
            PH_LOCALS
            pg8::Gemm g{YA, WP_T + (size_t)l * 3 * DM * 512, 512, 512, 512, (size_t)TOK * 512 * 2, nullptr};
            pg8::StaticOrder S; S.init(TOK / 256, DM / 256, G, bx, nullptr, 3);
            pg8::EpiMerge E{GT, MB};
            pg8::gemm_phase<pg8::EpiMerge, true>(lds, g, S, E, tid);
            SEAM();
        }
        PHASE(PH_OUT) {
            PH_LOCALS
            pg8::Gemm g{MB, WOUT_T + (size_t)l * DM * DM, DM, DM, DM, 0, nullptr};
            pg8::StaticOrder S; S.init(TOK / 256, DM / 256, G, bx, nullptr);
            pg8::EpiOut E{XB, ZB};
            pg8::gemm_phase<pg8::EpiOut, true>(lds, g, S, E, tid);
            SEAM();
        }
        PHASE(PH_LN1) {
            PH_LOCALS
            LAS float* PART = (LAS float*)lds;
            LAS float* RAW = (LAS float*)(lds + 8 * 32 * 33 * 4);
            LAS float* LG = (LAS float*)(lds + 8 * 32 * 33 * 4 + 64 * 33 * 4) + wave * (8 * 33);
            LAS int* LCNT = (LAS int*)(lds + 8 * 32 * 33 * 4 + 64 * 33 * 4 + 8 * 8 * 33 * 4);
            const float* g1 = args.in[I_LN1G] + (size_t)l * DM; const float* b1 = args.in[I_LN1B] + (size_t)l * DM;
            const float* cgcb = (const float*)(ws + OFF_CGCB) + (size_t)l * 64;
            const int tok0 = bx * (TOK / GRID);
            u32x2 zall[8][4];
#pragma unroll
            for (int q = 0; q < 8; ++q)
#pragma unroll
                for (int j = 0; j < 4; ++j) zall[q][j] = *(const u32x2*)(ZB + (size_t)(tok0 + wave * 8 + q) * DM + 4 * lane + 256 * j);
            __syncthreads();
            if (tid < 32) LCNT[tid] = 0;
            {
                const int tg = wave & 1, kq = wave >> 1, r32 = lane & 31, hi = lane >> 5;
                const bf16* zr = ZB + (size_t)(tok0 + tg * 32 + r32) * DM + kq * 256 + hi * 8;
                const bf16* whp = (const bf16*)(ws + OFF_RWGH) + ((size_t)l * NEXP + r32) * DM + kq * 256 + hi * 8;
                const bf16* wlp = (const bf16*)(ws + OFF_RWGL) + ((size_t)l * NEXP + r32) * DM + kq * 256 + hi * 8;
                f32x16 acc = f32x16{};
#pragma unroll 8
                for (int ks = 0; ks < 16; ++ks) {
                    const bf16x8 a_h = *(const bf16x8*)(zr + ks * 16);
                    const bf16x8 bh = *(const bf16x8*)(whp + ks * 16), bl = *(const bf16x8*)(wlp + ks * 16);
                    acc = __builtin_amdgcn_mfma_f32_32x32x16_bf16(a_h, bh, acc, 0, 0, 0);
                    acc = __builtin_amdgcn_mfma_f32_32x32x16_bf16(a_h, bl, acc, 0, 0, 0);
                }
#pragma unroll
                for (int r = 0; r < 16; ++r) PART[(wave * 32 + ((r & 3) + 8 * (r >> 2) + 4 * hi)) * 33 + r32] = acc[r];
            }
            __syncthreads();
            for (int i = tid; i < 64 * 32; i += NTHR) { const int t = i >> 5, e = i & 31, tg = t >> 5, tr = t & 31;
                RAW[t * 33 + e] = (PART[((0 * 2 + tg) * 32 + tr) * 33 + e] + PART[((1 * 2 + tg) * 32 + tr) * 33 + e]) + (PART[((2 * 2 + tg) * 32 + tr) * 33 + e] + PART[((3 * 2 + tg) * 32 + tr) * 33 + e]); }
            __syncthreads();
            f32x4 gv[4], bv[4];
#pragma unroll
            for (int j = 0; j < 4; ++j) { gv[j] = *(const f32x4*)(g1 + 4 * lane + 256 * j); bv[j] = *(const f32x4*)(b1 + 4 * lane + 256 * j); }
            const float cge = cgcb[lane & 31], cbe = cgcb[32 + (lane & 31)];
#pragma unroll
            for (int i0 = 0; i0 < 8; i0 += 2) {
                f32x4 v[2][4];
#pragma unroll
                for (int q = 0; q < 2; ++q)
#pragma unroll
                    for (int j = 0; j < 4; ++j) { const u32x2 w = zall[i0 + q][j]; v[q][j] = (f32x4){bflo(w.x), bfhi(w.x), bflo(w.y), bfhi(w.y)}; }
#pragma unroll
                for (int q = 0; q < 2; ++q) {
                    const int tl = wave * 8 + i0 + q, t = tok0 + tl;
                    float s = 0.f;
#pragma unroll
                    for (int j = 0; j < 4; ++j) s += (v[q][j][0] + v[q][j][1]) + (v[q][j][2] + v[q][j][3]);
                    const float mean = wave_sum(s, lane) * (1.f / DM); float s2 = 0.f;
#pragma unroll
                    for (int j = 0; j < 4; ++j) { v[q][j] = v[q][j] - mean; s2 += (v[q][j][0] * v[q][j][0] + v[q][j][1] * v[q][j][1]) + (v[q][j][2] * v[q][j][2] + v[q][j][3] * v[q][j][3]); }
                    const float rstd = 1.f / sqrtf(wave_sum(s2, lane) * (1.f / DM) + LN_EPS);
#pragma unroll
                    for (int j = 0; j < 4; ++j) { const f32x4 o = v[q][j] * rstd * gv[j] + bv[j];
                        u32x2 w; w.x = cvtpk(o[0], o[1]); w.y = cvtpk(o[2], o[3]);
                        *(u32x2*)(XB + (size_t)t * DM + 4 * lane + 256 * j) = w;
                        *(unsigned*)(XB8 + (size_t)t * DM + 4 * lane + 256 * j) = pk4_fp8(o[0], o[1], o[2], o[3]); }
                    if (lane < 32) LG[(i0 + q) * 33 + lane] = rstd * (RAW[tl * 33 + lane] - mean * cge) + cbe;
                }
            }
            LDS_WAIT(); asm volatile("" ::: "memory");
            if (lane < 8) {
                const int t = tok0 + wave * 8 + lane;
                float v0 = -INFINITY, v1 = -INFINITY, v2 = -INFINITY, v3 = -INFINITY; int e0 = 0, e1 = 0, e2 = 0, e3 = 0;
#pragma unroll 4
                for (int e = 0; e < 32; ++e) { const float x = LG[lane * 33 + e];
                    if (x > v0) { v3 = v2; e3 = e2; v2 = v1; e2 = e1; v1 = v0; e1 = e0; v0 = x; e0 = e; }
                    else if (x > v1) { v3 = v2; e3 = e2; v2 = v1; e2 = e1; v1 = x; e1 = e; }
                    else if (x > v2) { v3 = v2; e3 = e2; v2 = x; e2 = e; }
                    else if (x > v3) { v3 = x; e3 = e; } }
                const float p1 = __expf(v1 - v0), p2 = __expf(v2 - v0), p3 = __expf(v3 - v0), inv = 1.f / (1.f + p1 + p2 + p3);
                const int l0 = atomicAdd((int*)&LCNT[e0], 1), l1 = atomicAdd((int*)&LCNT[e1], 1), l2 = atomicAdd((int*)&LCNT[e2], 1), l3 = atomicAdd((int*)&LCNT[e3], 1);
                *(int4*)(TOKE + t * 4) = make_int4(e0, e1, e2, e3);
                *(float4*)(TOKW + t * 4) = make_float4(inv, p1 * inv, p2 * inv, p3 * inv);
                *(int4*)(TOKLP + t * 4) = make_int4(l0, l1, l2, l3);
            }
            __syncthreads();
            if (tid < 32) BLKCNT[bx * 32 + tid] = LCNT[tid];
            SEAM();
        }
        PHASE(PH_SORT) {
            PH_LOCALS
            LAS int* sTot = (LAS int*)lds; LAS int* sBase = sTot + 32; LAS int* sOff = sTot + 64; LAS int* sRow = sTot + 128;
            LAS int* sPT = sTot + 512; LAS int* sPB = sTot + 1024;
            __syncthreads();
            {   const int e = tid & 31, part = tid >> 5; int tot = 0, base = 0;
#pragma unroll
                for (int i = 0; i < 16; ++i) { const int b2 = part * 16 + i; const int c = BLKCNT[b2 * 32 + e]; tot += c; base += (b2 < bx) ? c : 0; }
                sPT[tid] = tot; sPB[tid] = base; }
            __syncthreads();
            if (tid < 32) { int tot = 0, base = 0;
#pragma unroll
                for (int p = 0; p < 16; ++p) { tot += sPT[p * 32 + tid]; base += sPB[p * 32 + tid]; } sTot[tid] = tot; sBase[tid] = base; }
            __syncthreads();
            if (tid == 0) { int off = 0, nt = 0;
#pragma unroll 1
                for (int e = 0; e < 32; ++e) { sOff[e] = off; const int n = (sTot[e] + 255) >> 8;
                    if (bx == 0) {
#pragma unroll 1
                        for (int i = 0; i < n; ++i) TILEE[nt + i] = e; }
                    nt += n; off += n * 256; }
                if (bx == 0) TILEE[512] = nt; }
            __syncthreads();
            if (tid < 256) { const int t = bx * 64 + (tid >> 2), k = tid & 3; const int e = TOKE[t * 4 + k];
                const int row = sOff[e] + sBase[e] + TOKLP[t * 4 + k]; TOKROW[t * 4 + k] = row; ROWW[row] = TOKW[t * 4 + k]; ROWTOK[row] = t; }
            if (bx < 32 && tid < 256) { const int lo = sOff[bx] + sTot[bx], hi = sOff[bx] + (((sTot[bx] + 255) >> 8) << 8);
                if (lo + tid < hi) ROWTOK[lo + tid] = 0; }
            SEAM();
        }
        PHASE(PH_GU) {
            PH_LOCALS
            const int ntiles = __builtin_amdgcn_readfirstlane(TILEE[512]);
            pg8::Gemm g{(const bf16*)XB8, (const bf16*)(WGU8 + (size_t)l * NEXP * 2048 * DM), DM / 2, DM / 2, DM / 2, 0, ROWTOK};
            pg8::StaticOrder S; S.init(ntiles, 8, G, bx, TILEE);
            pg8::EpiSwiglu E{args.in[I_BGU] + (size_t)l * NEXP * 2048, TILEE, ACT8};
            pg8::gemm_phase<pg8::EpiSwiglu, true, true, true>(lds, g, S, E, tid);
            SEAM();
        }
        PHASE(PH_DOWN) {
            PH_LOCALS
            const int ntiles = __builtin_amdgcn_readfirstlane(TILEE[512]);
            pg8::Gemm g{(const bf16*)ACT8, (const bf16*)(WDN8 + (size_t)l * NEXP * DM * DFF), DFF / 2, DFF / 2, DFF / 2, 0, nullptr};
            pg8::StaticOrder S; S.init(ntiles, 4, G, bx, TILEE, 1, 1);
            pg8::EpiDown E{args.in[I_BDN] + (size_t)l * NEXP * DM, TILEE, ROWW, (unsigned char*)YS};
            pg8::gemm_phase<pg8::EpiDown, true, false, true>(lds, g, S, E, tid);
            SEAM();
        }
        PHASE(PH_LN2) {
            PH_LOCALS
            const float* g2 = args.in[I_LN2G] + (size_t)l * DM; const float* b2 = args.in[I_LN2B] + (size_t)l * DM;
            f32x4 gv[4], bv[4];
#pragma unroll
            for (int j = 0; j < 4; ++j) { gv[j] = *(const f32x4*)(g2 + 4 * lane + 256 * j); bv[j] = *(const f32x4*)(b2 + 4 * lane + 256 * j); }
            const int tw0 = bx * (TOK / GRID) + wave * 8;
            const int myrow = TOKROW[tw0 * 4 + (lane & 31)];
#pragma unroll 1
            for (int i0 = 0; i0 < 8; i0 += 4) {
                u32x2 xb4[4][4]; unsigned ys4[4][4][4];
#pragma unroll
                for (int q = 0; q < 4; ++q) { const int t = tw0 + i0 + q;
#pragma unroll
                    for (int j = 0; j < 4; ++j) xb4[q][j] = *(const u32x2*)(XB + (size_t)t * DM + 4 * lane + 256 * j);
#pragma unroll
                    for (int k = 0; k < 4; ++k) { const int row = __builtin_amdgcn_readlane(myrow, (i0 + q) * 4 + k); const unsigned char* yr = (const unsigned char*)YS + (size_t)row * DM;
#pragma unroll
                        for (int j = 0; j < 4; ++j) ys4[q][k][j] = *(const unsigned*)(yr + 4 * lane + 256 * j); } }
#pragma unroll
                for (int q = 0; q < 4; ++q) {
                    const int t = tw0 + i0 + q;
                    f32x4 v[4];
#pragma unroll
                    for (int j = 0; j < 4; ++j) { const u32x2 w = xb4[q][j]; v[j] = (f32x4){bflo(w.x), bfhi(w.x), bflo(w.y), bfhi(w.y)} * DN_ALPHA;
                        f32x4 ya = (f32x4){0.f, 0.f, 0.f, 0.f};
#pragma unroll
                        for (int k = 0; k < 4; ++k) { const unsigned y = ys4[q][k][j]; const f32x2 lo = __builtin_amdgcn_cvt_pk_f32_fp8((int)y, false), hi2 = __builtin_amdgcn_cvt_pk_f32_fp8((int)y, true);
                            ya[0] += lo[0]; ya[1] += lo[1]; ya[2] += hi2[0]; ya[3] += hi2[1]; }
                        v[j] = v[j] + ya * (1.0f / YS8_SCALE); }
                    float sacc = 0.f;
#pragma unroll
                    for (int j = 0; j < 4; ++j) sacc += (v[j][0] + v[j][1]) + (v[j][2] + v[j][3]);
                    const float mean = wave_sum(sacc, lane) * (1.f / DM); float s2 = 0.f;
#pragma unroll
                    for (int j = 0; j < 4; ++j) { v[j] = v[j] - mean; s2 += (v[j][0] * v[j][0] + v[j][1] * v[j][1]) + (v[j][2] * v[j][2] + v[j][3] * v[j][3]); }
                    const float rstd = 1.f / sqrtf(wave_sum(s2, lane) * (1.f / DM) + LN_EPS);
#pragma unroll
                    for (int j = 0; j < 4; ++j) { const f32x4 o = v[j] * rstd * gv[j] + bv[j];
                        if (l == DEPTH - 1) *(f32x4*)(args.out + (size_t)t * DM + 4 * lane + 256 * j) = o;
                        u32x2 w; w.x = cvtpk(o[0], o[1]); w.y = cvtpk(o[2], o[3]);
                        *(u32x2*)(XB + (size_t)t * DM + 4 * lane + 256 * j) = w;
                        *(unsigned*)(XB8I + (size_t)t * DM + 4 * lane + 256 * j) = pk4_fp8(o[0], o[1], o[2], o[3]); }
                }
            }
            if (l + 1 < args.lay_hi) SEAM();
        }
#undef IN
#undef PHASE
    }
}

extern "C" void kernel_launch(void* const* d_in, const int* in_sizes, int n_in, void* d_out, int out_size, void* d_ws, size_t ws_size, hipStream_t stream) {
    static int ok = 0;
    if (ok == 0) {
        if (n_in != 28 || in_sizes[0] != TOK * DM || out_size != TOK * DM || ws_size < WS_END) {
            fprintf(stderr, "kernel_launch: unexpected shapes: n_in %d in0 %d out %d ws %zu (need %zu)\n", n_in, n_in > 0 ? in_sizes[0] : -1, out_size, ws_size, (size_t)WS_END); ok = -1; return; }
        int dev = 0, cus = 0, per_cu = 0;
        hipGetDevice(&dev); hipDeviceGetAttribute(&cus, hipDeviceAttributeMultiprocessorCount, dev);
        if (hipFuncSetAttribute((const void*)mega, hipFuncAttributeMaxDynamicSharedMemorySize, LDS_BYTES) != hipSuccess) { fprintf(stderr, "kernel_launch: hipFuncSetAttribute failed\n"); ok = -1; return; }
        if (hipOccupancyMaxActiveBlocksPerMultiprocessor(&per_cu, (const void*)mega, NTHR, LDS_BYTES) != hipSuccess || per_cu < 1) fprintf(stderr, "kernel_launch: occupancy query says %d blocks/CU\n", per_cu);
        (void)hipGetLastError();
        if (cus < GRID) { fprintf(stderr, "kernel_launch: device has %d CUs, need %d\n", cus, GRID); ok = -1; return; }
        ok = 1;
    }
    if (ok < 0) return;
    hipMemsetAsync((char*)d_ws + OFF_CTL, 0, CTL_BYTES, stream);
    Args a{};
    for (int i = 0; i < 28; ++i) a.in[i] = (const float*)d_in[i];
    a.out = (float*)d_out; a.ws = (unsigned char*)d_ws;
    for (int l = 0; l < 4; ++l) a.lam_init[l] = (float)(0.8 - 0.6 * exp(-0.3 * (double)l));
#if MK_MULTI
    a.single = 0;
    a.lay_lo = -1; a.lay_hi = 0; a.ph_lo = 0; a.ph_hi = 0;
    hipLaunchKernelGGL(mega, dim3(GRID), dim3(NTHR), LDS_BYTES, stream, a);
    for (int l = 0; l < DEPTH; ++l) for (int p = 1; p < PH_END; ++p) { a.lay_lo = l; a.lay_hi = l + 1; a.ph_lo = p; a.ph_hi = p + 1; hipLaunchKernelGGL(mega, dim3(GRID), dim3(NTHR), LDS_BYTES, stream, a); }
#else
    a.single = 1; a.lay_lo = -1; a.lay_hi = DEPTH; a.ph_lo = 1; a.ph_hi = PH_END;
    hipLaunchKernelGGL(mega, dim3(GRID), dim3(NTHR), LDS_BYTES, stream, a);
#endif
    const hipError_t le = hipPeekAtLastError();
    if (le != hipSuccess) fprintf(stderr, "kernel_launch: launch failed: %s\n", hipGetErrorName(le));
}
```
